# Optimizing an MI355X kernel written in HIP

```python
import math
import jax, jax.numpy as jnp
from jax import lax
import numpy as np

D_MODEL = 1024
BATCH = 2
SEQ = 8192
DEPTH = 1

N_MEM = 256
MLA_HEADS = 8
QK_NOPE = 64
QK_ROPE = 32
V_HEAD = 64
Q_LORA = 384
KV_LORA = 256
MLA_WIDTH = MLA_HEADS * V_HEAD
SSM_WIDTH = 512
SSM_GROUP = 16
SSM_GROUPS = SSM_WIDTH // SSM_GROUP
SSM_STATE = 64
DT_MIN = 1e-3
DT_MAX = 1e-1
MIX_WIDTH = MLA_WIDTH + SSM_WIDTH
IN_WIDTH = Q_LORA + KV_LORA + QK_ROPE + SSM_WIDTH
X_HEADS = 4
X_HEAD_DIM = D_MODEL // X_HEADS
N_KEYS = 128
N_EXPERTS = N_KEYS * N_KEYS
PEER_HEADS = 8
PEER_TOPK = 16
D_KEY = 256
HALF_KEY = D_KEY // 2
Q_BLOCK = 128
TOK_BLOCK = 128
ROPE_THETA = 10000.0
LN_EPS = 1e-5
RMS_EPS = 1e-6
ALPHA = (2 * DEPTH) ** 0.25
BETA = (8 * DEPTH) ** -0.25

kernel_name = "hybrid_mla_s5_peer_deepnorm_layer"


def layer_norm(x, g, b):
    xf = x.astype(jnp.float32)
    mu = jnp.mean(xf, -1, keepdims=True)
    var = jnp.mean(jnp.square(xf - mu), -1, keepdims=True)
    return ((xf - mu) * lax.rsqrt(var + LN_EPS) * g + b).astype(x.dtype)


def rms_norm(x, g):
    xf = x.astype(jnp.float32)
    return (xf * lax.rsqrt(jnp.mean(jnp.square(xf), -1, keepdims=True) + RMS_EPS) * g).astype(x.dtype)


def rope_angles(pos, dim):
    half = dim // 2
    freqs = ROPE_THETA ** (-jnp.arange(half, dtype=jnp.float32) / half)
    ang = pos.astype(jnp.float32)[..., None] * freqs
    return jnp.cos(ang), jnp.sin(ang)


def apply_rope(x, cos, sin):
    half = x.shape[-1] // 2
    xf = x.astype(jnp.float32)
    x1, x2 = xf[..., :half], xf[..., half:]
    return jnp.concatenate([x1 * cos - x2 * sin, x2 * cos + x1 * sin], -1).astype(x.dtype)


def mla(c_q, c_kv, k_r, pos, g_cq, w_uq, g_ckv, w_ukv):
    B, L, _ = c_q.shape
    dq = QK_NOPE + QK_ROPE
    q = (rms_norm(c_q, g_cq) @ w_uq).reshape(B, L, MLA_HEADS, dq)
    kv = (rms_norm(c_kv, g_ckv) @ w_ukv).reshape(B, L, MLA_HEADS, QK_NOPE + V_HEAD)
    q_nope, q_rope = q[..., :QK_NOPE], q[..., QK_NOPE:]
    k_nope, v = kv[..., :QK_NOPE], kv[..., QK_NOPE:]
    cos, sin = rope_angles(pos, QK_ROPE)
    q_rope = apply_rope(q_rope, cos[:, :, None], sin[:, :, None])
    k_rope = apply_rope(k_r, cos, sin)
    q = jnp.concatenate([q_nope, q_rope], -1)
    k = jnp.concatenate([k_nope, jnp.broadcast_to(k_rope[:, :, None], (B, L, MLA_HEADS, QK_ROPE))], -1)
    scale = dq ** -0.5
    nb = L // Q_BLOCK
    q_blocks = q.reshape(B, nb, Q_BLOCK, MLA_HEADS, dq).transpose(1, 0, 2, 3, 4)
    key_idx = jnp.arange(L)

    def block(args):
        qb, start = args
        s = jnp.einsum('bqhd,bkhd->bhqk', qb, k).astype(jnp.float32) * scale
        q_idx = start + jnp.arange(Q_BLOCK)
        s = jnp.where(key_idx[None, :] <= q_idx[:, None], s, -jnp.inf)
        p = jax.nn.softmax(s, -1).astype(v.dtype)
        return jnp.einsum('bhqk,bkhd->bqhd', p, v)

    o = lax.map(block, (q_blocks, jnp.arange(nb) * Q_BLOCK))
    return o.transpose(1, 0, 2, 3, 4).reshape(B, L, MLA_WIDTH)


def s5_ssm(u, lam_re, lam_im, log_dt, b_re, b_im, c_re, c_im, d_skip, w_glu, b_glu):
    B, L, _ = u.shape
    f32 = jnp.float32
    ug = u.reshape(B, L, SSM_GROUPS, SSM_GROUP).astype(f32)
    lr, li = lam_re.astype(f32), lam_im.astype(f32)
    b_re, b_im = b_re.astype(f32), b_im.astype(f32)
    c_re, c_im = c_re.astype(f32), c_im.astype(f32)
    dt = jnp.exp(log_dt.astype(f32))[:, None]
    mag = jnp.exp(lr * dt)
    ab_re, ab_im = mag * jnp.cos(li * dt), mag * jnp.sin(li * dt)
    den = lr * lr + li * li
    nr, ni = ab_re - 1.0, ab_im
    f_re = (nr * lr + ni * li) / den
    f_im = (ni * lr - nr * li) / den
    bb_re = f_re[..., None] * b_re - f_im[..., None] * b_im
    bb_im = f_re[..., None] * b_im + f_im[..., None] * b_re
    bu_re = jnp.einsum('blgh,gph->blgp', ug, bb_re)
    bu_im = jnp.einsum('blgh,gph->blgp', ug, bb_im)
    a_re = jnp.broadcast_to(ab_re, bu_re.shape)
    a_im = jnp.broadcast_to(ab_im, bu_im.shape)

    def combine(e1, e2):
        a1r, a1i, b1r, b1i = e1
        a2r, a2i, b2r, b2i = e2
        return (a2r * a1r - a2i * a1i,
                a2r * a1i + a2i * a1r,
                a2r * b1r - a2i * b1i + b2r,
                a2r * b1i + a2i * b1r + b2i)

    _, _, s_re, s_im = lax.associative_scan(combine, (a_re, a_im, bu_re, bu_im), axis=1)
    y = (jnp.einsum('blgp,ghp->blgh', s_re, c_re)
         - jnp.einsum('blgp,ghp->blgh', s_im, c_im)
         + d_skip.astype(f32) * ug)
    y = jax.nn.gelu(y.reshape(B, L, SSM_WIDTH))
    y = y * jax.nn.sigmoid(y @ w_glu.astype(f32) + b_glu.astype(f32))
    return y.astype(u.dtype)


def mem_xattn(x, mem, w_q, w_k, w_v, w_o):
    B, L, _ = x.shape
    M = mem.shape[1]
    q = (x @ w_q).reshape(B, L, X_HEADS, X_HEAD_DIM)
    k = (mem @ w_k).reshape(B, M, X_HEADS, X_HEAD_DIM)
    v = (mem @ w_v).reshape(B, M, X_HEADS, X_HEAD_DIM)
    s = jnp.einsum('blhd,bmhd->bhlm', q, k).astype(jnp.float32) * (X_HEAD_DIM ** -0.5)
    p = jax.nn.softmax(s, -1).astype(v.dtype)
    o = jnp.einsum('bhlm,bmhd->blhd', p, v).reshape(B, L, D_MODEL)
    return o @ w_o


def peer(x, w_query, sub_keys1, sub_keys2, u_tab, v_tab):
    B, L, D = x.shape
    T = B * L
    xt = x.reshape(T, D)
    q = (xt @ w_query).reshape(T, PEER_HEADS, 2, HALF_KEY)
    s1 = jnp.einsum('thd,nd->thn', q[:, :, 0], sub_keys1).astype(jnp.float32)
    s2 = jnp.einsum('thd,nd->thn', q[:, :, 1], sub_keys2).astype(jnp.float32)
    v1, i1 = lax.top_k(s1, PEER_TOPK)
    v2, i2 = lax.top_k(s2, PEER_TOPK)
    cand_s = (v1[..., :, None] + v2[..., None, :]).reshape(T, PEER_HEADS, PEER_TOPK * PEER_TOPK)
    cand_id = (i1[..., :, None] * N_KEYS + i2[..., None, :]).reshape(T, PEER_HEADS, PEER_TOPK * PEER_TOPK)
    top_s, sel = lax.top_k(cand_s, PEER_TOPK)
    ids = jnp.take_along_axis(cand_id, sel, -1)
    gates = jax.nn.softmax(top_s, -1).astype(x.dtype)
    nb = T // TOK_BLOCK

    def block(args):
        xb, idb, gb = args
        u = u_tab[idb]
        h = jax.nn.gelu(jnp.einsum('td,thkd->thk', xb, u))
        return jnp.einsum('thk,thkd->td', gb * h, v_tab[idb])

    out = lax.map(block, (xt.reshape(nb, TOK_BLOCK, D),
                          ids.reshape(nb, TOK_BLOCK, PEER_HEADS, PEER_TOPK),
                          gates.reshape(nb, TOK_BLOCK, PEER_HEADS, PEER_TOPK)))
    return out.reshape(B, L, D)


def setup_inputs(seed: int = 0) -> dict:
    key = jax.random.key(seed)
    ks = iter(jax.random.split(key, 48))

    def nrm(shape, scale):
        return jax.random.normal(next(ks), shape, jnp.float32) * scale

    def gain(n):
        return 1.0 + nrm((DEPTH, n), 0.02)

    G, P, H = SSM_GROUPS, SSM_STATE, SSM_GROUP
    x = nrm((BATCH, SEQ, D_MODEL), 1.0)
    mem = nrm((BATCH, N_MEM, D_MODEL), 1.0)
    positions = (jax.random.randint(next(ks), (BATCH, 1), 0, 4096, dtype=jnp.int32)
                 + jnp.arange(SEQ, dtype=jnp.int32)[None, :])
    n_idx = jnp.arange(P, dtype=jnp.float32)
    return {
        "x": x,
        "mem": mem,
        "positions": positions,
        "w_in": nrm((DEPTH, D_MODEL, IN_WIDTH), D_MODEL ** -0.5),
        "g_cq": gain(Q_LORA),
        "w_uq": nrm((DEPTH, Q_LORA, MLA_HEADS * (QK_NOPE + QK_ROPE)), Q_LORA ** -0.5),
        "g_ckv": gain(KV_LORA),
        "w_ukv": nrm((DEPTH, KV_LORA, MLA_HEADS * (QK_NOPE + V_HEAD)), KV_LORA ** -0.5),
        "lam_re": -0.5 + nrm((DEPTH, G, P), 0.01),
        "lam_im": jnp.pi * n_idx + nrm((DEPTH, G, P), 0.01),
        "log_dt": jax.random.uniform(next(ks), (DEPTH, G), jnp.float32,
                                     minval=math.log(DT_MIN), maxval=math.log(DT_MAX)),
        "b_re": nrm((DEPTH, G, P, H), (2.0 * H) ** -0.5),
        "b_im": nrm((DEPTH, G, P, H), (2.0 * H) ** -0.5),
        "c_re": nrm((DEPTH, G, H, P), (2.0 * P) ** -0.5),
        "c_im": nrm((DEPTH, G, H, P), (2.0 * P) ** -0.5),
        "d_skip": nrm((DEPTH, G, H), 1.0),
        "w_glu": nrm((DEPTH, SSM_WIDTH, SSM_WIDTH), SSM_WIDTH ** -0.5),
        "b_glu": nrm((DEPTH, SSM_WIDTH), 0.01),
        "g_mla_out": gain(MLA_WIDTH),
        "g_ssm_out": gain(SSM_WIDTH),
        "w_out": nrm((DEPTH, MIX_WIDTH, D_MODEL), BETA * MIX_WIDTH ** -0.5),
        "ln1_g": gain(D_MODEL),
        "ln1_b": nrm((DEPTH, D_MODEL), 0.01),
        "xq": nrm((DEPTH, D_MODEL, D_MODEL), D_MODEL ** -0.5),
        "xk": nrm((DEPTH, D_MODEL, D_MODEL), D_MODEL ** -0.5),
        "xv": nrm((DEPTH, D_MODEL, D_MODEL), D_MODEL ** -0.5),
        "xo": nrm((DEPTH, D_MODEL, D_MODEL), BETA * D_MODEL ** -0.5),
        "ln2_g": gain(D_MODEL),
        "ln2_b": nrm((DEPTH, D_MODEL), 0.01),
        "w_query": nrm((DEPTH, D_MODEL, PEER_HEADS * D_KEY), D_MODEL ** -0.5),
        "sub_keys1": nrm((DEPTH, N_KEYS, HALF_KEY), HALF_KEY ** -0.5),
        "sub_keys2": nrm((DEPTH, N_KEYS, HALF_KEY), HALF_KEY ** -0.5),
        "u_tab": nrm((DEPTH, N_EXPERTS, D_MODEL), D_MODEL ** -0.5),
        "v_tab": nrm((DEPTH, N_EXPERTS, D_MODEL), BETA),
        "ln3_g": gain(D_MODEL),
        "ln3_b": nrm((DEPTH, D_MODEL), 0.01),
    }


def reference(x, mem, positions, w_in, g_cq, w_uq, g_ckv, w_ukv, lam_re, lam_im, log_dt,
              b_re, b_im, c_re, c_im, d_skip, w_glu, b_glu, g_mla_out, g_ssm_out, w_out,
              ln1_g, ln1_b, xq, xk, xv, xo, ln2_g, ln2_b, w_query, sub_keys1, sub_keys2,
              u_tab, v_tab, ln3_g, ln3_b):
    split_at = [Q_LORA, Q_LORA + KV_LORA, Q_LORA + KV_LORA + QK_ROPE]
    for l in range(DEPTH):
        proj = x @ w_in[l]
        c_q, c_kv, k_r, u = jnp.split(proj, split_at, axis=-1)
        o_attn = mla(c_q, c_kv, k_r, positions, g_cq[l], w_uq[l], g_ckv[l], w_ukv[l])
        o_ssm = s5_ssm(u, lam_re[l], lam_im[l], log_dt[l], b_re[l], b_im[l], c_re[l], c_im[l],
                       d_skip[l], w_glu[l], b_glu[l])
        mixed = jnp.concatenate([rms_norm(o_attn, g_mla_out[l]),
                                 rms_norm(o_ssm, g_ssm_out[l])], -1) @ w_out[l]
        x = layer_norm(ALPHA * x + mixed, ln1_g[l], ln1_b[l])
        x = layer_norm(ALPHA * x + mem_xattn(x, mem, xq[l], xk[l], xv[l], xo[l]), ln2_g[l], ln2_b[l])
        x = layer_norm(ALPHA * x + peer(x, w_query[l], sub_keys1[l], sub_keys2[l], u_tab[l], v_tab[l]),
                       ln3_g[l], ln3_b[l])
    return x
```

```cpp
#include <hip/hip_runtime.h>
#include <hip/hip_bf16.h>
#include <cstdio>
#include <cstdint>
#include <cmath>

#ifndef MK_PER_PHASE
#define MK_PER_PHASE 0
#endif
#ifndef MK_DBG
#define MK_DBG 0
#endif
namespace pg8 {
#define PG8_LAS __attribute__((address_space(3)))
typedef unsigned short bf16_t;
typedef short bf16x8 __attribute__((ext_vector_type(8)));
typedef float f32x4 __attribute__((ext_vector_type(4)));
typedef unsigned u32x4 __attribute__((ext_vector_type(4)));
constexpr int BM = 256, BK = 64, HALF = 128, HTB = HALF * BK * 2  , STAGE_BYTES = 8 * HTB, NXCD = 8, WGM = 8;

__host__ __device__ __forceinline__ int lds_byte(int r, int c) { const int st = (r >> 4) * 2 + (c >> 5), rr = r & 15, cc = c & 31, ob = rr * 64 + cc * 2; return st * 1024 + (ob ^ (((ob >> 9) & 1) << 5)); }
__host__ __device__ __forceinline__ void stage_rc(int b, int& R, int& C) { const int st = b / 1024, sb = b % 1024, swz = sb ^ (((sb >> 9) & 1) << 5); R = (st >> 1) * 16 + swz / 64; C = (st & 1) * 32 + (swz % 64) / 2; }
__host__ __device__ __forceinline__ int perm32(int rho) { const int n = rho >> 4, i = rho & 15; return 8 * (i >> 2) + 4 * n + (i & 3); }

struct Unit { int pm, pn; };
struct Gemm { const bf16_t* A; const bf16_t* Bt; int M, N, K; };

struct StaticOrder {
    int nM, nN, nwg, G, c;
    __host__ __device__ void init(int M, int N, int G_, int c_) { nM = M / BM; nN = N / BM; nwg = nM * nN; G = G_; c = c_; }
    __host__ __device__ bool next(int i, Unit& u) const {
        const long L = (long)i * G + c; if (L >= nwg) return false;
        int wgid = (int)L; { const int q = nwg / NXCD, r = nwg % NXCD, xcd = wgid % NXCD, off = wgid / NXCD; wgid = (xcd < r ? xcd * (q + 1) : r * (q + 1) + (xcd - r) * q) + off; }
        const int nig = WGM * nN, gid = wgid / nig, fm = gid * WGM, gsz = (nM - fm) < WGM ? (nM - fm) : WGM;
        u.pm = fm + ((wgid % nig) % gsz); u.pn = (wgid % nig) / gsz; return true;
    }
    __device__ __forceinline__ void a_ready(const Unit&) const {}
    __device__ __forceinline__ void done(const Unit&) const {}
};

__device__ __forceinline__ unsigned cvt_pk_bf16(float lo, float hi) { unsigned r; asm volatile("v_cvt_pk_bf16_f32 %0, %1, %2" : "=v"(r) : "v"(lo), "v"(hi)); return r; }
typedef float f32x2 __attribute__((ext_vector_type(2)));
__device__ __forceinline__ f32x2 gelu_pk(f32x2 v) {
    const f32x2 av = __builtin_elementwise_abs(v), d = av * 0.2316418882f + 1.0f;
    f32x2 t; t.x = __builtin_amdgcn_rcpf(d.x); t.y = __builtin_amdgcn_rcpf(d.y);
    f32x2 q = t * 0.5307027145f + (-0.7265760135f); q = q * t + 0.7107068705f; q = q * t + (-0.142248368f); q = q * t + 0.127414796f; q = q * t;
    const f32x2 s = (v * v) * (-0.72134752044f);
    f32x2 e; e.x = __builtin_amdgcn_exp2f(s.x); e.y = __builtin_amdgcn_exp2f(s.y);
    const f32x2 m = v * (q * e), r = v - m;
    f32x2 o; o.x = v.x < 0.f ? m.x : r.x; o.y = v.y < 0.f ? m.y : r.y; return o;
}

template <int ACT  > struct EpiBf16 {
    static constexpr bool PERM = true, AFTER_DRAIN = false; static_assert(ACT == 0 || ACT == 1, "EpiBf16: ACT is 0 (none) or 1 (gelu_pk)");
    bf16_t* O; int ldc; const float* bias; int split_cols; size_t split_stride; float scale0;
    __device__ __forceinline__ void operator()(const f32x4 (&acc)[2][2][4][2], const Unit& u, int wr, int wc, int fr, int fq) const {
        const int row0 = u.pm * BM + wr * 64 + fr; int colt = u.pn * BM; bf16_t* base = O;
        float sc = 1.f; if (split_cols) { const int t = colt / split_cols; base += (size_t)t * split_stride; colt -= t * split_cols; if (t == 0) sc = scale0; }
        const int col0 = colt + wc * 32 + 8 * fq, bcol0 = u.pn * BM + wc * 32 + 8 * fq;
        f32x4 bv[2][2];
#pragma unroll
        for (int bj = 0; bj < 2; ++bj)
#pragma unroll
            for (int n = 0; n < 2; ++n) bv[bj][n] = bias ? *(const f32x4*)(bias + bcol0 + bj * HALF + 4 * n) : (f32x4){0.f, 0.f, 0.f, 0.f};
#pragma unroll
        for (int ai = 0; ai < 2; ++ai)
#pragma unroll
            for (int m = 0; m < 4; ++m) { bf16_t* rowp = base + (size_t)(row0 + ai * HALF + m * 16) * ldc + col0;
#pragma unroll
                for (int bj = 0; bj < 2; ++bj) { f32x4 v0 = acc[ai][bj][m][0] + bv[bj][0], v1 = acc[ai][bj][m][1] + bv[bj][1];
                    if (ACT == 1) { f32x2 a = gelu_pk((f32x2){v0[0], v0[1]}), b = gelu_pk((f32x2){v0[2], v0[3]}), c = gelu_pk((f32x2){v1[0], v1[1]}), d = gelu_pk((f32x2){v1[2], v1[3]});
                        v0 = (f32x4){a.x, a.y, b.x, b.y}; v1 = (f32x4){c.x, c.y, d.x, d.y}; }
                    v0 = v0 * sc; v1 = v1 * sc; u32x4 w; w.x = cvt_pk_bf16(v0[0], v0[1]); w.y = cvt_pk_bf16(v0[2], v0[3]); w.z = cvt_pk_bf16(v1[0], v1[1]); w.w = cvt_pk_bf16(v1[2], v1[3]);
                    *(u32x4*)(rowp + bj * HALF) = w; } }
    }
};

struct PanelStats {
    unsigned* xbuf;
    unsigned* cnt;
    unsigned* tmo;
    int ntn; float eps;
    unsigned code;
    __device__ __forceinline__ bool run(const f32x4 (&v)[2][2][4][2], const Unit& u, int wr, int wc, int fr, int fq, PG8_LAS unsigned char* lds, int wid, int lane) const {
        typedef float f32x2v __attribute__((ext_vector_type(2)));
        PG8_LAS f32x2v* P = (PG8_LAS f32x2v*)lds;
        PG8_LAS f32x2v* S = (PG8_LAS f32x2v*)(lds + 8192);
        PG8_LAS unsigned* flag = (PG8_LAS unsigned*)(lds + 8192 + 2048);
#pragma unroll
        for (int ai = 0; ai < 2; ++ai)
#pragma unroll
            for (int m = 0; m < 4; ++m) {
                float s = 0.f;
#pragma unroll
                for (int bj = 0; bj < 2; ++bj)
#pragma unroll
                    for (int n = 0; n < 2; ++n) { const f32x4 x = v[ai][bj][m][n]; s += (x[0] + x[1]) + (x[2] + x[3]); }
                s += __shfl_xor(s, 16); s += __shfl_xor(s, 32);
                const float mw = s * (1.0f / 64.0f); float q = 0.f;
#pragma unroll
                for (int bj = 0; bj < 2; ++bj)
#pragma unroll
                    for (int n = 0; n < 2; ++n) { const f32x4 d = v[ai][bj][m][n] - mw; q += (d[0] * d[0] + d[1] * d[1]) + (d[2] * d[2] + d[3] * d[3]); }
                q += __shfl_xor(q, 16); q += __shfl_xor(q, 32);
                if (fq == 0) P[(ai * HALF + wr * 64 + m * 16 + fr) * 4 + wc] = (f32x2v){mw, q};
            }
        asm volatile("s_waitcnt lgkmcnt(0)" ::: "memory"); __builtin_amdgcn_s_barrier(); asm volatile("" ::: "memory");
#if defined(BROKEN_EXCHANGE_NO_WAIT)
#warning BROKEN CONTROL BUILD: the row-statistics exchange does not wait; results are wrong by design
        if (blockIdx.x >= 64) { const long long t0_ = clock64(); while (clock64() - t0_ < 60000) __builtin_amdgcn_s_sleep(8); }
#endif
        const int row = wid * 32 + (lane & 31);
        if (lane < 32) {
            const f32x2v a = P[row * 4 + 0], b = P[row * 4 + 1], c = P[row * 4 + 2], d = P[row * 4 + 3];
            const float mt = (a.x + b.x + c.x + d.x) * 0.25f;
            const float da = a.x - mt, db = b.x - mt, dc = c.x - mt, dd = d.x - mt;
            const float m2 = (a.y + b.y) + (c.y + d.y) + 64.0f * ((da * da + db * db) + (dc * dc + dd * dd));
            unsigned long long* slot = (unsigned long long*)xbuf + ((size_t)(u.pm * BM + row) * 4 + u.pn);
            __hip_atomic_store(slot, ((unsigned long long)__float_as_uint(m2) << 32) | __float_as_uint(mt), __ATOMIC_RELAXED, __HIP_MEMORY_SCOPE_AGENT);
        }
        asm volatile("s_waitcnt vmcnt(0)" ::: "memory");
        if (lane == 0) __hip_atomic_fetch_add(cnt + 64 * u.pm, 1u, __ATOMIC_RELAXED, __HIP_MEMORY_SCOPE_AGENT);
        if (wid == 0) {
            bool dead = false; const unsigned long long t0 = __builtin_amdgcn_s_memrealtime(); const unsigned want = 8u * (unsigned)ntn;
            for (;;) {
#if defined(BROKEN_EXCHANGE_NO_WAIT)
                break;
#endif
                if ((unsigned)__builtin_amdgcn_readfirstlane(__hip_atomic_load(cnt + 64 * u.pm, __ATOMIC_RELAXED, __HIP_MEMORY_SCOPE_AGENT)) >= want) break;
                if (__builtin_amdgcn_s_memrealtime() - t0 > 2000000ull) {
                    if (lane == 0) { unsigned expect = 0u; __hip_atomic_compare_exchange_strong(tmo + 1, &expect, code | (unsigned)(u.pm & 0xff), __ATOMIC_RELAXED, __ATOMIC_RELAXED, __HIP_MEMORY_SCOPE_AGENT);
                                     __hip_atomic_store(tmo, 1u, __ATOMIC_RELAXED, __HIP_MEMORY_SCOPE_AGENT); }
                    dead = true; break; }
                __builtin_amdgcn_s_sleep(2);
            }
            __builtin_amdgcn_fence(__ATOMIC_ACQUIRE, "agent");
            if (lane == 0) flag[0] = dead ? 1u : 0u;
        }
        asm volatile("s_waitcnt vmcnt(0) lgkmcnt(0)" ::: "memory"); __builtin_amdgcn_s_barrier(); asm volatile("" ::: "memory");
        const bool bad = flag[0] != 0u;
        if (lane < 32) {
            const unsigned long long* slot = (const unsigned long long*)xbuf + (size_t)(u.pm * BM + row) * 4; float mt[4], m2[4]; float ms = 0.f;
#pragma unroll
            for (int t = 0; t < 4; ++t) { if (t < ntn) { const unsigned long long w = __hip_atomic_load(slot + t, __ATOMIC_RELAXED, __HIP_MEMORY_SCOPE_AGENT); mt[t] = __uint_as_float((unsigned)w); m2[t] = __uint_as_float((unsigned)(w >> 32)); } else { mt[t] = 0.f; m2[t] = 0.f; } ms += mt[t]; }
            const float mean = ms / (float)ntn; float q = 0.f;
#pragma unroll
            for (int t = 0; t < 4; ++t) if (t < ntn) { const float dm = mt[t] - mean; q += m2[t] + 256.0f * dm * dm; }
            S[row] = (f32x2v){mean, 1.0f / sqrtf(q / (256.0f * (float)ntn) + eps)};
        }
        asm volatile("s_waitcnt lgkmcnt(0)" ::: "memory"); __builtin_amdgcn_s_barrier(); asm volatile("" ::: "memory");
        return bad;
    }
};
struct EpiLnRes {
    static constexpr bool PERM = false, AFTER_DRAIN = true;
    const float* base; float* out; int ldc; const float* bias; PanelStats st; unsigned poison;
    __device__ __forceinline__ void fused(f32x4 (&acc)[2][2][4][2], const Unit& u, int wr, int wc, int fr, int fq, PG8_LAS unsigned char* lds, int wid, int lane) const {
        typedef float f32x2v __attribute__((ext_vector_type(2)));
        const PG8_LAS f32x2v* S = (const PG8_LAS f32x2v*)(lds + 8192);
        const int col0 = u.pn * BM + wc * 32 + 4 * fq;
#pragma unroll
        for (int bj = 0; bj < 2; ++bj)
#pragma unroll
            for (int n = 0; n < 2; ++n) { const f32x4 bv = bias ? *(const f32x4*)(bias + col0 + bj * HALF + n * 16) : (f32x4){0.f, 0.f, 0.f, 0.f};
#pragma unroll
                for (int ai = 0; ai < 2; ++ai)
#pragma unroll
                    for (int m = 0; m < 4; ++m) acc[ai][bj][m][n] += bv; }
        f32x4 pre[4][2][2];
#pragma unroll
        for (int m = 0; m < 4; ++m) { const size_t off = (size_t)(u.pm * BM + wr * 64 + m * 16 + fr) * ldc + col0;
#pragma unroll
            for (int bj = 0; bj < 2; ++bj)
#pragma unroll
                for (int n = 0; n < 2; ++n) pre[m][bj][n] = *(const f32x4*)(base + off + bj * HALF + n * 16); }
        const bool bad = st.run(acc, u, wr, wc, fr, fq, lds, wid, lane) || poison != 0u;
        const float qnan = __builtin_nanf("");
#pragma unroll
        for (int ai = 0; ai < 2; ++ai)
#pragma unroll
            for (int m = 0; m < 4; ++m) { const int r = ai * HALF + wr * 64 + m * 16 + fr; const f32x2v sr = S[r]; const size_t off = (size_t)(u.pm * BM + r) * ldc + col0;
#pragma unroll
                for (int bj = 0; bj < 2; ++bj)
#pragma unroll
                    for (int n = 0; n < 2; ++n) { const f32x4 bs = ai == 0 ? pre[m][bj][n] : *(const f32x4*)(base + off + bj * HALF + n * 16); f32x4 o = bs + (acc[ai][bj][m][n] - sr.x) * sr.y;
                        if (bad) o = (f32x4){qnan, qnan, qnan, qnan}; *(f32x4*)(out + off + bj * HALF + n * 16) = o; }
                if (m & 1) asm volatile("" ::: "memory"); }
    }
};
struct EpiLnResLn {
    static constexpr bool PERM = false, AFTER_DRAIN = true;
    const float* base; float* out; bf16_t* xn; int ldc; const float* bias; PanelStats st1, st2; unsigned poison;
    __device__ __forceinline__ void fused(f32x4 (&acc)[2][2][4][2], const Unit& u, int wr, int wc, int fr, int fq, PG8_LAS unsigned char* lds, int wid, int lane) const {
        typedef float f32x2v __attribute__((ext_vector_type(2))); typedef unsigned u32x2v __attribute__((ext_vector_type(2)));
        const PG8_LAS f32x2v* S = (const PG8_LAS f32x2v*)(lds + 8192);
        const int col0 = u.pn * BM + wc * 32 + 4 * fq;
#pragma unroll
        for (int bj = 0; bj < 2; ++bj)
#pragma unroll
            for (int n = 0; n < 2; ++n) { const f32x4 bv = bias ? *(const f32x4*)(bias + col0 + bj * HALF + n * 16) : (f32x4){0.f, 0.f, 0.f, 0.f};
#pragma unroll
                for (int ai = 0; ai < 2; ++ai)
#pragma unroll
                    for (int m = 0; m < 4; ++m) acc[ai][bj][m][n] += bv; }
        bool bad = st1.run(acc, u, wr, wc, fr, fq, lds, wid, lane) || poison != 0u;
        const float qnan = __builtin_nanf("");
#pragma unroll
        for (int ai = 0; ai < 2; ++ai)
#pragma unroll
            for (int m = 0; m < 4; ++m) { const int r = ai * HALF + wr * 64 + m * 16 + fr; const f32x2v sr = S[r]; const size_t off = (size_t)(u.pm * BM + r) * ldc + col0;
#pragma unroll
                for (int bj = 0; bj < 2; ++bj)
#pragma unroll
                    for (int n = 0; n < 2; ++n) { const f32x4 bs = *(const f32x4*)(base + off + bj * HALF + n * 16); acc[ai][bj][m][n] = bs + (acc[ai][bj][m][n] - sr.x) * sr.y; }
                asm volatile("" : "+v"(acc[ai][0][m][0]), "+v"(acc[ai][0][m][1]), "+v"(acc[ai][1][m][0]), "+v"(acc[ai][1][m][1]));
                if (m & 1) asm volatile("" ::: "memory"); }
        const bool bad1 = bad;
        bad = st2.run(acc, u, wr, wc, fr, fq, lds, wid, lane) || bad;
#pragma unroll
        for (int ai = 0; ai < 2; ++ai)
#pragma unroll
            for (int m = 0; m < 4; ++m) { const int r = ai * HALF + wr * 64 + m * 16 + fr; const f32x2v sr = S[r]; const size_t off = (size_t)(u.pm * BM + r) * ldc + col0;
#pragma unroll
                for (int bj = 0; bj < 2; ++bj)
#pragma unroll
                    for (int n = 0; n < 2; ++n) { const f32x4 x1 = acc[ai][bj][m][n]; *(f32x4*)(out + off + bj * HALF + n * 16) = bad1 ? (f32x4){qnan, qnan, qnan, qnan} : x1;
                        const f32x4 o = (x1 - sr.x) * sr.y; u32x2v w; w.x = cvt_pk_bf16(o[0], o[1]); w.y = cvt_pk_bf16(o[2], o[3]);
                        if (bad) { w.x = 0x7fc07fc0u; w.y = 0x7fc07fc0u; } *(u32x2v*)(xn + off + bj * HALF + n * 16) = w; }
                asm volatile("" ::: "memory"); }
    }
};

template <class Epi, class Sched, bool ALIGN_EPI = false, bool SP2 = false>
__device__ __forceinline__ void gemm_phase(PG8_LAS unsigned char* lds, const Gemm g, const Sched& S, const Epi& E) {
    int tid_ = threadIdx.x; asm volatile("" : "+v"(tid_));
    const int tid = tid_, wid = __builtin_amdgcn_readfirstlane(tid >> 6), lane = tid & 63, wr = wid >> 2, wc = wid & 3, fr = lane & 15, fq = lane >> 4;
    const int K = g.K, nt = K / BK;
    unsigned voffA[2], voffB[2];
#pragma unroll
    for (int i = 0; i < 2; ++i) { int R, C; stage_rc(tid * 16 + i * 8192, R, C); const int Rb = Epi::PERM ? ((R & ~31) + perm32(R & 31)) : R;
        voffA[i] = (unsigned)(R * K + C) * 2u; voffB[i] = (unsigned)(Rb * K + C) * 2u; }
    const size_t kstep = (size_t)(BK * 2);
    const size_t hstep = (size_t)HALF * K * 2;
    const size_t tstep = 2 * hstep;
    const unsigned ldsw = (unsigned)wid * 1024u;
    const int aoff = lds_byte(wr * 64 + fr, fq * 8), boff = lds_byte(wc * 32 + fr, fq * 8);
#define PG8_SA(b, h) (((b) * 2 + (h)) * HTB)
#define PG8_SB(b, h) ((4 + (b) * 2 + (h)) * HTB)
#define PG8_STAGE(bufoff, gbase, voff) do { _Pragma("unroll") for (int _i = 0; _i < 2; ++_i) \
        __builtin_amdgcn_global_load_lds((const unsigned*)((const char*)(gbase) + (voff)[_i]), (PG8_LAS unsigned*)(lds + (bufoff) + ldsw + _i * 8192), 16, 0, 0); } while (0)
#define PG8_LDA(dst, b, h) do { _Pragma("unroll") for (int m = 0; m < 4; ++m) _Pragma("unroll") for (int k = 0; k < 2; ++k) dst[m][k] = *(const PG8_LAS bf16x8*)(lds + PG8_SA(b, h) + aoff + m * 2048 + k * 1024); } while (0)
#define PG8_LDB(dst, b, h) do { _Pragma("unroll") for (int n = 0; n < 2; ++n) _Pragma("unroll") for (int k = 0; k < 2; ++k) dst[n][k] = *(const PG8_LAS bf16x8*)(lds + PG8_SB(b, h) + boff + n * 2048 + k * 1024); } while (0)
#define PG8_MMA(ai, bj, At, Bt) do { __builtin_amdgcn_s_setprio(1); _Pragma("unroll") for (int m = 0; m < 4; ++m) _Pragma("unroll") for (int n = 0; n < 2; ++n) _Pragma("unroll") for (int k = 0; k < 2; ++k) \
        acc[ai][bj][m][n] = __builtin_amdgcn_mfma_f32_16x16x32_bf16(Bt[n][k], At[m][k], acc[ai][bj][m][n], 0, 0, 0); __builtin_amdgcn_s_setprio(0); } while (0)
#define PG8_WAIT_V(n) asm volatile("s_waitcnt vmcnt(" #n ")" ::: "memory")
#define PG8_WAIT_L(n) asm volatile("s_waitcnt lgkmcnt(" #n ")" ::: "memory")
#define PG8_BAR __builtin_amdgcn_s_barrier()
#define PG8_SCHED __builtin_amdgcn_sched_barrier(0)
    Unit cur, nxt; int ui = 0;
    if (!S.next(0, cur)) return;
    f32x4 acc[2][2][4][2];
#pragma unroll
    for (int a = 0; a < 2; ++a)
#pragma unroll
        for (int b = 0; b < 2; ++b)
#pragma unroll
            for (int m = 0; m < 4; ++m)
#pragma unroll
                for (int n = 0; n < 2; ++n) acc[a][b][m][n] = (f32x4){0.f, 0.f, 0.f, 0.f};
    bf16x8 At[4][2], B0[2][2], B1[2][2];
    const char* cA = (const char*)g.A + (size_t)cur.pm * tstep; const char* cB = (const char*)g.Bt + (size_t)cur.pn * tstep;
    S.a_ready(cur);
    if constexpr (SP2) {
        PG8_STAGE(PG8_SB(0, 0), cB, voffB); PG8_STAGE(PG8_SB(0, 1), cB + hstep, voffB); PG8_STAGE(PG8_SA(0, 0), cA, voffA); PG8_STAGE(PG8_SA(0, 1), cA + hstep, voffA);
        if (wr == 1) PG8_BAR;
        PG8_WAIT_V(2); PG8_BAR;
        PG8_STAGE(PG8_SB(1, 0), cB + kstep, voffB); PG8_STAGE(PG8_SA(1, 0), cA + kstep, voffA); PG8_STAGE(PG8_SB(1, 1), cB + hstep + kstep, voffB);
        PG8_WAIT_V(6); PG8_BAR;
    } else {
        PG8_STAGE(PG8_SB(0, 0), cB, voffB); PG8_STAGE(PG8_SA(0, 0), cA, voffA); PG8_STAGE(PG8_SB(0, 1), cB + hstep, voffB); PG8_STAGE(PG8_SA(0, 1), cA + hstep, voffA);
        if (wr == 1) PG8_BAR;
        PG8_WAIT_V(4); PG8_BAR;
        PG8_STAGE(PG8_SB(1, 0), cB + kstep, voffB); PG8_STAGE(PG8_SA(1, 0), cA + kstep, voffA); PG8_STAGE(PG8_SB(1, 1), cB + hstep + kstep, voffB);
        PG8_WAIT_V(6); PG8_BAR;
    }
    for (;;) {
        const bool has_next = S.next(ui + 1, nxt);
        const char* nA = has_next ? (const char*)g.A + (size_t)nxt.pm * tstep : cA; const char* nB = has_next ? (const char*)g.Bt + (size_t)nxt.pn * tstep : cB;
#pragma unroll 1
        for (int t = 0; t < nt; t += 2) {
            const bool last = (t == nt - 2);
            const char* a1 = cA + (size_t)(t + 1) * kstep;
            const char* a2 = last ? nA : cA + (size_t)(t + 2) * kstep; const char* b2 = last ? nB : cB + (size_t)(t + 2) * kstep;
            const char* a3 = a2 + kstep; const char* b3 = b2 + kstep;
            if (last && has_next) S.a_ready(nxt);
            if constexpr (SP2) {
            PG8_LDB(B0, 0, 0); PG8_LDB(B1, 0, 1); PG8_SCHED; PG8_LDA(At, 0, 0); PG8_STAGE(PG8_SA(1, 1), a1 + hstep, voffA);
            PG8_WAIT_V(8); PG8_WAIT_L(0); PG8_BAR; PG8_MMA(0, 0, At, B0); PG8_MMA(0, 1, At, B1); PG8_BAR; PG8_SCHED;
            PG8_LDA(At, 0, 1); PG8_STAGE(PG8_SB(0, 0), b2, voffB); PG8_STAGE(PG8_SB(0, 1), b2 + hstep, voffB); PG8_STAGE(PG8_SA(0, 0), a2, voffA);
            PG8_WAIT_V(8); PG8_WAIT_L(0); PG8_BAR; PG8_MMA(1, 0, At, B0); PG8_MMA(1, 1, At, B1); PG8_BAR; PG8_SCHED;
            PG8_LDB(B0, 1, 0); PG8_LDB(B1, 1, 1); PG8_SCHED; PG8_LDA(At, 1, 0); PG8_STAGE(PG8_SA(0, 1), a2 + hstep, voffA);
            PG8_WAIT_V(8); PG8_WAIT_L(0); PG8_BAR; PG8_MMA(0, 0, At, B0); PG8_MMA(0, 1, At, B1); PG8_BAR; PG8_SCHED;
            PG8_LDA(At, 1, 1); PG8_STAGE(PG8_SB(1, 0), b3, voffB); PG8_STAGE(PG8_SB(1, 1), b3 + hstep, voffB); PG8_STAGE(PG8_SA(1, 0), a3, voffA);
            PG8_WAIT_V(8); PG8_WAIT_L(0); PG8_BAR; PG8_MMA(1, 0, At, B0); PG8_MMA(1, 1, At, B1); PG8_BAR; PG8_SCHED;
            } else {
            PG8_LDB(B0, 0, 0); PG8_SCHED; PG8_LDA(At, 0, 0); PG8_STAGE(PG8_SA(1, 1), a1 + hstep, voffA);
            PG8_WAIT_L(8); PG8_BAR; PG8_WAIT_L(0); PG8_MMA(0, 0, At, B0); PG8_BAR; PG8_SCHED;
            PG8_LDB(B1, 0, 1); PG8_STAGE(PG8_SB(0, 0), b2, voffB);
            PG8_BAR; PG8_WAIT_L(0); PG8_MMA(0, 1, At, B1); PG8_BAR;
            PG8_LDA(At, 0, 1); PG8_STAGE(PG8_SA(0, 0), a2, voffA);
            PG8_BAR; PG8_WAIT_L(0); PG8_MMA(1, 0, At, B0); PG8_BAR; PG8_SCHED;
            PG8_STAGE(PG8_SB(0, 1), b2 + hstep, voffB);
            PG8_WAIT_V(6); PG8_BAR; PG8_MMA(1, 1, At, B1); PG8_BAR;
            PG8_LDB(B0, 1, 0); PG8_SCHED; PG8_LDA(At, 1, 0); PG8_STAGE(PG8_SA(0, 1), a2 + hstep, voffA);
            PG8_WAIT_L(8); PG8_BAR; PG8_WAIT_L(0); PG8_MMA(0, 0, At, B0); PG8_BAR; PG8_SCHED;
            PG8_LDB(B1, 1, 1); PG8_STAGE(PG8_SB(1, 0), b3, voffB);
            PG8_BAR; PG8_WAIT_L(0); PG8_MMA(0, 1, At, B1); PG8_BAR;
            PG8_LDA(At, 1, 1); PG8_STAGE(PG8_SA(1, 0), a3, voffA);
            PG8_BAR; PG8_WAIT_L(0); PG8_MMA(1, 0, At, B0); PG8_BAR; PG8_SCHED;
            PG8_STAGE(PG8_SB(1, 1), b3 + hstep, voffB);
            PG8_WAIT_V(6); PG8_BAR; PG8_MMA(1, 1, At, B1); PG8_BAR;
            }
        }
        if constexpr (ALIGN_EPI) { if (wr == 0) PG8_BAR; }
        if constexpr (!Epi::AFTER_DRAIN) { E(acc, cur, wr, wc, fr, fq); S.done(cur); }
        if (!has_next) break;
#pragma unroll
        for (int a = 0; a < 2; ++a)
#pragma unroll
            for (int b = 0; b < 2; ++b)
#pragma unroll
                for (int m = 0; m < 4; ++m)
#pragma unroll
                    for (int n = 0; n < 2; ++n) acc[a][b][m][n] = (f32x4){0.f, 0.f, 0.f, 0.f};
        cur = nxt; cA = nA; cB = nB; ++ui;
        if constexpr (ALIGN_EPI) { if (wr == 1) PG8_BAR; }
    }
    PG8_WAIT_V(0);
    if constexpr (!ALIGN_EPI) { if (wr == 0) PG8_BAR; }
    PG8_BAR;
    if constexpr (Epi::AFTER_DRAIN) { E.fused(acc, cur, wr, wc, fr, fq, lds, wid, lane); S.done(cur); }
#undef PG8_SA
#undef PG8_SB
#undef PG8_STAGE
#undef PG8_LDA
#undef PG8_LDB
#undef PG8_MMA
#undef PG8_WAIT_V
#undef PG8_WAIT_L
#undef PG8_BAR
#undef PG8_SCHED
}
}

namespace mk {
typedef unsigned short bf16;
typedef float f32x4 __attribute__((ext_vector_type(4)));
typedef float f32x2 __attribute__((ext_vector_type(2)));
typedef unsigned u32x4 __attribute__((ext_vector_type(4)));
typedef unsigned u32x2 __attribute__((ext_vector_type(2)));
typedef short bf16x8 __attribute__((ext_vector_type(8)));
#define LAS __attribute__((address_space(3)))

constexpr int NTOK = 16384, DM = 1024, SEQ = 8192, NBATCH = 2;
constexpr int QL = 384, KVL = 256, NINP = 1280;
constexpr float ALPHA = 1.18920711500272f;
constexpr float C2Q = 0.10206207261596575f * 1.4426950408889634f;
constexpr float XSC = 0.0625f * 1.4426950408889634f;
constexpr float LN_EPS = 1e-5f, RMS_EPS = 1e-6f;

constexpr size_t MiB = 1u << 20;
constexpr size_t WS_CTL = 0, CTL_ZERO_BYTES = 1 * MiB;
constexpr size_t W_WINT = 1 * MiB;
constexpr size_t W_WUQT = W_WINT + (size_t)1280 * 1024 * 2;
constexpr size_t W_WUKVT = W_WUQT + (size_t)768 * 384 * 2;
constexpr size_t W_WGLUT = W_WUKVT + (size_t)1024 * 256 * 2;
constexpr size_t W_WOUTT = W_WGLUT + (size_t)512 * 512 * 2;
constexpr size_t W_XKVT = W_WOUTT + (size_t)1024 * 1024 * 2;
constexpr size_t W_XQH = W_XKVT + (size_t)2048 * 1024 * 2;
constexpr size_t W_XOTH = W_XQH + (size_t)4 * 1024 * 256 * 2;
constexpr size_t W_MB = W_XOTH + (size_t)4 * 1024 * 256 * 2;
constexpr size_t W_VOT = W_MB + (size_t)2 * 1024 * 1024 * 2;
constexpr size_t W_K2V2 = W_VOT + (size_t)2 * 1024 * 1024 * 2;
constexpr size_t W_WQR = W_K2V2 + (size_t)2 * 2 * 4 * 256 * 256 * 2;
constexpr size_t W_SKP = W_WQR + (size_t)16 * 1024 * 256 * 2;
constexpr size_t W_WSC = W_SKP + (size_t)2 * 256 * 256 * 2;
constexpr size_t W_TH = W_WSC + (size_t)2048 * 1024 * 2;
constexpr size_t W_GM = W_TH + (size_t)32 * 512 * 640 * 2;
constexpr size_t W_MEMB = W_GM + (size_t)32 * 256 * 640 * 2;
constexpr size_t W_ROPE = W_MEMB + (size_t)512 * 1024 * 2;
constexpr size_t W_SSQ = W_ROPE + (size_t)16384 * 16 * 8;
constexpr size_t W_END = W_SSQ + (size_t)16384 * 20 * 4;
static_assert(W_END <= 80 * MiB, "weights region");
constexpr size_t A_UT = 80 * MiB, A_VT = 112 * MiB;
constexpr size_t A_SCHI = 80 * MiB;
constexpr size_t A_CQ = 144 * MiB, A_CKV = 156 * MiB, A_UP = 164 * MiB, A_QH = 184 * MiB, A_KH = 208 * MiB, A_VH = 232 * MiB, A_LS = 248 * MiB;
constexpr size_t A_OA = 144 * MiB, A_MIXN = 184 * MiB, A_X1 = 216 * MiB, A_P = 144 * MiB, A_X2 = 176 * MiB, A_IDS = 144 * MiB, A_GATES = 152 * MiB;
constexpr size_t WS_NEED = 256 * MiB;
constexpr size_t O_XB = 0, O_YS = 0, O_OS = 16 * MiB;
constexpr int CW_TMO = 0, CW_BAR = 4096, CW_SSQQ = 16384, CW_SSQKV = 32768, CW_DBG = 65536;
constexpr int RING_BYTES = 131072, EXCH_OFF = 131072, MISC_OFF = EXCH_OFF + 8192, LDS_BYTES = 147456;

__device__ __forceinline__ unsigned cvtpk(float lo, float hi) { unsigned r; asm volatile("v_cvt_pk_bf16_f32 %0, %1, %2" : "=v"(r) : "v"(lo), "v"(hi)); return r; }
__device__ __forceinline__ u32x4 pack8(f32x4 a, f32x4 b) { u32x4 w; w.x = cvtpk(a[0], a[1]); w.y = cvtpk(a[2], a[3]); w.z = cvtpk(b[0], b[1]); w.w = cvtpk(b[2], b[3]); return w; }
__device__ __forceinline__ float bflo(unsigned w) { return __uint_as_float(w << 16); }
__device__ __forceinline__ float bfhi(unsigned w) { return __uint_as_float(w & 0xffff0000u); }
__device__ __forceinline__ void unpack8(u32x4 w, f32x4& a, f32x4& b) { a = (f32x4){bflo(w.x), bfhi(w.x), bflo(w.y), bfhi(w.y)}; b = (f32x4){bflo(w.z), bfhi(w.z), bflo(w.w), bfhi(w.w)}; }
__device__ __forceinline__ float gelu_tanh(float v) {
    const float z = v * (1.0f + 0.044715f * v * v) * (-2.0f * 0.7978845608028654f * 1.4426950408889634f);
    return v * __builtin_amdgcn_rcpf(1.0f + __builtin_amdgcn_exp2f(z));
}
__device__ __forceinline__ float sigmoidf_(float z) { return __builtin_amdgcn_rcpf(1.0f + __builtin_amdgcn_exp2f(-1.4426950408889634f * z)); }

template <class Dec> struct ListSched {
    int n, G, c; Dec dec;
    __device__ __forceinline__ bool next(int i, pg8::Unit& u) const { const long L = (long)i * G + c; if (L >= n) return false; dec((int)L, u); return true; }
    __device__ __forceinline__ void a_ready(const pg8::Unit&) const {}
    __device__ __forceinline__ void done(const pg8::Unit&) const {}
};
struct BigSched {
    pg8::StaticOrder so; int bt;
    __device__ __forceinline__ bool next(int i, pg8::Unit& u) const { if (!so.next(i, u)) return false; u.pn += (u.pm >> 5) * bt; return true; }
    __device__ __forceinline__ void a_ready(const pg8::Unit&) const {}
    __device__ __forceinline__ void done(const pg8::Unit&) const {}
};
struct DecLS  { __device__ __forceinline__ void operator()(int L, pg8::Unit& u) const { const int g = L >> 1, b = L & 1; u.pm = 2 * g + b; u.pn = g; } };
struct DecY   { __device__ __forceinline__ void operator()(int L, pg8::Unit& u) const { const int g = L >> 2, b = (L >> 1) & 1, n = L & 1; u.pm = 2 * g + b; u.pn = 2 * g + n; } };
struct DecKV2 { __device__ __forceinline__ void operator()(int L, pg8::Unit& u) const { u.pm = L >> 3; u.pn = L & 7; } };
struct DecMb  { __device__ __forceinline__ void operator()(int L, pg8::Unit& u) const { const int bh = L >> 2, kt = L & 3; u.pm = bh; u.pn = (bh & 3) * 4 + kt; } };
struct DecVOT { __device__ __forceinline__ void operator()(int L, pg8::Unit& u) const { const int bh = L >> 2, ct = L & 3; u.pm = (bh & 3) * 4 + ct; u.pn = bh; } };
struct DecWsc { __device__ __forceinline__ void operator()(int L, pg8::Unit& u) const { const int hh = L >> 2, kt = L & 3; u.pm = hh & 1; u.pn = hh * 4 + kt; } };

typedef f32x4 AccT[2][2][4][2];
#define EPI_ROWS_BEGIN _Pragma("unroll") for (int ai = 0; ai < 2; ++ai) _Pragma("unroll") for (int m = 0; m < 4; ++m) { const int rt = ai * 128 + wr * 64 + m * 16 + fr;
#define EPI_ROWS_END asm volatile("" ::: "memory"); }

__device__ __forceinline__ void rope8(f32x4& v0, f32x4& v1, const float2* cs) {
#pragma unroll
    for (int j = 0; j < 4; ++j) { const float2 c = cs[j]; const float a = v0[j], b = v1[j]; v0[j] = a * c.x - b * c.y; v1[j] = b * c.x + a * c.y; }
}

struct EpiWin {
    static constexpr bool PERM = true, AFTER_DRAIN = false;
    bf16* CQ; bf16* CKV; bf16* KH; bf16* UP; const float2* rope; float* ssqp;
    __device__ __forceinline__ void operator()(AccT& acc, const pg8::Unit& u, int wr, int wc, int fr, int fq) const { asm volatile("" : "+v"(fr), "+v"(fq));
#pragma unroll
        for (int bj = 0; bj < 2; ++bj) {
            const int s = 8 * u.pn + 4 * bj + wc;
            if (s >= 21 && s < 24) continue;
            const int c0 = 32 * s + 8 * fq;
            EPI_ROWS_BEGIN {
                const int t = u.pm * 256 + rt; f32x4 v0 = acc[ai][bj][m][0], v1 = acc[ai][bj][m][1];
                if (s < 20) {
                    float q = (v0[0] * v0[0] + v0[1] * v0[1]) + (v0[2] * v0[2] + v0[3] * v0[3]) + (v1[0] * v1[0] + v1[1] * v1[1]) + (v1[2] * v1[2] + v1[3] * v1[3]);
                    q += __shfl_xor(q, 16); q += __shfl_xor(q, 32);
                    if (fq == 0) ssqp[(size_t)t * 20 + s] = q;
                    if (s < 12) *(u32x4*)(CQ + (size_t)t * QL + c0) = pack8(v0, v1);
                    else *(u32x4*)(CKV + (size_t)t * KVL + (c0 - 384)) = pack8(v0, v1);
                } else if (s == 20) {
                    rope8(v0, v1, rope + (size_t)t * 16 + 4 * fq);
                    const u32x4 w = pack8(v0, v1); const int b = t >> 13, tl = t & 8191;
#pragma unroll
                    for (int h = 0; h < 8; ++h) *(u32x4*)(KH + ((size_t)(b * 8 + h) * SEQ + tl) * 96 + 64 + 8 * fq) = w;
                } else {
                    const int ch = c0 - 768, g = ch >> 4, h8 = ch & 15, b = t >> 13, tl = t & 8191, chunk = b * 256 + (tl >> 5), j = tl & 31;
                    *(u32x4*)(UP + ((size_t)(g * 512 + chunk) * 640) + j * 16 + h8) = pack8(v0, v1);
                }
            } EPI_ROWS_END
        }
    }
};
struct EpiQ {
    static constexpr bool PERM = true, AFTER_DRAIN = false;
    bf16* QH; const float2* rope; const float* ssqp;
    __device__ __forceinline__ void operator()(AccT& acc, const pg8::Unit& u, int wr, int wc, int fr, int fq) const { asm volatile("" : "+v"(fr), "+v"(fq));
#pragma unroll
        for (int bj = 0; bj < 2; ++bj) {
            const int s = 8 * u.pn + 4 * bj + wc, h = s / 3, sl = s - 3 * h, d0 = sl * 32 + 8 * fq;
            EPI_ROWS_BEGIN {
                const int t = u.pm * 256 + rt; const f32x4 qa = *(const f32x4*)(ssqp + (size_t)t * 20), qb = *(const f32x4*)(ssqp + (size_t)t * 20 + 4), qc = *(const f32x4*)(ssqp + (size_t)t * 20 + 8);
                const float sq = ((qa[0] + qa[1]) + (qa[2] + qa[3])) + ((qb[0] + qb[1]) + (qb[2] + qb[3])) + ((qc[0] + qc[1]) + (qc[2] + qc[3]));
                const float rq = rsqrtf(sq * (1.0f / QL) + RMS_EPS) * C2Q;
                f32x4 v0 = acc[ai][bj][m][0] * rq, v1 = acc[ai][bj][m][1] * rq;
                if (sl == 2) rope8(v0, v1, rope + (size_t)t * 16 + 4 * fq);
                const int b = t >> 13, tl = t & 8191;
                *(u32x4*)(QH + ((size_t)(b * 8 + h) * SEQ + tl) * 96 + d0) = pack8(v0, v1);
            } EPI_ROWS_END
        }
    }
};
struct EpiKV {
    static constexpr bool PERM = true, AFTER_DRAIN = false;
    bf16* KH; bf16* VH; const float* ssqp;
    __device__ __forceinline__ void operator()(AccT& acc, const pg8::Unit& u, int wr, int wc, int fr, int fq) const { asm volatile("" : "+v"(fr), "+v"(fq));
#pragma unroll
        for (int bj = 0; bj < 2; ++bj) {
            const int s = 8 * u.pn + 4 * bj + wc, h = s >> 2, sl = s & 3, j0 = sl * 32 + 8 * fq;
            EPI_ROWS_BEGIN {
                const int t = u.pm * 256 + rt; const f32x4 qa = *(const f32x4*)(ssqp + (size_t)t * 20 + 12), qb = *(const f32x4*)(ssqp + (size_t)t * 20 + 16);
                const float rk = rsqrtf((((qa[0] + qa[1]) + (qa[2] + qa[3])) + ((qb[0] + qb[1]) + (qb[2] + qb[3]))) * (1.0f / KVL) + RMS_EPS);
                const f32x4 v0 = acc[ai][bj][m][0] * rk, v1 = acc[ai][bj][m][1] * rk; const int b = t >> 13, tl = t & 8191;
                if (sl < 2) *(u32x4*)(KH + ((size_t)(b * 8 + h) * SEQ + tl) * 96 + j0) = pack8(v0, v1);
                else *(u32x4*)(VH + ((size_t)(b * 8 + h) * SEQ + tl) * 64 + (j0 - 64)) = pack8(v0, v1);
            } EPI_ROWS_END
        }
    }
};
struct EpiLS {
    static constexpr bool PERM = false, AFTER_DRAIN = false;
    float* LS;
    __device__ __forceinline__ void operator()(AccT& acc, const pg8::Unit& u, int wr, int wc, int fr, int fq) const { asm volatile("" : "+v"(fr), "+v"(fq));
        const int g = u.pn, b = u.pm & 1;
        EPI_ROWS_BEGIN {
            float* rowp = LS + ((size_t)(g * 512 + b * 256 + rt)) * 128 + wc * 32 + 4 * fq;
            *(f32x4*)(rowp) = acc[ai][0][m][0]; *(f32x4*)(rowp + 16) = acc[ai][0][m][1];
        } EPI_ROWS_END
    }
};
struct EpiY {
    static constexpr bool PERM = true, AFTER_DRAIN = false;
    bf16* YS;
    __device__ __forceinline__ void operator()(AccT& acc, const pg8::Unit& u, int wr, int wc, int fr, int fq) const { asm volatile("" : "+v"(fr), "+v"(fq));
        const int g = u.pm >> 1, b = u.pm & 1, nt = u.pn & 1;
#pragma unroll
        for (int bj = 0; bj < 2; ++bj) {
            const int n0 = nt * 256 + bj * 128 + wc * 32 + 8 * fq, i = n0 >> 4, h8 = n0 & 15;
            EPI_ROWS_BEGIN {
                const int t = b * SEQ + rt * 32 + i; f32x4 v0 = acc[ai][bj][m][0], v1 = acc[ai][bj][m][1];
#pragma unroll
                for (int j = 0; j < 4; ++j) { v0[j] = gelu_tanh(v0[j]); v1[j] = gelu_tanh(v1[j]); }
                *(u32x4*)(YS + (size_t)t * 512 + g * 16 + h8) = pack8(v0, v1);
            } EPI_ROWS_END
        }
    }
};
struct EpiGlu {
    static constexpr bool PERM = true, AFTER_DRAIN = false;
    const bf16* YS; bf16* OS; const float* bglu;
    __device__ __forceinline__ void operator()(AccT& acc, const pg8::Unit& u, int wr, int wc, int fr, int fq) const { asm volatile("" : "+v"(fr), "+v"(fq));
#pragma unroll
        for (int bj = 0; bj < 2; ++bj) {
            const int c0 = u.pn * 256 + bj * 128 + wc * 32 + 8 * fq;
            const f32x4 b0 = *(const f32x4*)(bglu + c0), b1 = *(const f32x4*)(bglu + c0 + 4);
            EPI_ROWS_BEGIN {
                const int t = u.pm * 256 + rt; f32x4 y0, y1; unpack8(*(const u32x4*)(YS + (size_t)t * 512 + c0), y0, y1);
                f32x4 z0 = acc[ai][bj][m][0] + b0, z1 = acc[ai][bj][m][1] + b1;
#pragma unroll
                for (int j = 0; j < 4; ++j) { z0[j] = y0[j] * sigmoidf_(z0[j]); z1[j] = y1[j] * sigmoidf_(z1[j]); }
                *(u32x4*)(OS + (size_t)t * 512 + c0) = pack8(z0, z1);
            } EPI_ROWS_END
        }
    }
};
template <int MODE  > struct EpiPre {
    static constexpr bool PERM = false, AFTER_DRAIN = false;
    const float* resf; const bf16* resb; float* PRE;
    __device__ __forceinline__ void operator()(AccT& acc, const pg8::Unit& u, int wr, int wc, int fr, int fq) const { asm volatile("" : "+v"(fr), "+v"(fq));
        const int cb = (u.pn & 3) * 256 + wc * 32 + 4 * fq;
        EPI_ROWS_BEGIN {
            const size_t ro = (size_t)(u.pm * 256 + rt) * DM + cb;
#pragma unroll
            for (int bj = 0; bj < 2; ++bj)
#pragma unroll
                for (int n = 0; n < 2; ++n) { const size_t o = ro + bj * 128 + n * 16; f32x4 r;
                    if (MODE == 0) r = *(const f32x4*)(resf + o);
                    else { const u32x2 w = *(const u32x2*)(resb + o); r = (f32x4){bflo(w.x), bfhi(w.x), bflo(w.y), bfhi(w.y)}; }
                    *(f32x4*)(PRE + o) = r * ALPHA + acc[ai][bj][m][n]; }
        } EPI_ROWS_END
    }
};
struct EpiXS {
    static constexpr bool PERM = true, AFTER_DRAIN = false;
    bf16* P; LAS unsigned char* lds;
    __device__ __forceinline__ void operator()(AccT& acc, const pg8::Unit& u, int wr, int wc, int fr, int fq) const { asm volatile("" : "+v"(fr), "+v"(fq));
        LAS float* exm = (LAS float*)(lds + EXCH_OFF); LAS float* exs = exm + 1024;
        EPI_ROWS_BEGIN {
            float mx = -3.0e38f;
#pragma unroll
            for (int bj = 0; bj < 2; ++bj)
#pragma unroll
                for (int n = 0; n < 2; ++n) { const f32x4 x = acc[ai][bj][m][n]; mx = fmaxf(mx, fmaxf(fmaxf(x[0], x[1]), fmaxf(x[2], x[3]))); }
            mx = fmaxf(mx, __shfl_xor(mx, 16)); mx = fmaxf(mx, __shfl_xor(mx, 32));
            if (fq == 0) exm[rt * 4 + wc] = mx;
        } EPI_ROWS_END
        asm volatile("s_waitcnt lgkmcnt(0)" ::: "memory"); __builtin_amdgcn_s_barrier(); asm volatile("" ::: "memory");
        EPI_ROWS_BEGIN {
            const f32x4 mm = *(const LAS f32x4*)(exm + rt * 4); const float M = fmaxf(fmaxf(mm[0], mm[1]), fmaxf(mm[2], mm[3])); float s = 0.f;
#pragma unroll
            for (int bj = 0; bj < 2; ++bj)
#pragma unroll
                for (int n = 0; n < 2; ++n) { f32x4 x = acc[ai][bj][m][n];
#pragma unroll
                    for (int j = 0; j < 4; ++j) { x[j] = __builtin_amdgcn_exp2f(x[j] - M); s += x[j]; }
                    acc[ai][bj][m][n] = x; }
            s += __shfl_xor(s, 16); s += __shfl_xor(s, 32);
            if (fq == 0) exs[rt * 4 + wc] = s;
        } EPI_ROWS_END
        asm volatile("s_waitcnt lgkmcnt(0)" ::: "memory"); __builtin_amdgcn_s_barrier(); asm volatile("" ::: "memory");
        const int cb = (u.pn & 3) * 256 + wc * 32 + 8 * fq;
        EPI_ROWS_BEGIN {
            const f32x4 ss = *(const LAS f32x4*)(exs + rt * 4); const float inv = __builtin_amdgcn_rcpf((ss[0] + ss[1]) + (ss[2] + ss[3]));
            bf16* rowp = P + (size_t)(u.pm * 256 + rt) * DM + cb;
#pragma unroll
            for (int bj = 0; bj < 2; ++bj) *(u32x4*)(rowp + bj * 128) = pack8(acc[ai][bj][m][0] * inv, acc[ai][bj][m][1] * inv);
        } EPI_ROWS_END
    }
};
struct EpiSC {
    static constexpr bool PERM = false, AFTER_DRAIN = false;
    float* SCLO; float* SCHI;
    __device__ __forceinline__ void operator()(AccT& acc, const pg8::Unit& u, int wr, int wc, int fr, int fq) const { asm volatile("" : "+v"(fr), "+v"(fq));
        float* base = (u.pn < 4 ? SCLO : SCHI) + (u.pn & 3) * 256 + wc * 32 + 4 * fq;
        EPI_ROWS_BEGIN {
            float* rowp = base + (size_t)(u.pm * 256 + rt) * 1024;
#pragma unroll
            for (int bj = 0; bj < 2; ++bj)
#pragma unroll
                for (int n = 0; n < 2; ++n) *(f32x4*)(rowp + bj * 128 + n * 16) = acc[ai][bj][m][n];
        } EPI_ROWS_END
    }
};
struct EpiK2V2 {
    static constexpr bool PERM = true, AFTER_DRAIN = false;
    bf16* O;
    __device__ __forceinline__ void operator()(AccT& acc, const pg8::Unit& u, int wr, int wc, int fr, int fq) const { asm volatile("" : "+v"(fr), "+v"(fq));
        const int b = u.pm, kv = u.pn >> 2, h = u.pn & 3;
        EPI_ROWS_BEGIN {
            bf16* rowp = O + ((size_t)(((kv * 2 + b) * 4 + h) * 256 + rt)) * 256 + wc * 32 + 8 * fq;
#pragma unroll
            for (int bj = 0; bj < 2; ++bj) *(u32x4*)(rowp + bj * 128) = pack8(acc[ai][bj][m][0], acc[ai][bj][m][1]);
        } EPI_ROWS_END
    }
};
struct EpiMb {
    static constexpr bool PERM = true, AFTER_DRAIN = false;
    bf16* O;
    __device__ __forceinline__ void operator()(AccT& acc, const pg8::Unit& u, int wr, int wc, int fr, int fq) const { asm volatile("" : "+v"(fr), "+v"(fq));
        const int b = u.pm >> 2, h = u.pm & 3, kt = u.pn & 3;
        EPI_ROWS_BEGIN {
            bf16* rowp = O + ((size_t)(b * 1024 + h * 256 + rt)) * 1024 + kt * 256 + wc * 32 + 8 * fq;
#pragma unroll
            for (int bj = 0; bj < 2; ++bj) *(u32x4*)(rowp + bj * 128) = pack8(acc[ai][bj][m][0] * XSC, acc[ai][bj][m][1] * XSC);
        } EPI_ROWS_END
    }
};
struct EpiVOT {
    static constexpr bool PERM = true, AFTER_DRAIN = false;
    bf16* O;
    __device__ __forceinline__ void operator()(AccT& acc, const pg8::Unit& u, int wr, int wc, int fr, int fq) const { asm volatile("" : "+v"(fr), "+v"(fq));
        const int h = u.pm >> 2, ct = u.pm & 3, b = u.pn >> 2;
        EPI_ROWS_BEGIN {
            bf16* rowp = O + ((size_t)(b * 1024 + ct * 256 + rt)) * 1024 + h * 256 + wc * 32 + 8 * fq;
#pragma unroll
            for (int bj = 0; bj < 2; ++bj) *(u32x4*)(rowp + bj * 128) = pack8(acc[ai][bj][m][0], acc[ai][bj][m][1]);
        } EPI_ROWS_END
    }
};
struct EpiWsc {
    static constexpr bool PERM = true, AFTER_DRAIN = false;
    bf16* O;
    __device__ __forceinline__ void operator()(AccT& acc, const pg8::Unit& u, int wr, int wc, int fr, int fq) const { asm volatile("" : "+v"(fr), "+v"(fq));
        const int hh = u.pn >> 2, kt = u.pn & 3;
#pragma unroll
        for (int m = 0; m < 4; ++m) { const int key = wr * 64 + m * 16 + fr;
            bf16* rowp = O + ((size_t)(hh * 128 + key)) * 1024 + kt * 256 + wc * 32 + 8 * fq;
#pragma unroll
            for (int bj = 0; bj < 2; ++bj) *(u32x4*)(rowp + bj * 128) = pack8(acc[0][bj][m][0], acc[0][bj][m][1]); }
    }
};
}
namespace att {
typedef unsigned short bf16;
typedef short bf16x8 __attribute__((ext_vector_type(8)));
typedef short s16x4 __attribute__((ext_vector_type(4)));
typedef float f32x16 __attribute__((ext_vector_type(16)));
typedef float f32x4 __attribute__((ext_vector_type(4)));
typedef unsigned u32x4 __attribute__((ext_vector_type(4)));
constexpr int DQ = 96, DV = 64, NW = 8, QBLK = 32, KVBLK = 64, QB = NW * QBLK, SEQ = 8192, OPITCH = 512;
constexpr int SHM_V = 16384, SHM_K = 16384;
constexpr int LDS_BYTES = 2 * SHM_V + 2 * SHM_K + NW * 64 * 4;
constexpr float THR = 8.f;
constexpr unsigned WBIG = 0x7fffffffu;

#define KSWZ(row, colB) ((row) * 256 + ((colB) ^ (((row) & 7) << 4)))
#define SBAR() __builtin_amdgcn_sched_barrier(0)
__device__ __forceinline__ int v_st(int k, int c) { const int kk = (k & ~0xC) | ((k & 4) << 1) | ((k & 8) >> 1); return ((kk >> 3) * 4 + (c >> 5)) * 512 + ((kk & 7) * 32 + (c & 31)) * 2; }
__device__ __forceinline__ int v_rd_base(int lane) { return ((lane & 3) << 3) | (((lane >> 2) & 3) << 6) | (((lane >> 4) & 1) << 5) | (((lane >> 5) & 1) << 8); }
constexpr int v_rd_off(int d0, int ks, int half) { return d0 * 512 + ks * 4096 + half * 2048; }
__device__ __forceinline__ int crow(int r, int hi) { return (r & 3) + 8 * (r >> 2) + 4 * hi; }
__device__ __forceinline__ unsigned cvtpk(float lo, float hi) { unsigned r; asm volatile("v_cvt_pk_bf16_f32 %0, %1, %2" : "=v"(r) : "v"(lo), "v"(hi)); return r; }

__device__ __forceinline__ void mask_tile(f32x16& p0, f32x16& p1, int dq, unsigned W) {
    const float NEG = -__builtin_inff();
#pragma unroll
    for (int r = 0; r < 16; ++r) {
        const int c = (r & 3) + 8 * (r >> 2);
        if ((unsigned)(dq - c) >= W) p0[r] = NEG;
        if ((unsigned)(dq - c - 32) >= W) p1[r] = NEG;
    }
}
__device__ __forceinline__ void partialSM(f32x16& p0, f32x16& p1, float& m_reg, float& mn, float& alpha) {
    float pmax = p0[0];
#pragma unroll
    for (int r = 1; r < 16; ++r) pmax = fmaxf(pmax, p0[r]);
#pragma unroll
    for (int r = 0; r < 16; ++r) pmax = fmaxf(pmax, p1[r]);
    { auto rr = __builtin_amdgcn_permlane32_swap(__float_as_uint(pmax), __float_as_uint(pmax), false, false);
      pmax = fmaxf(__uint_as_float(rr[0]), __uint_as_float(rr[1])); }
    if (__builtin_expect(__all((pmax - m_reg) <= THR), 1)) { mn = m_reg; alpha = 1.f; }
    else { mn = fmaxf(m_reg, pmax); alpha = __builtin_amdgcn_exp2f(m_reg - mn); m_reg = mn; }
#pragma unroll
    for (int r = 0; r < 16; ++r) p0[r] = p0[r] - mn;
#pragma unroll
    for (int r = 0; r < 16; ++r) p1[r] = p1[r] - mn;
#pragma unroll
    for (int r = 0; r < 16; ++r) p0[r] = __builtin_amdgcn_exp2f(p0[r]);
}
__device__ __forceinline__ void finishSM(f32x16& p0, f32x16& p1, float alpha, float& l_reg, bf16x8& pa0, bf16x8& pa1, bf16x8& pa2, bf16x8& pa3) {
#pragma unroll
    for (int r = 0; r < 16; ++r) p1[r] = __builtin_amdgcn_exp2f(p1[r]);
    float ps = 0;
#pragma unroll
    for (int r = 0; r < 16; ++r) ps += p0[r];
#pragma unroll
    for (int r = 0; r < 16; ++r) ps += p1[r];
    { auto rr = __builtin_amdgcn_permlane32_swap(__float_as_uint(ps), __float_as_uint(ps), false, false);
      ps = __uint_as_float(rr[0]) + __uint_as_float(rr[1]); }
    l_reg = l_reg * alpha + ps;
#define PK4(P, B_, OUT) do { unsigned a0 = cvtpk(P[B_+0], P[B_+1]), a1 = cvtpk(P[B_+2], P[B_+3]);                          \
        unsigned b0 = cvtpk(P[B_+4], P[B_+5]), b1 = cvtpk(P[B_+6], P[B_+7]);                                             \
        auto r0 = __builtin_amdgcn_permlane32_swap(a0, b0, false, false); auto r1 = __builtin_amdgcn_permlane32_swap(a1, b1, false, false); \
        u32x4 w = {r0[0], r1[0], r0[1], r1[1]}; OUT = *reinterpret_cast<bf16x8*>(&w); } while (0)
    PK4(p0, 0, pa0); PK4(p0, 8, pa1); PK4(p1, 0, pa2); PK4(p1, 8, pa3);
#undef PK4
}
template <int KB>
__device__ __forceinline__ void qkt(f32x16& p0, f32x16& p1, const char* K_lds, int r32, int hi, const bf16x8* qr) {
    p0 = f32x16{}; p1 = f32x16{};
    const char* kb[4];
#pragma unroll
    for (int dd = 0; dd < 4; ++dd) kb[dd] = K_lds + KB * SHM_K + KSWZ(r32, (dd * 16 + hi * 8) * 2);
#pragma unroll
    for (int d0 = 0; d0 < 6; ++d0) { const char* a = kb[d0 & 3] + (d0 >> 2) * 128;
        bf16x8 b0 = *reinterpret_cast<const bf16x8*>(a);
        bf16x8 b1 = *reinterpret_cast<const bf16x8*>(a + 32 * 256);
        p0 = __builtin_amdgcn_mfma_f32_32x32x16_bf16(b0, qr[d0], p0, 0, 0, 0);
        p1 = __builtin_amdgcn_mfma_f32_32x32x16_bf16(b1, qr[d0], p1, 0, 0, 0); }
}
template <int VB>
__device__ __forceinline__ void pv_tile(f32x16* o, int vb0, bf16x8 pa0, bf16x8 pa1, bf16x8 pa2, bf16x8 pa3) {
#define TRRD(dst, off) asm volatile("ds_read_b64_tr_b16 %0, %1 offset:%2" : "=&v"(dst) : "v"(vb0), "i"(off) : "memory")
#define PV_D0(d0) do { s16x4 l0, l1, l2, l3, h0, h1, h2, h3; constexpr int b_ = VB * SHM_V + v_rd_off(d0, 0, 0); \
        TRRD(l0, b_); TRRD(h0, b_ + 2048); TRRD(l1, b_ + 4096); TRRD(h1, b_ + 6144); TRRD(l2, b_ + 8192); TRRD(h2, b_ + 10240); TRRD(l3, b_ + 12288); TRRD(h3, b_ + 14336); \
        asm volatile("s_waitcnt lgkmcnt(0)" ::: "memory"); SBAR(); \
        o[d0] = __builtin_amdgcn_mfma_f32_32x32x16_bf16(pa0, (bf16x8){l0[0], l0[1], l0[2], l0[3], h0[0], h0[1], h0[2], h0[3]}, o[d0], 0, 0, 0);   \
        o[d0] = __builtin_amdgcn_mfma_f32_32x32x16_bf16(pa1, (bf16x8){l1[0], l1[1], l1[2], l1[3], h1[0], h1[1], h1[2], h1[3]}, o[d0], 0, 0, 0);   \
        o[d0] = __builtin_amdgcn_mfma_f32_32x32x16_bf16(pa2, (bf16x8){l2[0], l2[1], l2[2], l2[3], h2[0], h2[1], h2[2], h2[3]}, o[d0], 0, 0, 0);   \
        o[d0] = __builtin_amdgcn_mfma_f32_32x32x16_bf16(pa3, (bf16x8){l3[0], l3[1], l3[2], l3[3], h3[0], h3[1], h3[2], h3[3]}, o[d0], 0, 0, 0); } while (0)
    PV_D0(0); PV_D0(1);
#undef PV_D0
#undef TRRD
}

struct BlockRef { const bf16* Q; const bf16* K; const bf16* V; bf16* O; int P0; };
struct Seam { bf16x8 qr[6]; bf16x8 st_v0, st_k0, st_k1; };
#define KROW(p, k0, rr) ((p) + (size_t)((k0) + (rr)) * DQ + scl)
#define VROW(p, k0) ((p) + (size_t)((k0) + vr) * DV + vc)
#define VMW() asm volatile("s_waitcnt vmcnt(0)" ::: "memory")
#define VMWN(n) asm volatile("s_waitcnt vmcnt(%0)" :: "i"(n) : "memory")
#define SLOAD_H(Kp, Vp, k0) do { S.st_v0 = *reinterpret_cast<const bf16x8*>(VROW(Vp, k0)); \
                         S.st_k0 = *reinterpret_cast<const bf16x8*>(KROW(Kp, k0, sr)); S.st_k1 = *reinterpret_cast<const bf16x8*>(KROW(Kp, k0, 32 + sr)); } while (0)
#define SWRITE_HK(bf) do { *(bf16x8*)(K_lds + (bf) * SHM_K + kws) = S.st_k0; *(bf16x8*)(K_lds + (bf) * SHM_K + kws + 32 * 256) = S.st_k1; } while (0)
#define SWRITE_HV(bf) do { *(bf16x8*)(V_lds + (bf) * SHM_V + vst0) = S.st_v0; } while (0)
#define SWRITE_H(bf) do { SWRITE_HV(bf); SWRITE_HK(bf); } while (0)
__device__ __forceinline__ void attn_prime(const BlockRef& cur, char* lds, Seam& S) {
    int tid_ = threadIdx.x; asm volatile("" : "+v"(tid_)); const int tid = tid_, wid = __builtin_amdgcn_readfirstlane(tid >> 6), lane = tid & 63, r32 = lane & 31, hi = lane >> 5;
    const int sr = tid >> 4, sc = (tid & 15) * 8, scl = sc < DQ ? sc : DQ - 8, kws = KSWZ(sr, sc * 2), vr = tid >> 3, vc = (tid & 7) * 8; char* K_lds = lds + 2 * SHM_V;
#pragma unroll
    for (int d0 = 0; d0 < 6; ++d0) S.qr[d0] = *reinterpret_cast<const bf16x8*>(cur.Q + (size_t)(wid * QBLK + r32) * DQ + d0 * 16 + hi * 8);
    SLOAD_H(cur.K, cur.V, 0); VMW(); SWRITE_HK(0);
    __syncthreads();
}
__device__ __forceinline__ void attn_block(const BlockRef& cur, const BlockRef& nxt, char* lds, Seam& S) {
    int tid_ = threadIdx.x; asm volatile("" : "+v"(tid_)); const int tid = tid_, wid = __builtin_amdgcn_readfirstlane(tid >> 6), lane = tid & 63, r32 = lane & 31, hi = lane >> 5;
    const int NT = (cur.P0 + QB - 1) / KVBLK + 1;
    const int qlo = cur.P0 + wid * QBLK, qm = qlo + r32 - 4 * hi;
    char* V_lds = lds; char* K_lds = lds + 2 * SHM_V;
    float* ws = (float*)(lds + 2 * SHM_V + 2 * SHM_K) + wid * 64; float* li_l = ws, * al_l = ws + 32;
    float m_reg = -1e30f, l_reg = 0; f32x16 o[2] = {};
    const int sr = tid >> 4, sc = (tid & 15) * 8, scl = sc < DQ ? sc : DQ - 8, kws = KSWZ(sr, sc * 2), vr = tid >> 3, vc = (tid & 7) * 8, vst0 = v_st(vr, vc);
    const int vb0 = (int)(uintptr_t)V_lds + v_rd_base(lane);
    const bf16* Kh = cur.K; const bf16* Vh = cur.V;
#define RESC(a) do { if (__any((a) < 1.f)) { if (hi == 0) al_l[r32] = (a); asm volatile("s_waitcnt lgkmcnt(0)" ::: "memory");              \
                     _Pragma("unroll") for (int d_ = 0; d_ < 2; ++d_) _Pragma("unroll") for (int r = 0; r < 16; ++r) o[d_][r] *= al_l[crow(r, hi)]; } } while (0)
#define KBASE(t) ((t) * KVBLK)
#define MASKT(P0_, P1_, t) do { const int kb_ = KBASE(t); if (kb_ + KVBLK - 1 > qlo) mask_tile(P0_, P1_, qm - kb_, WBIG); } while (0)
    constexpr int NQL = 6;
#define SEAM_K0() do { VMWN(NQL); SWRITE_HK(0); SBAR(); } while (0)
    f32x16 pA0, pA1, pB0, pB1; float mnA, mnB, alA, alB; bf16x8 pa0, pa1, pa2, pa3;
    SWRITE_HV(0); SBAR();
    SLOAD_H(Kh, Vh, KBASE(1));
    SBAR(); qkt<0>(pA0, pA1, K_lds, r32, hi, S.qr);
    MASKT(pA0, pA1, 0); partialSM(pA0, pA1, m_reg, mnA, alA);
    VMW(); SWRITE_H(1);
    __syncthreads();
#define HALF_STEP(PX0, PX1, mnX, alX, PY0, PY1, alY, t, KB, VB, SB) do {                                                      \
        SBAR(); qkt<KB>(PX0, PX1, K_lds, r32, hi, S.qr);                                                                      \
        finishSM(PY0, PY1, alY, l_reg, pa0, pa1, pa2, pa3); SBAR();                                                           \
        if ((t) + 1 < NT) { SLOAD_H(Kh, Vh, KBASE((t) + 1)); SBAR(); }                                                        \
        pv_tile<VB>(o, vb0, pa0, pa1, pa2, pa3); MASKT(PX0, PX1, (t)); partialSM(PX0, PX1, m_reg, mnX, alX);                  \
        __syncthreads();                                                                                                      \
        if ((t) + 1 < NT) { VMW(); SWRITE_H(SB); }                                                                            \
        RESC(alX); __syncthreads(); } while (0)
    for (int t = 1; t + 1 < NT; t += 2) {
        HALF_STEP(pB0, pB1, mnB, alB, pA0, pA1, alA, t, 1, 0, 0);
        HALF_STEP(pA0, pA1, mnA, alA, pB0, pB1, alB, t + 1, 0, 1, 1);
    }
    SBAR(); qkt<1>(pB0, pB1, K_lds, r32, hi, S.qr); SBAR();
    SLOAD_H(nxt.K, nxt.V, 0); SBAR();
#pragma unroll
    for (int d0 = 0; d0 < 6; ++d0) S.qr[d0] = *reinterpret_cast<const bf16x8*>(nxt.Q + (size_t)(wid * QBLK + r32) * DQ + d0 * 16 + hi * 8);
    SBAR();
    finishSM(pA0, pA1, alA, l_reg, pa0, pa1, pa2, pa3); SBAR();
    pv_tile<0>(o, vb0, pa0, pa1, pa2, pa3);
    MASKT(pB0, pB1, NT - 1); partialSM(pB0, pB1, m_reg, mnB, alB); __syncthreads(); RESC(alB);
    finishSM(pB0, pB1, alB, l_reg, pa0, pa1, pa2, pa3); SBAR(); pv_tile<1>(o, vb0, pa0, pa1, pa2, pa3);
    SBAR(); SEAM_K0();
    if (hi == 0) li_l[r32] = l_reg; asm volatile("s_waitcnt lgkmcnt(0)" ::: "memory");
    float rli[16];
#pragma unroll
    for (int r = 0; r < 16; ++r) rli[r] = __builtin_amdgcn_rcpf(li_l[crow(r, hi)]);
    bf16* Ow = cur.O + (size_t)(wid * QBLK) * OPITCH;
#pragma unroll
    for (int r = 0; r < 16; ++r) { const int orow = crow(r, hi);
#pragma unroll
        for (int d0 = 0; d0 < 2; ++d0) { const float v = o[d0][r] * rli[r]; const float vn = __shfl_xor(v, 1);
            if ((r32 & 1) == 0) *(unsigned*)(Ow + (size_t)orow * OPITCH + d0 * 32 + r32) = cvtpk(v, vn); } }
    __syncthreads();
#undef RESC
#undef KBASE
#undef MASKT
#undef SEAM_K0
#undef HALF_STEP
}
#undef KROW
#undef VROW
#undef VMW
#undef VMWN
#undef SLOAD_H
#undef SWRITE_HK
#undef SWRITE_HV
#undef SWRITE_H
#undef KSWZ
#undef SBAR
}
using namespace mk;
typedef __attribute__((address_space(1))) unsigned gu32;
#define RLX_AGENT __ATOMIC_RELAXED, __HIP_MEMORY_SCOPE_AGENT
#define LDS_WAIT() asm volatile("s_waitcnt lgkmcnt(0)" ::: "memory")
#define VM_WAIT() asm volatile("s_waitcnt vmcnt(0)" ::: "memory")
constexpr int NWAVES = 8, NPH = 16;

#define XB_TMO      128
#define XB_XCNT(j)  (256  + 64 * (j))
#define XB_XSUB(j)  (1280 + 64 * (j))
#define XB_XGEN(j)  (2304 + 64 * (j))
#define XB_TOP      3328
#define XB_TOPGEN   3392
#define XCD_BAR_WORDS 3456
#define XB_SPIN_CAP (1u << 18)

__device__ __forceinline__ unsigned xb_ld(unsigned* p)              { return __hip_atomic_load(p, __ATOMIC_RELAXED, __HIP_MEMORY_SCOPE_AGENT); }
__device__ __forceinline__ unsigned xb_add(unsigned* p, unsigned v) { return __hip_atomic_fetch_add(p, v, __ATOMIC_RELAXED, __HIP_MEMORY_SCOPE_AGENT); }
__device__ __forceinline__ unsigned xb_xcc_id() { return (unsigned)__builtin_amdgcn_s_getreg((3 << 11) | 20) & 0xFu; }
#define XB_SPIN(cond, bar) do { unsigned _sp = 0; while (cond) { __builtin_amdgcn_s_sleep(1); \
    if ((++_sp & 255u) == 0u) { if (xb_ld(&(bar)[XB_TMO])) break; if (_sp > XB_SPIN_CAP) { atomicAdd(&(bar)[XB_TMO], 1u); break; } } } } while (0)

struct XcdBarrier {
    unsigned* bar; unsigned x;
    volatile LAS unsigned* st;
};

__device__ __forceinline__ XcdBarrier xcd_barrier_post(unsigned* bar, volatile LAS unsigned* st) {
    XcdBarrier b; b.bar = bar; b.x = xb_xcc_id(); b.st = st;
    if (threadIdx.x == 0) (void)xb_add(&bar[XB_XCNT(b.x)], 1u);
    return b;
}
__device__ __forceinline__ void xcd_barrier_complete(unsigned* bar, unsigned x, unsigned& nloc, unsigned& nx) {
    const unsigned G = gridDim.x * gridDim.y * gridDim.z;
    unsigned sum, cnt, mine, sp = 0u;
    for (;;) {
        sum = 0u; cnt = 0u; mine = 0u;
#pragma unroll
        for (unsigned j = 0; j < 16; ++j) { const unsigned c = xb_ld(&bar[XB_XCNT(j)]); sum += c; cnt += (c > 0u) ? 1u : 0u; mine = (j == x) ? c : mine; }
        if (sum == G) break;
        __builtin_amdgcn_s_sleep(1);
        if ((++sp & 255u) == 0u) { if (xb_ld(&bar[XB_TMO])) break; if (sp > XB_SPIN_CAP) { atomicAdd(&bar[XB_TMO], 1u); break; } }
    }
    nloc = mine > 0u ? mine : 1u; nx = cnt > 0u ? cnt : 1u;
}

__device__ __forceinline__ void xcd_barrier(const XcdBarrier& b) {
    asm volatile("s_waitcnt vmcnt(0)" ::: "memory");
    __syncthreads();
    if (threadIdx.x == 0) {
        unsigned* bar = b.bar;
        __builtin_amdgcn_s_waitcnt(0);
        unsigned nloc = b.st[0], nx = b.st[1];
        if (nloc == 0u) { xcd_barrier_complete(bar, b.x, nloc, nx); b.st[0] = nloc; b.st[1] = nx; }
        const unsigned old = xb_add(&bar[XB_XSUB(b.x)], 1u);
        const unsigned gen = old / nloc;
        if (old + 1u == (gen + 1u) * nloc) {
            __builtin_amdgcn_fence(__ATOMIC_RELEASE, "agent");
            asm volatile("s_waitcnt vmcnt(0)" ::: "memory");
            const unsigned og = xb_add(&bar[XB_TOP], 1u);
            const unsigned tg = og / nx;
            if (og + 1u == (tg + 1u) * nx) xb_add(&bar[XB_TOPGEN], 1u);
            else XB_SPIN(xb_ld(&bar[XB_TOPGEN]) == tg, bar);
            __builtin_amdgcn_fence(__ATOMIC_ACQUIRE, "agent");
            xb_add(&bar[XB_XGEN(b.x)], 1u);
            asm volatile("s_waitcnt vmcnt(0)" ::: "memory");
        } else {
            XB_SPIN(xb_ld(&bar[XB_XGEN(b.x)]) == gen, bar);
            __builtin_amdgcn_fence(__ATOMIC_ACQUIRE, "agent");
            asm volatile("s_waitcnt vmcnt(0)" ::: "memory");
        }
    }
    __syncthreads();
}


struct Args { const void* in[36]; float* out; unsigned char* ws; int ph_lo, ph_hi; };
typedef const __attribute__((address_space(4))) Args* KArgs;
__device__ __forceinline__ KArgs kargs() { KArgs p = (KArgs)__builtin_amdgcn_kernarg_segment_ptr(); asm volatile("" : "+s"(p)); return p; }
struct Frame {
    LAS unsigned char* lds; unsigned char* ws; unsigned char* ob;
    unsigned* ctl; int tid, lane, wave, vcu, G, gw, ngw;
    __device__ __forceinline__ void refresh() { int t = threadIdx.x; asm volatile("" : "+v"(t)); tid = t; lane = t & 63; wave = __builtin_amdgcn_readfirstlane(t >> 6); gw = vcu * 8 + wave; }
};

__device__ __forceinline__ float wave_sum(float v) {
#pragma unroll
    for (int o = 1; o < 64; o <<= 1) v += __shfl_xor(v, o);
    return v;
}
__device__ __forceinline__ unsigned pk2(float lo, float hi) { return cvtpk(lo, hi); }

__device__ __forceinline__ int ropeperm(int n) { const int b = n >> 3, j = n & 7; return j < 4 ? 4 * b + j : 16 + 4 * b + (j - 4); }
__device__ __forceinline__ void tr_item(const float* W, int ldw, int k0, int scol0, bf16* WT, int ldt, int drow0, const float* kscale, bool perm, LAS float* scr, int lane) {
#pragma unroll 8
    for (int i = 0; i < 32; ++i) { const int kk = 2 * i + (lane >> 5); const float sc = kscale ? kscale[k0 + kk] : 1.0f;
        scr[kk * 33 + (lane & 31)] = W[(size_t)(k0 + kk) * ldw + scol0 + (lane & 31)] * sc; }
    LDS_WAIT(); asm volatile("" ::: "memory");
    const int c = lane & 7;
#pragma unroll
    for (int j = 0; j < 4; ++j) { const int n = (lane >> 3) + 8 * j, ns = perm ? ropeperm(n) : n; const LAS float* s = scr + (8 * c) * 33 + ns;
        u32x4 o; o.x = pk2(s[0 * 33], s[1 * 33]); o.y = pk2(s[2 * 33], s[3 * 33]); o.z = pk2(s[4 * 33], s[5 * 33]); o.w = pk2(s[6 * 33], s[7 * 33]);
        *(u32x4*)(WT + (size_t)(drow0 + n) * ldt + k0 + 8 * c) = o; }
    LDS_WAIT(); asm volatile("" ::: "memory");
}
__device__ __forceinline__ void ssm_precompute(const Frame& F, KArgs A, int g) {
    const float* lam_re = (const float*)A->in[8] + g * 64; const float* lam_im = (const float*)A->in[9] + g * 64; const float dt = expf(((const float*)A->in[10])[g]);
    const float* b_re = (const float*)A->in[11] + g * 1024; const float* b_im = (const float*)A->in[12] + g * 1024;
    const float* c_re = (const float*)A->in[13] + g * 1024; const float* c_im = (const float*)A->in[14] + g * 1024;
    const float* dsk = (const float*)A->in[15] + g * 16;
    LAS float* apr = (LAS float*)F.lds; LAS float* api = apr + 33 * 64; LAS float* bbr = api + 33 * 64; LAS float* bbi = bbr + 1024;
    LAS float* crs = bbi + 1024; LAS float* cis = crs + 1024; LAS float* Kt = cis + 1024;
    const int tid = F.tid;
    for (int e = tid; e < 33 * 64; e += 512) { const int m = e >> 6, p = e & 63; const float lr = lam_re[p], li = lam_im[p];
        const float mag = expf(lr * dt * (float)m); float sn, cs; sincosf(li * dt * (float)m, &sn, &cs); apr[e] = mag * cs; api[e] = mag * sn; }
    for (int e = tid; e < 1024; e += 512) { crs[e] = c_re[e]; cis[e] = c_im[e]; }
    __syncthreads();
    for (int e = tid; e < 1024; e += 512) { const int p = e >> 4; const float lr = lam_re[p], li = lam_im[p], den = lr * lr + li * li;
        const float nr = apr[64 + p] - 1.0f, ni = api[64 + p]; const float fr_ = (nr * lr + ni * li) / den, fi_ = (ni * lr - nr * li) / den;
        const float br = b_re[e], bi = b_im[e]; bbr[e] = fr_ * br - fi_ * bi; bbi[e] = fr_ * bi + fi_ * br; }
    __syncthreads();
    for (int e = tid; e < 8192; e += 512) { const int m = e >> 8, h = (e >> 4) & 15, hp = e & 15; float s = 0.f;
        for (int p = 0; p < 64; ++p) { const float cr = crs[h * 64 + p], ci = cis[h * 64 + p], ar = apr[m * 64 + p], ai = api[m * 64 + p];
            const float er = cr * ar - ci * ai, ei = cr * ai + ci * ar; s += er * bbr[p * 16 + hp] - ei * bbi[p * 16 + hp]; }
        if (m == 0 && h == hp) s += dsk[h];
        Kt[e] = s; }
    __syncthreads();
    bf16* TH = (bf16*)(F.ws + W_TH) + (size_t)g * 512 * 640; bf16* GM = (bf16*)(F.ws + W_GM) + (size_t)g * 256 * 640;
    for (int e = tid; e < 512 * 64; e += 512) { const int n = e >> 6, cg = e & 63, i = n >> 4, h = n & 15, j = cg >> 1, h0 = (cg & 1) * 8; u32x4 o = {0u, 0u, 0u, 0u};
        if (j <= i) { const LAS float* k = Kt + (i - j) * 256 + h * 16 + h0; o.x = pk2(k[0], k[1]); o.y = pk2(k[2], k[3]); o.z = pk2(k[4], k[5]); o.w = pk2(k[6], k[7]); }
        *(u32x4*)(TH + (size_t)n * 640 + cg * 8) = o; }
    for (int e = tid; e < 512 * 16; e += 512) { const int n = e >> 4, cg = e & 15, i = n >> 4, h = n & 15; float v[8];
#pragma unroll
        for (int q = 0; q < 8; ++q) { const int sidx = cg * 8 + q, p = sidx & 63; const float cr = crs[h * 64 + p], ci = cis[h * 64 + p], ar = apr[(i + 1) * 64 + p], ai = api[(i + 1) * 64 + p];
            v[q] = sidx < 64 ? (cr * ar - ci * ai) : -(cr * ai + ci * ar); }
        u32x4 o; o.x = pk2(v[0], v[1]); o.y = pk2(v[2], v[3]); o.z = pk2(v[4], v[5]); o.w = pk2(v[6], v[7]);
        *(u32x4*)(TH + (size_t)n * 640 + 512 + cg * 8) = o; }
    for (int e = tid; e < 256 * 80; e += 512) { const int n = e / 80, cg = e - n * 80; u32x4 o = {0u, 0u, 0u, 0u};
        if (n < 128 && cg < 64) { const int p = n & 63, im = n >> 6, j = cg >> 1, h0 = (cg & 1) * 8; const float ar = apr[(31 - j) * 64 + p], ai = api[(31 - j) * 64 + p]; float v[8];
#pragma unroll
            for (int q = 0; q < 8; ++q) { const float br = bbr[p * 16 + h0 + q], bi = bbi[p * 16 + h0 + q]; v[q] = im ? (ar * bi + ai * br) : (ar * br - ai * bi); }
            o.x = pk2(v[0], v[1]); o.y = pk2(v[2], v[3]); o.z = pk2(v[4], v[5]); o.w = pk2(v[6], v[7]); }
        *(u32x4*)(GM + (size_t)n * 640 + cg * 8) = o; }
    __syncthreads();
}
__device__ __forceinline__ void cvt_row1024(const float* src, bf16* dst, int lane) {
#pragma unroll
    for (int j = 0; j < 4; ++j) { const f32x4 v = *(const f32x4*)(src + (j * 64 + lane) * 4); u32x2 o; o.x = pk2(v[0], v[1]); o.y = pk2(v[2], v[3]); *(u32x2*)(dst + (j * 64 + lane) * 4) = o; }
}
__device__ __forceinline__ void p0_prologue(const Frame& F, KArgs A) {
    for (int g = blockIdx.x; g < 32; g += F.G) ssm_precompute(F, A, g);
    LAS float* scr = (LAS float*)(F.lds + F.wave * 16384);
    const int lane = F.lane;
    const float* x = (const float*)A->in[0]; const float* mem = (const float*)A->in[1]; const int* pos = (const int*)A->in[2];
    const float* w_in = (const float*)A->in[3]; const float* g_cq = (const float*)A->in[4]; const float* w_uq = (const float*)A->in[5]; const float* g_ckv = (const float*)A->in[6];
    const float* w_ukv = (const float*)A->in[7]; const float* w_glu = (const float*)A->in[16]; const float* g_mla = (const float*)A->in[18]; const float* g_ssm = (const float*)A->in[19];
    const float* w_out = (const float*)A->in[20]; const float* xq = (const float*)A->in[23]; const float* xk = (const float*)A->in[24]; const float* xv = (const float*)A->in[25];
    const float* xo = (const float*)A->in[26]; const float* w_query = (const float*)A->in[29]; const float* sk1 = (const float*)A->in[30]; const float* sk2 = (const float*)A->in[31];
    bf16* WINT = (bf16*)(F.ws + W_WINT); bf16* WUQT = (bf16*)(F.ws + W_WUQT); bf16* WUKVT = (bf16*)(F.ws + W_WUKVT); bf16* WGLUT = (bf16*)(F.ws + W_WGLUT); bf16* WOUTT = (bf16*)(F.ws + W_WOUTT);
    bf16* XKVT = (bf16*)(F.ws + W_XKVT); bf16* XQH = (bf16*)(F.ws + W_XQH); bf16* XOTH = (bf16*)(F.ws + W_XOTH); bf16* WQR = (bf16*)(F.ws + W_WQR); bf16* SKP = (bf16*)(F.ws + W_SKP);
    bf16* MEMB = (bf16*)(F.ws + W_MEMB); float2* ROPE = (float2*)(F.ws + W_ROPE); bf16* XB = (bf16*)(F.ob + O_XB); bf16* UP = (bf16*)(F.ws + A_UP);
    constexpr int I0 = 37 * 16, I1 = 24 * 6, I2 = 32 * 4, I3 = 16 * 8, I4 = 32 * 16, I5 = 32 * 16, I6 = 32 * 16, I7 = 4 * 32 * 4;
    constexpr int I8 = 16384, I9 = 512, I10 = 1024, I11 = 1024, I12 = 512, I13 = 4096, I14 = 4096, I15 = 96;
    constexpr int NIT = I0 + I1 + I2 + I3 + I4 + I5 + I6 + I7 + I8 + I9 + I10 + I11 + I12 + I13 + I14 + I15;
    for (int it = F.gw; it < NIT; it += F.ngw) {
        int r = it;
        if (r < I0) { const int nb = r >> 4, kb = r & 15; tr_item(w_in, 1184, kb * 64, nb * 32, WINT, 1024, nb * 32 + (nb >= 21 ? 96 : 0), nullptr, nb == 20, scr, lane); continue; } r -= I0;
        if (r < I1) { const int nb = r / 6, kb = r - nb * 6; tr_item(w_uq, 768, kb * 64, nb * 32, WUQT, 384, nb * 32, g_cq, (nb % 3) == 2, scr, lane); continue; } r -= I1;
        if (r < I2) { const int nb = r >> 2, kb = r & 3; tr_item(w_ukv, 1024, kb * 64, nb * 32, WUKVT, 256, nb * 32, g_ckv, false, scr, lane); continue; } r -= I2;
        if (r < I3) { const int nb = r >> 3, kb = r & 7; tr_item(w_glu, 512, kb * 64, nb * 32, WGLUT, 512, nb * 32, nullptr, false, scr, lane); continue; } r -= I3;
        if (r < I4) { const int nb = r >> 4, kb = r & 15; tr_item(w_out, 1024, kb * 64, nb * 32, WOUTT, 1024, nb * 32, kb < 8 ? g_mla : g_ssm - 512, false, scr, lane); continue; } r -= I4;
        if (r < I5) { const int nb = r >> 4, kb = r & 15; tr_item(xk, 1024, kb * 64, nb * 32, XKVT, 1024, nb * 32, nullptr, false, scr, lane); continue; } r -= I5;
        if (r < I6) { const int nb = r >> 4, kb = r & 15; tr_item(xv, 1024, kb * 64, nb * 32, XKVT, 1024, 1024 + nb * 32, nullptr, false, scr, lane); continue; } r -= I6;
        if (r < I7) { const int h = r >> 7, nb = (r >> 2) & 31, kb = r & 3; tr_item(xo + (size_t)h * 256 * 1024, 1024, kb * 64, nb * 32, XOTH + (size_t)h * 1024 * 256, 256, nb * 32, nullptr, false, scr, lane); continue; } r -= I7;
        if (r < I8) { cvt_row1024(x + (size_t)r * 1024, XB + (size_t)r * 1024, lane); continue; } r -= I8;
        if (r < I9) { cvt_row1024(mem + (size_t)r * 1024, MEMB + (size_t)r * 1024, lane); continue; } r -= I9;
        if (r < I10) {
#pragma unroll
            for (int j = 0; j < 4; ++j) { const int e = (j * 64 + lane) * 4, h = e >> 8, jj = e & 255; const f32x4 v = *(const f32x4*)(xq + (size_t)r * 1024 + e);
                u32x2 o; o.x = pk2(v[0], v[1]); o.y = pk2(v[2], v[3]); *(u32x2*)(XQH + ((size_t)h * 1024 + r) * 256 + jj) = o; }
            continue; } r -= I10;
        if (r < I11) {
#pragma unroll
            for (int j = 0; j < 8; ++j) { const int e = (j * 64 + lane) * 4, hh = e >> 7, d = e & 127; const f32x4 v = *(const f32x4*)(w_query + (size_t)r * 2048 + e);
                u32x2 o; o.x = pk2(v[0], v[1]); o.y = pk2(v[2], v[3]); bf16* dp = WQR + ((size_t)hh * 1024 + r) * 256 + d; *(u32x2*)dp = o; *(u32x2*)(dp + 128) = (u32x2){0u, 0u}; }
            continue; } r -= I11;
        if (r < I12) { const int half = r >> 8, key = r & 255, d = lane * 4; u32x2 o = {0u, 0u};
            if (key < 128 && d < 128) { const f32x4 v = *(const f32x4*)((half ? sk2 : sk1) + key * 128 + d); o.x = pk2(v[0], v[1]); o.y = pk2(v[2], v[3]); }
            *(u32x2*)(SKP + ((size_t)half * 256 + key) * 256 + d) = o; continue; } r -= I12;
        if (r < I13) { const int t = r * 4 + (lane >> 4), i = lane & 15; const float fq_ = exp2f(-(float)i * (13.287712379549449f / 16.0f));
            const float ang = (float)pos[t] * fq_; float sn, cs; sincosf(ang, &sn, &cs); ROPE[(size_t)t * 16 + i] = make_float2(cs, sn); continue; } r -= I13;
        if (r < I14) { const int row = r * 4 + (lane >> 4); *(u32x4*)(UP + (size_t)row * 640 + 512 + (lane & 15) * 8) = (u32x4){0u, 0u, 0u, 0u}; continue; } r -= I14;
        { const int row = 672 + r; *(u32x4*)(WINT + (size_t)row * 1024 + lane * 16) = (u32x4){0u, 0u, 0u, 0u}; *(u32x4*)(WINT + (size_t)row * 1024 + lane * 16 + 8) = (u32x4){0u, 0u, 0u, 0u}; }
    }
}
__device__ __forceinline__ void p3_scan(const Frame& F, KArgs A) {
    if (F.wave != 0) return;
    for (int task = blockIdx.x; task < 64; task += F.G) {
        const int g = task >> 1, b = task & 1, p = F.lane;
        const float lr = ((const float*)A->in[8])[g * 64 + p], li = ((const float*)A->in[9])[g * 64 + p], dt = expf(((const float*)A->in[10])[g]);
        const float mag = expf(lr * dt * 32.f); float sn, cs; sincosf(li * dt * 32.f, &sn, &cs); const float ar = mag * cs, ai = mag * sn;
        const float* LS = (const float*)(F.ws + A_LS) + (size_t)(g * 512 + b * 256) * 128; bf16* UP = (bf16*)(F.ws + A_UP) + (size_t)(g * 512 + b * 256) * 640 + 512;
        float sr = 0.f, si = 0.f;
#pragma unroll 8
        for (int c = 0; c < 256; ++c) {
            UP[(size_t)c * 640 + p] = (bf16)(cvtpk(sr, 0.f) & 0xffffu); UP[(size_t)c * 640 + 64 + p] = (bf16)(cvtpk(si, 0.f) & 0xffffu);
            const float l0 = LS[c * 128 + p], l1 = LS[c * 128 + 64 + p];
            const float nr = ar * sr - ai * si + l0, ni = ar * si + ai * sr + l1; sr = nr; si = ni;
        }
    }
}
__device__ __forceinline__ void p6_rmsnorm(const Frame& F) {
    const bf16* OA = (const bf16*)(F.ws + A_OA); const bf16* OS = (const bf16*)(F.ob + O_OS); bf16* MIXN = (bf16*)(F.ws + A_MIXN);
    for (int t = F.gw; t < NTOK; t += F.ngw) {
        f32x4 a0, a1, s0, s1; unpack8(*(const u32x4*)(OA + (size_t)t * 512 + F.lane * 8), a0, a1); unpack8(*(const u32x4*)(OS + (size_t)t * 512 + F.lane * 8), s0, s1);
        float qa = 0.f, qs = 0.f;
#pragma unroll
        for (int j = 0; j < 4; ++j) { qa += a0[j] * a0[j] + a1[j] * a1[j]; qs += s0[j] * s0[j] + s1[j] * s1[j]; }
        const float ra = rsqrtf(wave_sum(qa) * (1.f / 512.f) + RMS_EPS), rs = rsqrtf(wave_sum(qs) * (1.f / 512.f) + RMS_EPS);
        *(u32x4*)(MIXN + (size_t)t * 1024 + F.lane * 8) = pack8(a0 * ra, a1 * ra); *(u32x4*)(MIXN + (size_t)t * 1024 + 512 + F.lane * 8) = pack8(s0 * rs, s1 * rs);
    }
}
__device__ __forceinline__ void ln_rows(const Frame& F, const float* PRE, const float* gam, const float* bet, bf16* X) {
    for (int t = F.gw; t < NTOK; t += F.ngw) {
        f32x4 v[4]; float s = 0.f;
#pragma unroll
        for (int j = 0; j < 4; ++j) { v[j] = *(const f32x4*)(PRE + (size_t)t * 1024 + (j * 64 + F.lane) * 4); s += (v[j][0] + v[j][1]) + (v[j][2] + v[j][3]); }
        const float mean = wave_sum(s) * (1.f / 1024.f); float q = 0.f;
#pragma unroll
        for (int j = 0; j < 4; ++j) { v[j] = v[j] - mean; q += (v[j][0] * v[j][0] + v[j][1] * v[j][1]) + (v[j][2] * v[j][2] + v[j][3] * v[j][3]); }
        const float rstd = rsqrtf(wave_sum(q) * (1.f / 1024.f) + LN_EPS);
#pragma unroll
        for (int j = 0; j < 4; ++j) { const int c = (j * 64 + F.lane) * 4; const f32x4 gg = *(const f32x4*)(gam + c), bb = *(const f32x4*)(bet + c); const f32x4 o = v[j] * rstd * gg + bb;
            u32x2 w; w.x = pk2(o[0], o[1]); w.y = pk2(o[2], o[3]); *(u32x2*)(X + (size_t)t * 1024 + c) = w; }
    }
}
__device__ const unsigned char PAIRTAB[64] = {0x00,0x01,0x02,0x03,0x04,0x05,0x06,0x07,0x08,0x09,0x0a,0x0b,0x0c,0x0d,0x0e,0x0f,0x10,0x11,0x12,0x13,0x14,0x15,0x16,0x17,0x20,0x21,0x22,0x23,0x24,0x30,0x31,0x32,
    0x33,0x40,0x41,0x42,0x50,0x51,0x60,0x61,0x70,0x71,0x80,0x90,0xa0,0xb0,0xc0,0xd0,0xe0,0xf0,0xff,0xff,0xff,0xff,0xff,0xff,0xff,0xff,0xff,0xff,0xff,0xff,0xff,0xff};
__device__ __forceinline__ unsigned f2sort(float f) { const unsigned u = __float_as_uint(f); return u ^ ((u >> 31) ? 0xffffffffu : 0x80000000u); }
__device__ __forceinline__ float sort2f(unsigned k) { return __uint_as_float((k & 0x80000000u) ? (k ^ 0x80000000u) : ~k); }
__device__ __forceinline__ unsigned umax_(unsigned a, unsigned b) { return a > b ? a : b; }
__device__ __forceinline__ unsigned gmax16(unsigned v) { v = umax_(v, (unsigned)__shfl_xor((int)v, 1)); v = umax_(v, (unsigned)__shfl_xor((int)v, 2)); v = umax_(v, (unsigned)__shfl_xor((int)v, 4)); v = umax_(v, (unsigned)__shfl_xor((int)v, 8)); return v; }
__device__ __forceinline__ void p13_topk(const Frame& F) {
    const float* SCLO = (const float*)F.ob; const float* SCHI = (const float*)(F.ws + A_SCHI); int* IDS = (int*)(F.ws + A_IDS); float* GATES = (float*)(F.ws + A_GATES);
    const int lane = F.lane, l = lane & 15, gbase = lane & 48;
    for (int w = F.gw; w < NTOK * 2; w += F.ngw) {
        const int t = w >> 1, h = (w & 1) * 4 + (lane >> 4);
        const float* src = (h < 4 ? SCLO : SCHI) + (size_t)t * 1024 + (h & 3) * 256;
        const f32x4 a0 = *(const f32x4*)(src + 4 * l), a1 = *(const f32x4*)(src + 64 + 4 * l), b0 = *(const f32x4*)(src + 128 + 4 * l), b1 = *(const f32x4*)(src + 192 + 4 * l);
        unsigned k1[8], k2[8];
#pragma unroll
        for (int e = 0; e < 4; ++e) { k1[e] = (f2sort(a0[e]) & ~127u) | (unsigned)(4 * l + e); k1[4 + e] = (f2sort(a1[e]) & ~127u) | (unsigned)(64 + 4 * l + e);
                                      k2[e] = (f2sort(b0[e]) & ~127u) | (unsigned)(4 * l + e); k2[4 + e] = (f2sort(b1[e]) & ~127u) | (unsigned)(64 + 4 * l + e); }
        unsigned r1 = 0u, r2 = 0u;
        for (int k = 0; k < 16; ++k) {
            unsigned m1 = umax_(umax_(umax_(k1[0], k1[1]), umax_(k1[2], k1[3])), umax_(umax_(k1[4], k1[5]), umax_(k1[6], k1[7])));
            unsigned m2 = umax_(umax_(umax_(k2[0], k2[1]), umax_(k2[2], k2[3])), umax_(umax_(k2[4], k2[5]), umax_(k2[6], k2[7])));
            m1 = gmax16(m1); m2 = gmax16(m2);
            if (l == k) { r1 = m1; r2 = m2; }
#pragma unroll
            for (int e = 0; e < 8; ++e) { if (k1[e] == m1) k1[e] = 0u; if (k2[e] == m2) k2[e] = 0u; }
        }
        unsigned ck[4];
#pragma unroll
        for (int s = 0; s < 4; ++s) { const unsigned pr = PAIRTAB[s * 16 + l]; const bool valid = pr != 0xffu; const int i = valid ? (int)(pr >> 4) : 0, j = valid ? (int)(pr & 15u) : 0;
            const unsigned ki = (unsigned)__shfl((int)r1, gbase + i), kj = (unsigned)__shfl((int)r2, gbase + j);
            const float sum = sort2f(ki & ~127u) + sort2f(kj & ~127u);
            ck[s] = valid ? ((f2sort(sum) & ~255u) | pr) : 0u; }
        unsigned res = 0u;
        for (int k = 0; k < 16; ++k) {
            unsigned m = gmax16(umax_(umax_(ck[0], ck[1]), umax_(ck[2], ck[3])));
            if (l == k) res = m;
#pragma unroll
            for (int s = 0; s < 4; ++s) if (ck[s] == m) ck[s] = 0u;
        }
        const int i = (int)((res >> 4) & 15u), j = (int)(res & 15u);
        const unsigned ki = (unsigned)__shfl((int)r1, gbase + i), kj = (unsigned)__shfl((int)r2, gbase + j);
        const float val = sort2f(ki & ~127u) + sort2f(kj & ~127u); const int id = (int)(ki & 127u) * 128 + (int)(kj & 127u);
        float mx = val; mx = fmaxf(mx, __shfl_xor(mx, 1)); mx = fmaxf(mx, __shfl_xor(mx, 2)); mx = fmaxf(mx, __shfl_xor(mx, 4)); mx = fmaxf(mx, __shfl_xor(mx, 8));
        const float ex = __expf(val - mx); float sm = ex; sm += __shfl_xor(sm, 1); sm += __shfl_xor(sm, 2); sm += __shfl_xor(sm, 4); sm += __shfl_xor(sm, 8);
        IDS[(size_t)t * 128 + h * 16 + l] = id; GATES[(size_t)t * 128 + h * 16 + l] = ex / sm;
    }
}
__device__ __forceinline__ void p14_tables(const Frame& F, KArgs A) {
    const float* u_tab = (const float*)A->in[32]; const float* v_tab = (const float*)A->in[33]; bf16* UT = (bf16*)(F.ws + A_UT); bf16* VT = (bf16*)(F.ws + A_VT);
    for (int r = F.gw; r < 32768; r += F.ngw) { const int e = r & 16383; if (r < 16384) cvt_row1024(u_tab + (size_t)e * 1024, UT + (size_t)e * 1024, F.lane); else cvt_row1024(v_tab + (size_t)e * 1024, VT + (size_t)e * 1024, F.lane); }
}
__device__ __forceinline__ float dot8(u32x4 a, u32x4 b) {
    float s = 0.f;
    s += bflo(a.x) * bflo(b.x); s += bfhi(a.x) * bfhi(b.x); s += bflo(a.y) * bflo(b.y); s += bfhi(a.y) * bfhi(b.y);
    s += bflo(a.z) * bflo(b.z); s += bfhi(a.z) * bfhi(b.z); s += bflo(a.w) * bflo(b.w); s += bfhi(a.w) * bfhi(b.w);
    return s;
}
__device__ __forceinline__ void p15_gather(const Frame& F, KArgs A) {
    const bf16* X2 = (const bf16*)(F.ws + A_X2); const int* IDS = (const int*)(F.ws + A_IDS); const float* GATES = (const float*)(F.ws + A_GATES);
    const bf16* UT = (const bf16*)(F.ws + A_UT); const bf16* VT = (const bf16*)(F.ws + A_VT); const float* g3 = (const float*)A->in[34]; const float* b3 = (const float*)A->in[35];
    float* out = (float*)F.ob; const int lane = F.lane; const bool b5 = lane & 32, b4 = lane & 16, b3_ = lane & 8;
    const int srcl = ((lane >> 2) & 1) * 32 + ((lane >> 1) & 1) * 16 + (lane & 1) * 8;
    for (int t = F.gw; t < NTOK; t += F.ngw) {
        const u32x4 xa = *(const u32x4*)(X2 + (size_t)t * 1024 + 8 * lane), xb = *(const u32x4*)(X2 + (size_t)t * 1024 + 512 + 8 * lane);
        const int id0 = IDS[(size_t)t * 128 + lane], id1 = IDS[(size_t)t * 128 + 64 + lane]; const float g0 = GATES[(size_t)t * 128 + lane], g1 = GATES[(size_t)t * 128 + 64 + lane];
        float c0 = 0.f, c1 = 0.f;
        for (int bi = 0; bi < 16; ++bi) {
            const int idv = bi < 8 ? id0 : id1; float p[8];
#pragma unroll
            for (int r = 0; r < 8; ++r) { const int id = __builtin_amdgcn_readlane(idv, (bi & 7) * 8 + r); const bf16* ur = UT + (size_t)id * 1024;
                const u32x4 ua = *(const u32x4*)(ur + 8 * lane), ub = *(const u32x4*)(ur + 512 + 8 * lane); p[r] = dot8(xa, ua) + dot8(xb, ub); }
            float q[4], s2[2];
#pragma unroll
            for (int r = 0; r < 4; ++r) { const float keep = b5 ? p[r + 4] : p[r], send = b5 ? p[r] : p[r + 4]; q[r] = keep + __shfl_xor(send, 32); }
#pragma unroll
            for (int r = 0; r < 2; ++r) { const float keep = b4 ? q[r + 2] : q[r], send = b4 ? q[r] : q[r + 2]; s2[r] = keep + __shfl_xor(send, 16); }
            float v; { const float keep = b3_ ? s2[1] : s2[0], send = b3_ ? s2[0] : s2[1]; v = keep + __shfl_xor(send, 8); }
            v += __shfl_xor(v, 4); v += __shfl_xor(v, 2); v += __shfl_xor(v, 1);
            const float tv = __shfl(v, srcl);
            if ((lane >> 3) == (bi & 7)) { if (bi < 8) c0 = tv; else c1 = tv; }
        }
        c0 = g0 * gelu_tanh(c0); c1 = g1 * gelu_tanh(c1);
        f32x4 acc[4] = {};
        for (int bi = 0; bi < 16; ++bi) {
            const int idv = bi < 8 ? id0 : id1; const float cv = bi < 8 ? c0 : c1;
#pragma unroll
            for (int r = 0; r < 8; ++r) { const int kk = (bi & 7) * 8 + r; const int id = __builtin_amdgcn_readlane(idv, kk);
                const float s = __uint_as_float(__builtin_amdgcn_readlane(__float_as_uint(cv), kk)); const bf16* vr = VT + (size_t)id * 1024;
                f32x4 a0, a1, b0, b1; unpack8(*(const u32x4*)(vr + 8 * lane), a0, a1); unpack8(*(const u32x4*)(vr + 512 + 8 * lane), b0, b1);
                acc[0] += a0 * s; acc[1] += a1 * s; acc[2] += b0 * s; acc[3] += b1 * s; }
        }
        f32x4 x0, x1, x2, x3; unpack8(xa, x0, x1); unpack8(xb, x2, x3);
        acc[0] += x0 * ALPHA; acc[1] += x1 * ALPHA; acc[2] += x2 * ALPHA; acc[3] += x3 * ALPHA;
        float s = 0.f;
#pragma unroll
        for (int j = 0; j < 4; ++j) s += (acc[j][0] + acc[j][1]) + (acc[j][2] + acc[j][3]);
        const float mean = wave_sum(s) * (1.f / 1024.f); float qv = 0.f;
#pragma unroll
        for (int j = 0; j < 4; ++j) { acc[j] = acc[j] - mean; qv += (acc[j][0] * acc[j][0] + acc[j][1] * acc[j][1]) + (acc[j][2] * acc[j][2] + acc[j][3] * acc[j][3]); }
        const float rstd = rsqrtf(wave_sum(qv) * (1.f / 1024.f) + LN_EPS);
#pragma unroll
        for (int j = 0; j < 4; ++j) { const int c = (j >> 1) * 512 + 8 * lane + (j & 1) * 4; const f32x4 gg = *(const f32x4*)(g3 + c), bb = *(const f32x4*)(b3 + c);
            *(f32x4*)(out + (size_t)t * 1024 + c) = acc[j] * rstd * gg + bb; }
    }
}

__global__ void __launch_bounds__(NWAVES * 64, 2) mk_fwd(Args args) {
    extern __shared__ __attribute__((aligned(16))) unsigned char lds[];
    Frame F;
    F.lds = (LAS unsigned char*)lds; F.ws = args.ws; F.ob = (unsigned char*)args.out; F.ctl = (unsigned*)(args.ws + WS_CTL);
    F.tid = threadIdx.x; F.lane = F.tid & 63; F.wave = __builtin_amdgcn_readfirstlane(F.tid >> 6);
    F.G = gridDim.x; { const int bx = blockIdx.x; F.vcu = (F.G % 8 == 0) ? (bx % 8) * (F.G / 8) + bx / 8 : bx; }
    F.gw = F.vcu * NWAVES + F.wave; F.ngw = F.G * NWAVES;
    volatile LAS unsigned* MISC = (volatile LAS unsigned*)(F.lds + MISC_OFF);
    if (F.tid < 32) MISC[F.tid] = 0u;
    __syncthreads();
    const int lo = args.ph_lo, hi = args.ph_hi;
    XcdBarrier bar; bar.bar = F.ctl + CW_BAR; bar.x = 0; bar.st = nullptr;
    if (hi - lo > 1) bar = xcd_barrier_post(F.ctl + CW_BAR, MISC + 8);
#define IN(k) (lo <= (k) && (k) < hi)
#define SEAM(k) do { if (IN(k) && IN((k) + 1)) xcd_barrier(bar); } while (0)
    const int bx = (int)blockIdx.x;

    if (IN(0)) { F.refresh(); p0_prologue(F, kargs()); SEAM(0); }

    if (IN(1)) {
        { pg8::Gemm g{(const bf16*)(F.ob + O_XB), (const bf16*)(F.ws + W_WINT), NTOK, NINP, DM}; BigSched S; S.so.init(NTOK, NINP, F.G, bx); S.bt = 0;
          EpiWin E{(bf16*)(F.ws + A_CQ), (bf16*)(F.ws + A_CKV), (bf16*)(F.ws + A_KH), (bf16*)(F.ws + A_UP), (const float2*)(F.ws + W_ROPE), (float*)(F.ws + W_SSQ)};
          pg8::gemm_phase<EpiWin, BigSched, true, true>(F.lds, g, S, E); }
        { pg8::Gemm g{(const bf16*)(F.ws + W_MEMB), (const bf16*)(F.ws + W_XKVT), 512, 2048, DM}; ListSched<DecKV2> S{16, F.G, (bx + F.G - 64) % F.G, DecKV2{}};
          EpiK2V2 E{(bf16*)(F.ws + W_K2V2)};
          pg8::gemm_phase<EpiK2V2, ListSched<DecKV2>, true, true>(F.lds, g, S, E); }
        SEAM(1);
    }
    if (IN(2)) {
        { pg8::Gemm g{(const bf16*)(F.ws + A_CQ), (const bf16*)(F.ws + W_WUQT), NTOK, 768, QL}; BigSched S; S.so.init(NTOK, 768, F.G, bx); S.bt = 0;
          EpiQ E{(bf16*)(F.ws + A_QH), (const float2*)(F.ws + W_ROPE), (const float*)(F.ws + W_SSQ)};
          pg8::gemm_phase<EpiQ, BigSched, true, true>(F.lds, g, S, E); }
        { pg8::Gemm g{(const bf16*)(F.ws + A_UP), (const bf16*)(F.ws + W_GM), 16384, 8192, 640}; ListSched<DecLS> S{64, F.G, (bx + F.G - 192) % F.G, DecLS{}};
          EpiLS E{(float*)(F.ws + A_LS)};
          pg8::gemm_phase<EpiLS, ListSched<DecLS>, true, true>(F.lds, g, S, E); }
        { pg8::Gemm g{(const bf16*)(F.ws + A_CKV), (const bf16*)(F.ws + W_WUKVT), NTOK, 1024, KVL}; BigSched S; S.so.init(NTOK, 1024, F.G, bx); S.bt = 0;
          EpiKV E{(bf16*)(F.ws + A_KH), (bf16*)(F.ws + A_VH), (const float*)(F.ws + W_SSQ)};
          pg8::gemm_phase<EpiKV, BigSched, true, true>(F.lds, g, S, E); }
        { pg8::Gemm g{(const bf16*)(F.ws + W_K2V2), (const bf16*)(F.ws + W_XQH), 2048, 4096, 256}; ListSched<DecMb> S{32, F.G, bx, DecMb{}};
          EpiMb E{(bf16*)(F.ws + W_MB)};
          pg8::gemm_phase<EpiMb, ListSched<DecMb>, true, true>(F.lds, g, S, E); }
        { pg8::Gemm g{(const bf16*)(F.ws + W_XOTH), (const bf16*)(F.ws + W_K2V2) + (size_t)2 * 4 * 256 * 256, 4096, 2048, 256}; ListSched<DecVOT> S{32, F.G, (bx + F.G - 32) % F.G, DecVOT{}};
          EpiVOT E{(bf16*)(F.ws + W_VOT)};
          pg8::gemm_phase<EpiVOT, ListSched<DecVOT>, true, true>(F.lds, g, S, E); }
        { pg8::Gemm g{(const bf16*)(F.ws + W_SKP), (const bf16*)(F.ws + W_WQR), 512, 16384, 256}; ListSched<DecWsc> S{64, F.G, (bx + F.G - 64) % F.G, DecWsc{}};
          EpiWsc E{(bf16*)(F.ws + W_WSC)};
          pg8::gemm_phase<EpiWsc, ListSched<DecWsc>, true, true>(F.lds, g, S, E); }
        SEAM(2);
    }
    if (IN(3)) { F.refresh(); p3_scan(F, kargs()); SEAM(3); }
    if (IN(4)) {
        for (int L = F.vcu; L < 256; L += F.G) {
            const int bh = L >> 4, xq_ = L & 15, q0 = xq_, q1 = 31 - xq_, b = bh >> 3, h = bh & 7;
            const att::bf16* Qb = (const att::bf16*)(F.ws + A_QH) + (size_t)bh * SEQ * 96; const att::bf16* Kb = (const att::bf16*)(F.ws + A_KH) + (size_t)bh * SEQ * 96;
            const att::bf16* Vb = (const att::bf16*)(F.ws + A_VH) + (size_t)bh * SEQ * 64; att::bf16* Ob = (att::bf16*)(F.ws + A_OA) + (size_t)b * SEQ * 512 + h * 64;
            const att::BlockRef r0{Qb + (size_t)q0 * 256 * 96, Kb, Vb, Ob + (size_t)q0 * 256 * 512, q0 * 256};
            const att::BlockRef r1{Qb + (size_t)q1 * 256 * 96, Kb, Vb, Ob + (size_t)q1 * 256 * 512, q1 * 256};
            att::Seam S;
            att::attn_prime(r0, (char*)lds, S);
            att::attn_block(r0, r1, (char*)lds, S);
            att::attn_block(r1, r1, (char*)lds, S);
        }
        { pg8::Gemm g{(const bf16*)(F.ws + A_UP), (const bf16*)(F.ws + W_TH), 16384, 16384, 640}; ListSched<DecY> S{128, F.G, bx, DecY{}};
          EpiY E{(bf16*)(F.ob + O_YS)};
          pg8::gemm_phase<EpiY, ListSched<DecY>, true, true>(F.lds, g, S, E); }
        SEAM(4);
    }
    if (IN(5)) {
        pg8::Gemm g{(const bf16*)(F.ob + O_YS), (const bf16*)(F.ws + W_WGLUT), NTOK, 512, 512}; BigSched S; S.so.init(NTOK, 512, F.G, bx); S.bt = 0;
        EpiGlu E{(const bf16*)(F.ob + O_YS), (bf16*)(F.ob + O_OS), (const float*)kargs()->in[17]};
        pg8::gemm_phase<EpiGlu, BigSched, true, true>(F.lds, g, S, E);
        SEAM(5);
    }
    if (IN(6)) { F.refresh(); p6_rmsnorm(F); SEAM(6); }
    if (IN(7)) {
        pg8::Gemm g{(const bf16*)(F.ws + A_MIXN), (const bf16*)(F.ws + W_WOUTT), NTOK, DM, DM}; BigSched S; S.so.init(NTOK, DM, F.G, bx); S.bt = 0;
        EpiPre<0> E{(const float*)kargs()->in[0], nullptr, (float*)F.ob};
        pg8::gemm_phase<EpiPre<0>, BigSched, true, true>(F.lds, g, S, E);
        SEAM(7);
    }
    if (IN(8)) { F.refresh(); ln_rows(F, (const float*)F.ob, (const float*)kargs()->in[21], (const float*)kargs()->in[22], (bf16*)(F.ws + A_X1)); SEAM(8); }
    if (IN(9)) {
        pg8::Gemm g{(const bf16*)(F.ws + A_X1), (const bf16*)(F.ws + W_MB), NTOK, DM, DM}; BigSched S; S.so.init(NTOK, DM, F.G, bx); S.bt = 4;
        EpiXS E{(bf16*)(F.ws + A_P), F.lds};
        pg8::gemm_phase<EpiXS, BigSched, true, true>(F.lds, g, S, E);
        SEAM(9);
    }
    if (IN(10)) {
        pg8::Gemm g{(const bf16*)(F.ws + A_P), (const bf16*)(F.ws + W_VOT), NTOK, DM, DM}; BigSched S; S.so.init(NTOK, DM, F.G, bx); S.bt = 4;
        EpiPre<1> E{nullptr, (const bf16*)(F.ws + A_X1), (float*)F.ob};
        pg8::gemm_phase<EpiPre<1>, BigSched, true, true>(F.lds, g, S, E);
        SEAM(10);
    }
    if (IN(11)) { F.refresh(); ln_rows(F, (const float*)F.ob, (const float*)kargs()->in[27], (const float*)kargs()->in[28], (bf16*)(F.ws + A_X2)); SEAM(11); }
    if (IN(12)) {
        pg8::Gemm g{(const bf16*)(F.ws + A_X2), (const bf16*)(F.ws + W_WSC), NTOK, 2048, DM}; BigSched S; S.so.init(NTOK, 2048, F.G, bx); S.bt = 0;
        EpiSC E{(float*)F.ob, (float*)(F.ws + A_SCHI)};
        pg8::gemm_phase<EpiSC, BigSched, true, true>(F.lds, g, S, E);
        SEAM(12);
    }
    if (IN(13)) { F.refresh(); p13_topk(F); SEAM(13); }
    if (IN(14)) { F.refresh(); p14_tables(F, kargs()); SEAM(14); }
    if (IN(15)) { F.refresh(); p15_gather(F, kargs()); }
#undef IN
#undef SEAM
}

extern "C" void kernel_launch(void* const* d_in, const int* in_sizes, int n_in, void* d_out, int out_size, void* d_ws, size_t ws_size, hipStream_t stream) {
    static int grid = 0;
    if (grid == 0) {
        if (n_in != 36 || in_sizes[0] != NTOK * DM || out_size != NTOK * DM || ws_size < WS_NEED) {
            fprintf(stderr, "kernel_launch: unexpected shapes (n_in %d, in0 %d, out %d, ws %zu); nothing launched\n", n_in, n_in > 0 ? in_sizes[0] : -1, out_size, ws_size); grid = -1; return; }
        int dev = 0, cus = 0, per_cu = 0;
        if (hipGetDevice(&dev) != hipSuccess || hipDeviceGetAttribute(&cus, hipDeviceAttributeMultiprocessorCount, dev) != hipSuccess) { grid = -1; return; }
        if (hipFuncSetAttribute((const void*)mk_fwd, hipFuncAttributeMaxDynamicSharedMemorySize, LDS_BYTES) != hipSuccess) { fprintf(stderr, "kernel_launch: hipFuncSetAttribute failed\n"); grid = -1; return; }
        if (hipOccupancyMaxActiveBlocksPerMultiprocessor(&per_cu, (const void*)mk_fwd, NWAVES * 64, LDS_BYTES) != hipSuccess || per_cu < 1)
            fprintf(stderr, "kernel_launch: note: occupancy query reports %d workgroups per CU\n", per_cu);
        (void)hipGetLastError();
        grid = cus;
    }
    if (grid < 0) return;
    if (hipMemsetAsync((char*)d_ws + WS_CTL, 0, CTL_ZERO_BYTES, stream) != hipSuccess) return;
    Args a{};
    for (int i = 0; i < 36; ++i) a.in[i] = d_in[i];
    a.out = (float*)d_out; a.ws = (unsigned char*)d_ws;
#if MK_PER_PHASE
    for (int p = 0; p < NPH; ++p) { a.ph_lo = p; a.ph_hi = p + 1; hipLaunchKernelGGL(mk_fwd, dim3(grid), dim3(NWAVES * 64), LDS_BYTES, stream, a); }
#else
    a.ph_lo = 0; a.ph_hi = NPH; hipLaunchKernelGGL(mk_fwd, dim3(grid), dim3(NWAVES * 64), LDS_BYTES, stream, a);
#endif
}
```

```cpp
#include <hip/hip_runtime.h>
#include <hip/hip_bf16.h>
#include <cstdio>
#include <cstdint>
#include <cmath>

#ifndef MK_PER_PHASE
#define MK_PER_PHASE 0
#endif
#ifndef MK_DBG
#define MK_DBG 0
#endif
#ifndef MK_REP
#define MK_REP 0
#endif
namespace pg8 {
#define PG8_LAS __attribute__((address_space(3)))
typedef unsigned short bf16_t;
typedef short bf16x8 __attribute__((ext_vector_type(8)));
typedef float f32x4 __attribute__((ext_vector_type(4)));
typedef unsigned u32x4 __attribute__((ext_vector_type(4)));
constexpr int BM = 256, BK = 64, HALF = 128, HTB = HALF * BK * 2  , STAGE_BYTES = 8 * HTB, NXCD = 8, WGM = 8;

__host__ __device__ __forceinline__ int lds_byte(int r, int c) { const int st = (r >> 4) * 2 + (c >> 5), rr = r & 15, cc = c & 31, ob = rr * 64 + cc * 2; return st * 1024 + (ob ^ (((ob >> 9) & 1) << 5)); }
__host__ __device__ __forceinline__ void stage_rc(int b, int& R, int& C) { const int st = b / 1024, sb = b % 1024, swz = sb ^ (((sb >> 9) & 1) << 5); R = (st >> 1) * 16 + swz / 64; C = (st & 1) * 32 + (swz % 64) / 2; }
__host__ __device__ __forceinline__ int perm32(int rho) { const int n = rho >> 4, i = rho & 15; return 8 * (i >> 2) + 4 * n + (i & 3); }

struct Unit { int pm, pn; };
struct Gemm { const bf16_t* A; const bf16_t* Bt; int M, N, K; };

struct StaticOrder {
    int nM, nN, nwg, G, c;
    __host__ __device__ void init(int M, int N, int G_, int c_) { nM = M / BM; nN = N / BM; nwg = nM * nN; G = G_; c = c_; }
    __host__ __device__ bool next(int i, Unit& u) const {
        const long L = (long)i * G + c; if (L >= nwg) return false;
        int wgid = (int)L; { const int q = nwg / NXCD, r = nwg % NXCD, xcd = wgid % NXCD, off = wgid / NXCD; wgid = (xcd < r ? xcd * (q + 1) : r * (q + 1) + (xcd - r) * q) + off; }
        const int nig = WGM * nN, gid = wgid / nig, fm = gid * WGM, gsz = (nM - fm) < WGM ? (nM - fm) : WGM;
        u.pm = fm + ((wgid % nig) % gsz); u.pn = (wgid % nig) / gsz; return true;
    }
    __device__ __forceinline__ void a_ready(const Unit&) const {}
    __device__ __forceinline__ void done(const Unit&) const {}
};

__device__ __forceinline__ unsigned cvt_pk_bf16(float lo, float hi) { unsigned r; asm volatile("v_cvt_pk_bf16_f32 %0, %1, %2" : "=v"(r) : "v"(lo), "v"(hi)); return r; }
typedef float f32x2 __attribute__((ext_vector_type(2)));
__device__ __forceinline__ f32x2 gelu_pk(f32x2 v) {
    const f32x2 av = __builtin_elementwise_abs(v), d = av * 0.2316418882f + 1.0f;
    f32x2 t; t.x = __builtin_amdgcn_rcpf(d.x); t.y = __builtin_amdgcn_rcpf(d.y);
    f32x2 q = t * 0.5307027145f + (-0.7265760135f); q = q * t + 0.7107068705f; q = q * t + (-0.142248368f); q = q * t + 0.127414796f; q = q * t;
    const f32x2 s = (v * v) * (-0.72134752044f);
    f32x2 e; e.x = __builtin_amdgcn_exp2f(s.x); e.y = __builtin_amdgcn_exp2f(s.y);
    const f32x2 m = v * (q * e), r = v - m;
    f32x2 o; o.x = v.x < 0.f ? m.x : r.x; o.y = v.y < 0.f ? m.y : r.y; return o;
}

template <int ACT  > struct EpiBf16 {
    static constexpr bool PERM = true, AFTER_DRAIN = false; static_assert(ACT == 0 || ACT == 1, "EpiBf16: ACT is 0 (none) or 1 (gelu_pk)");
    bf16_t* O; int ldc; const float* bias; int split_cols; size_t split_stride; float scale0;
    __device__ __forceinline__ void operator()(const f32x4 (&acc)[2][2][4][2], const Unit& u, int wr, int wc, int fr, int fq) const {
        const int row0 = u.pm * BM + wr * 64 + fr; int colt = u.pn * BM; bf16_t* base = O;
        float sc = 1.f; if (split_cols) { const int t = colt / split_cols; base += (size_t)t * split_stride; colt -= t * split_cols; if (t == 0) sc = scale0; }
        const int col0 = colt + wc * 32 + 8 * fq, bcol0 = u.pn * BM + wc * 32 + 8 * fq;
        f32x4 bv[2][2];
#pragma unroll
        for (int bj = 0; bj < 2; ++bj)
#pragma unroll
            for (int n = 0; n < 2; ++n) bv[bj][n] = bias ? *(const f32x4*)(bias + bcol0 + bj * HALF + 4 * n) : (f32x4){0.f, 0.f, 0.f, 0.f};
#pragma unroll
        for (int ai = 0; ai < 2; ++ai)
#pragma unroll
            for (int m = 0; m < 4; ++m) { bf16_t* rowp = base + (size_t)(row0 + ai * HALF + m * 16) * ldc + col0;
#pragma unroll
                for (int bj = 0; bj < 2; ++bj) { f32x4 v0 = acc[ai][bj][m][0] + bv[bj][0], v1 = acc[ai][bj][m][1] + bv[bj][1];
                    if (ACT == 1) { f32x2 a = gelu_pk((f32x2){v0[0], v0[1]}), b = gelu_pk((f32x2){v0[2], v0[3]}), c = gelu_pk((f32x2){v1[0], v1[1]}), d = gelu_pk((f32x2){v1[2], v1[3]});
                        v0 = (f32x4){a.x, a.y, b.x, b.y}; v1 = (f32x4){c.x, c.y, d.x, d.y}; }
                    v0 = v0 * sc; v1 = v1 * sc; u32x4 w; w.x = cvt_pk_bf16(v0[0], v0[1]); w.y = cvt_pk_bf16(v0[2], v0[3]); w.z = cvt_pk_bf16(v1[0], v1[1]); w.w = cvt_pk_bf16(v1[2], v1[3]);
                    *(u32x4*)(rowp + bj * HALF) = w; } }
    }
};

struct PanelStats {
    unsigned* xbuf;
    unsigned* cnt;
    unsigned* tmo;
    int ntn; float eps;
    unsigned code;
    __device__ __forceinline__ bool run(const f32x4 (&v)[2][2][4][2], const Unit& u, int wr, int wc, int fr, int fq, PG8_LAS unsigned char* lds, int wid, int lane) const {
        typedef float f32x2v __attribute__((ext_vector_type(2)));
        PG8_LAS f32x2v* P = (PG8_LAS f32x2v*)lds;
        PG8_LAS f32x2v* S = (PG8_LAS f32x2v*)(lds + 8192);
        PG8_LAS unsigned* flag = (PG8_LAS unsigned*)(lds + 8192 + 2048);
#pragma unroll
        for (int ai = 0; ai < 2; ++ai)
#pragma unroll
            for (int m = 0; m < 4; ++m) {
                float s = 0.f;
#pragma unroll
                for (int bj = 0; bj < 2; ++bj)
#pragma unroll
                    for (int n = 0; n < 2; ++n) { const f32x4 x = v[ai][bj][m][n]; s += (x[0] + x[1]) + (x[2] + x[3]); }
                s += __shfl_xor(s, 16); s += __shfl_xor(s, 32);
                const float mw = s * (1.0f / 64.0f); float q = 0.f;
#pragma unroll
                for (int bj = 0; bj < 2; ++bj)
#pragma unroll
                    for (int n = 0; n < 2; ++n) { const f32x4 d = v[ai][bj][m][n] - mw; q += (d[0] * d[0] + d[1] * d[1]) + (d[2] * d[2] + d[3] * d[3]); }
                q += __shfl_xor(q, 16); q += __shfl_xor(q, 32);
                if (fq == 0) P[(ai * HALF + wr * 64 + m * 16 + fr) * 4 + wc] = (f32x2v){mw, q};
            }
        asm volatile("s_waitcnt lgkmcnt(0)" ::: "memory"); __builtin_amdgcn_s_barrier(); asm volatile("" ::: "memory");
#if defined(BROKEN_EXCHANGE_NO_WAIT)
#warning BROKEN CONTROL BUILD: the row-statistics exchange does not wait; results are wrong by design
        if (blockIdx.x >= 64) { const long long t0_ = clock64(); while (clock64() - t0_ < 60000) __builtin_amdgcn_s_sleep(8); }
#endif
        const int row = wid * 32 + (lane & 31);
        if (lane < 32) {
            const f32x2v a = P[row * 4 + 0], b = P[row * 4 + 1], c = P[row * 4 + 2], d = P[row * 4 + 3];
            const float mt = (a.x + b.x + c.x + d.x) * 0.25f;
            const float da = a.x - mt, db = b.x - mt, dc = c.x - mt, dd = d.x - mt;
            const float m2 = (a.y + b.y) + (c.y + d.y) + 64.0f * ((da * da + db * db) + (dc * dc + dd * dd));
            unsigned long long* slot = (unsigned long long*)xbuf + ((size_t)(u.pm * BM + row) * 4 + u.pn);
            __hip_atomic_store(slot, ((unsigned long long)__float_as_uint(m2) << 32) | __float_as_uint(mt), __ATOMIC_RELAXED, __HIP_MEMORY_SCOPE_AGENT);
        }
        asm volatile("s_waitcnt vmcnt(0)" ::: "memory");
        if (lane == 0) __hip_atomic_fetch_add(cnt + 64 * u.pm, 1u, __ATOMIC_RELAXED, __HIP_MEMORY_SCOPE_AGENT);
        if (wid == 0) {
            bool dead = false; const unsigned long long t0 = __builtin_amdgcn_s_memrealtime(); const unsigned want = 8u * (unsigned)ntn;
            for (;;) {
#if defined(BROKEN_EXCHANGE_NO_WAIT)
                break;
#endif
                if ((unsigned)__builtin_amdgcn_readfirstlane(__hip_atomic_load(cnt + 64 * u.pm, __ATOMIC_RELAXED, __HIP_MEMORY_SCOPE_AGENT)) >= want) break;
                if (__builtin_amdgcn_s_memrealtime() - t0 > 2000000ull) {
                    if (lane == 0) { unsigned expect = 0u; __hip_atomic_compare_exchange_strong(tmo + 1, &expect, code | (unsigned)(u.pm & 0xff), __ATOMIC_RELAXED, __ATOMIC_RELAXED, __HIP_MEMORY_SCOPE_AGENT);
                                     __hip_atomic_store(tmo, 1u, __ATOMIC_RELAXED, __HIP_MEMORY_SCOPE_AGENT); }
                    dead = true; break; }
                __builtin_amdgcn_s_sleep(2);
            }
            __builtin_amdgcn_fence(__ATOMIC_ACQUIRE, "agent");
            if (lane == 0) flag[0] = dead ? 1u : 0u;
        }
        asm volatile("s_waitcnt vmcnt(0) lgkmcnt(0)" ::: "memory"); __builtin_amdgcn_s_barrier(); asm volatile("" ::: "memory");
        const bool bad = flag[0] != 0u;
        if (lane < 32) {
            const unsigned long long* slot = (const unsigned long long*)xbuf + (size_t)(u.pm * BM + row) * 4; float mt[4], m2[4]; float ms = 0.f;
#pragma unroll
            for (int t = 0; t < 4; ++t) { if (t < ntn) { const unsigned long long w = __hip_atomic_load(slot + t, __ATOMIC_RELAXED, __HIP_MEMORY_SCOPE_AGENT); mt[t] = __uint_as_float((unsigned)w); m2[t] = __uint_as_float((unsigned)(w >> 32)); } else { mt[t] = 0.f; m2[t] = 0.f; } ms += mt[t]; }
            const float mean = ms / (float)ntn; float q = 0.f;
#pragma unroll
            for (int t = 0; t < 4; ++t) if (t < ntn) { const float dm = mt[t] - mean; q += m2[t] + 256.0f * dm * dm; }
            S[row] = (f32x2v){mean, 1.0f / sqrtf(q / (256.0f * (float)ntn) + eps)};
        }
        asm volatile("s_waitcnt lgkmcnt(0)" ::: "memory"); __builtin_amdgcn_s_barrier(); asm volatile("" ::: "memory");
        return bad;
    }
};
struct EpiLnRes {
    static constexpr bool PERM = false, AFTER_DRAIN = true;
    const float* base; float* out; int ldc; const float* bias; PanelStats st; unsigned poison;
    __device__ __forceinline__ void fused(f32x4 (&acc)[2][2][4][2], const Unit& u, int wr, int wc, int fr, int fq, PG8_LAS unsigned char* lds, int wid, int lane) const {
        typedef float f32x2v __attribute__((ext_vector_type(2)));
        const PG8_LAS f32x2v* S = (const PG8_LAS f32x2v*)(lds + 8192);
        const int col0 = u.pn * BM + wc * 32 + 4 * fq;
#pragma unroll
        for (int bj = 0; bj < 2; ++bj)
#pragma unroll
            for (int n = 0; n < 2; ++n) { const f32x4 bv = bias ? *(const f32x4*)(bias + col0 + bj * HALF + n * 16) : (f32x4){0.f, 0.f, 0.f, 0.f};
#pragma unroll
                for (int ai = 0; ai < 2; ++ai)
#pragma unroll
                    for (int m = 0; m < 4; ++m) acc[ai][bj][m][n] += bv; }
        f32x4 pre[4][2][2];
#pragma unroll
        for (int m = 0; m < 4; ++m) { const size_t off = (size_t)(u.pm * BM + wr * 64 + m * 16 + fr) * ldc + col0;
#pragma unroll
            for (int bj = 0; bj < 2; ++bj)
#pragma unroll
                for (int n = 0; n < 2; ++n) pre[m][bj][n] = *(const f32x4*)(base + off + bj * HALF + n * 16); }
        const bool bad = st.run(acc, u, wr, wc, fr, fq, lds, wid, lane) || poison != 0u;
        const float qnan = __builtin_nanf("");
#pragma unroll
        for (int ai = 0; ai < 2; ++ai)
#pragma unroll
            for (int m = 0; m < 4; ++m) { const int r = ai * HALF + wr * 64 + m * 16 + fr; const f32x2v sr = S[r]; const size_t off = (size_t)(u.pm * BM + r) * ldc + col0;
#pragma unroll
                for (int bj = 0; bj < 2; ++bj)
#pragma unroll
                    for (int n = 0; n < 2; ++n) { const f32x4 bs = ai == 0 ? pre[m][bj][n] : *(const f32x4*)(base + off + bj * HALF + n * 16); f32x4 o = bs + (acc[ai][bj][m][n] - sr.x) * sr.y;
                        if (bad) o = (f32x4){qnan, qnan, qnan, qnan}; *(f32x4*)(out + off + bj * HALF + n * 16) = o; }
                if (m & 1) asm volatile("" ::: "memory"); }
    }
};
struct EpiLnResLn {
    static constexpr bool PERM = false, AFTER_DRAIN = true;
    const float* base; float* out; bf16_t* xn; int ldc; const float* bias; PanelStats st1, st2; unsigned poison;
    __device__ __forceinline__ void fused(f32x4 (&acc)[2][2][4][2], const Unit& u, int wr, int wc, int fr, int fq, PG8_LAS unsigned char* lds, int wid, int lane) const {
        typedef float f32x2v __attribute__((ext_vector_type(2))); typedef unsigned u32x2v __attribute__((ext_vector_type(2)));
        const PG8_LAS f32x2v* S = (const PG8_LAS f32x2v*)(lds + 8192);
        const int col0 = u.pn * BM + wc * 32 + 4 * fq;
#pragma unroll
        for (int bj = 0; bj < 2; ++bj)
#pragma unroll
            for (int n = 0; n < 2; ++n) { const f32x4 bv = bias ? *(const f32x4*)(bias + col0 + bj * HALF + n * 16) : (f32x4){0.f, 0.f, 0.f, 0.f};
#pragma unroll
                for (int ai = 0; ai < 2; ++ai)
#pragma unroll
                    for (int m = 0; m < 4; ++m) acc[ai][bj][m][n] += bv; }
        bool bad = st1.run(acc, u, wr, wc, fr, fq, lds, wid, lane) || poison != 0u;
        const float qnan = __builtin_nanf("");
#pragma unroll
        for (int ai = 0; ai < 2; ++ai)
#pragma unroll
            for (int m = 0; m < 4; ++m) { const int r = ai * HALF + wr * 64 + m * 16 + fr; const f32x2v sr = S[r]; const size_t off = (size_t)(u.pm * BM + r) * ldc + col0;
#pragma unroll
                for (int bj = 0; bj < 2; ++bj)
#pragma unroll
                    for (int n = 0; n < 2; ++n) { const f32x4 bs = *(const f32x4*)(base + off + bj * HALF + n * 16); acc[ai][bj][m][n] = bs + (acc[ai][bj][m][n] - sr.x) * sr.y; }
                asm volatile("" : "+v"(acc[ai][0][m][0]), "+v"(acc[ai][0][m][1]), "+v"(acc[ai][1][m][0]), "+v"(acc[ai][1][m][1]));
                if (m & 1) asm volatile("" ::: "memory"); }
        const bool bad1 = bad;
        bad = st2.run(acc, u, wr, wc, fr, fq, lds, wid, lane) || bad;
#pragma unroll
        for (int ai = 0; ai < 2; ++ai)
#pragma unroll
            for (int m = 0; m < 4; ++m) { const int r = ai * HALF + wr * 64 + m * 16 + fr; const f32x2v sr = S[r]; const size_t off = (size_t)(u.pm * BM + r) * ldc + col0;
#pragma unroll
                for (int bj = 0; bj < 2; ++bj)
#pragma unroll
                    for (int n = 0; n < 2; ++n) { const f32x4 x1 = acc[ai][bj][m][n]; *(f32x4*)(out + off + bj * HALF + n * 16) = bad1 ? (f32x4){qnan, qnan, qnan, qnan} : x1;
                        const f32x4 o = (x1 - sr.x) * sr.y; u32x2v w; w.x = cvt_pk_bf16(o[0], o[1]); w.y = cvt_pk_bf16(o[2], o[3]);
                        if (bad) { w.x = 0x7fc07fc0u; w.y = 0x7fc07fc0u; } *(u32x2v*)(xn + off + bj * HALF + n * 16) = w; }
                asm volatile("" ::: "memory"); }
    }
};

template <class Epi, class Sched, bool ALIGN_EPI = false, bool SP2 = false>
__device__ __forceinline__ void gemm_phase(PG8_LAS unsigned char* lds, const Gemm g, const Sched& S, const Epi& E) {
    int tid_ = threadIdx.x; asm volatile("" : "+v"(tid_));
    const int tid = tid_, wid = __builtin_amdgcn_readfirstlane(tid >> 6), lane = tid & 63, wr = wid >> 2, wc = wid & 3, fr = lane & 15, fq = lane >> 4;
    const int K = g.K, nt = K / BK;
    unsigned voffA[2], voffB[2];
#pragma unroll
    for (int i = 0; i < 2; ++i) { int R, C; stage_rc(tid * 16 + i * 8192, R, C); const int Rb = Epi::PERM ? ((R & ~31) + perm32(R & 31)) : R;
        voffA[i] = (unsigned)(R * K + C) * 2u; voffB[i] = (unsigned)(Rb * K + C) * 2u; }
    const size_t kstep = (size_t)(BK * 2);
    const size_t hstep = (size_t)HALF * K * 2;
    const size_t tstep = 2 * hstep;
    const unsigned ldsw = (unsigned)wid * 1024u;
    const int aoff = lds_byte(wr * 64 + fr, fq * 8), boff = lds_byte(wc * 32 + fr, fq * 8);
#define PG8_SA(b, h) (((b) * 2 + (h)) * HTB)
#define PG8_SB(b, h) ((4 + (b) * 2 + (h)) * HTB)
#define PG8_STAGE(bufoff, gbase, voff) do { _Pragma("unroll") for (int _i = 0; _i < 2; ++_i) \
        __builtin_amdgcn_global_load_lds((const unsigned*)((const char*)(gbase) + (voff)[_i]), (PG8_LAS unsigned*)(lds + (bufoff) + ldsw + _i * 8192), 16, 0, 0); } while (0)
#define PG8_LDA(dst, b, h) do { _Pragma("unroll") for (int m = 0; m < 4; ++m) _Pragma("unroll") for (int k = 0; k < 2; ++k) dst[m][k] = *(const PG8_LAS bf16x8*)(lds + PG8_SA(b, h) + aoff + m * 2048 + k * 1024); } while (0)
#define PG8_LDB(dst, b, h) do { _Pragma("unroll") for (int n = 0; n < 2; ++n) _Pragma("unroll") for (int k = 0; k < 2; ++k) dst[n][k] = *(const PG8_LAS bf16x8*)(lds + PG8_SB(b, h) + boff + n * 2048 + k * 1024); } while (0)
#define PG8_MMA(ai, bj, At, Bt) do { __builtin_amdgcn_s_setprio(1); _Pragma("unroll") for (int m = 0; m < 4; ++m) _Pragma("unroll") for (int n = 0; n < 2; ++n) _Pragma("unroll") for (int k = 0; k < 2; ++k) \
        acc[ai][bj][m][n] = __builtin_amdgcn_mfma_f32_16x16x32_bf16(Bt[n][k], At[m][k], acc[ai][bj][m][n], 0, 0, 0); __builtin_amdgcn_s_setprio(0); } while (0)
#define PG8_WAIT_V(n) asm volatile("s_waitcnt vmcnt(" #n ")" ::: "memory")
#define PG8_WAIT_L(n) asm volatile("s_waitcnt lgkmcnt(" #n ")" ::: "memory")
#define PG8_BAR __builtin_amdgcn_s_barrier()
#define PG8_SCHED __builtin_amdgcn_sched_barrier(0)
    Unit cur, nxt; int ui = 0;
    if (!S.next(0, cur)) return;
    f32x4 acc[2][2][4][2];
#pragma unroll
    for (int a = 0; a < 2; ++a)
#pragma unroll
        for (int b = 0; b < 2; ++b)
#pragma unroll
            for (int m = 0; m < 4; ++m)
#pragma unroll
                for (int n = 0; n < 2; ++n) acc[a][b][m][n] = (f32x4){0.f, 0.f, 0.f, 0.f};
    bf16x8 At[4][2], B0[2][2], B1[2][2];
    const char* cA = (const char*)g.A + (size_t)cur.pm * tstep; const char* cB = (const char*)g.Bt + (size_t)cur.pn * tstep;
    S.a_ready(cur);
    if constexpr (SP2) {
        PG8_STAGE(PG8_SB(0, 0), cB, voffB); PG8_STAGE(PG8_SB(0, 1), cB + hstep, voffB); PG8_STAGE(PG8_SA(0, 0), cA, voffA); PG8_STAGE(PG8_SA(0, 1), cA + hstep, voffA);
        if (wr == 1) PG8_BAR;
        PG8_WAIT_V(2); PG8_BAR;
        PG8_STAGE(PG8_SB(1, 0), cB + kstep, voffB); PG8_STAGE(PG8_SA(1, 0), cA + kstep, voffA); PG8_STAGE(PG8_SB(1, 1), cB + hstep + kstep, voffB);
        PG8_WAIT_V(6); PG8_BAR;
    } else {
        PG8_STAGE(PG8_SB(0, 0), cB, voffB); PG8_STAGE(PG8_SA(0, 0), cA, voffA); PG8_STAGE(PG8_SB(0, 1), cB + hstep, voffB); PG8_STAGE(PG8_SA(0, 1), cA + hstep, voffA);
        if (wr == 1) PG8_BAR;
        PG8_WAIT_V(4); PG8_BAR;
        PG8_STAGE(PG8_SB(1, 0), cB + kstep, voffB); PG8_STAGE(PG8_SA(1, 0), cA + kstep, voffA); PG8_STAGE(PG8_SB(1, 1), cB + hstep + kstep, voffB);
        PG8_WAIT_V(6); PG8_BAR;
    }
    for (;;) {
        const bool has_next = S.next(ui + 1, nxt);
        const char* nA = has_next ? (const char*)g.A + (size_t)nxt.pm * tstep : cA; const char* nB = has_next ? (const char*)g.Bt + (size_t)nxt.pn * tstep : cB;
#pragma unroll 1
        for (int t = 0; t < nt; t += 2) {
            const bool last = (t == nt - 2);
            const char* a1 = cA + (size_t)(t + 1) * kstep;
            const char* a2 = last ? nA : cA + (size_t)(t + 2) * kstep; const char* b2 = last ? nB : cB + (size_t)(t + 2) * kstep;
            const char* a3 = a2 + kstep; const char* b3 = b2 + kstep;
            if (last && has_next) S.a_ready(nxt);
            if constexpr (SP2) {
            PG8_LDB(B0, 0, 0); PG8_LDB(B1, 0, 1); PG8_SCHED; PG8_LDA(At, 0, 0); PG8_STAGE(PG8_SA(1, 1), a1 + hstep, voffA);
            PG8_WAIT_V(8); PG8_WAIT_L(0); PG8_BAR; PG8_MMA(0, 0, At, B0); PG8_MMA(0, 1, At, B1); PG8_BAR; PG8_SCHED;
            PG8_LDA(At, 0, 1); PG8_STAGE(PG8_SB(0, 0), b2, voffB); PG8_STAGE(PG8_SB(0, 1), b2 + hstep, voffB); PG8_STAGE(PG8_SA(0, 0), a2, voffA);
            PG8_WAIT_V(8); PG8_WAIT_L(0); PG8_BAR; PG8_MMA(1, 0, At, B0); PG8_MMA(1, 1, At, B1); PG8_BAR; PG8_SCHED;
            PG8_LDB(B0, 1, 0); PG8_LDB(B1, 1, 1); PG8_SCHED; PG8_LDA(At, 1, 0); PG8_STAGE(PG8_SA(0, 1), a2 + hstep, voffA);
            PG8_WAIT_V(8); PG8_WAIT_L(0); PG8_BAR; PG8_MMA(0, 0, At, B0); PG8_MMA(0, 1, At, B1); PG8_BAR; PG8_SCHED;
            PG8_LDA(At, 1, 1); PG8_STAGE(PG8_SB(1, 0), b3, voffB); PG8_STAGE(PG8_SB(1, 1), b3 + hstep, voffB); PG8_STAGE(PG8_SA(1, 0), a3, voffA);
            PG8_WAIT_V(8); PG8_WAIT_L(0); PG8_BAR; PG8_MMA(1, 0, At, B0); PG8_MMA(1, 1, At, B1); PG8_BAR; PG8_SCHED;
            } else {
            PG8_LDB(B0, 0, 0); PG8_SCHED; PG8_LDA(At, 0, 0); PG8_STAGE(PG8_SA(1, 1), a1 + hstep, voffA);
            PG8_WAIT_L(8); PG8_BAR; PG8_WAIT_L(0); PG8_MMA(0, 0, At, B0); PG8_BAR; PG8_SCHED;
            PG8_LDB(B1, 0, 1); PG8_STAGE(PG8_SB(0, 0), b2, voffB);
            PG8_BAR; PG8_WAIT_L(0); PG8_MMA(0, 1, At, B1); PG8_BAR;
            PG8_LDA(At, 0, 1); PG8_STAGE(PG8_SA(0, 0), a2, voffA);
            PG8_BAR; PG8_WAIT_L(0); PG8_MMA(1, 0, At, B0); PG8_BAR; PG8_SCHED;
            PG8_STAGE(PG8_SB(0, 1), b2 + hstep, voffB);
            PG8_WAIT_V(6); PG8_BAR; PG8_MMA(1, 1, At, B1); PG8_BAR;
            PG8_LDB(B0, 1, 0); PG8_SCHED; PG8_LDA(At, 1, 0); PG8_STAGE(PG8_SA(0, 1), a2 + hstep, voffA);
            PG8_WAIT_L(8); PG8_BAR; PG8_WAIT_L(0); PG8_MMA(0, 0, At, B0); PG8_BAR; PG8_SCHED;
            PG8_LDB(B1, 1, 1); PG8_STAGE(PG8_SB(1, 0), b3, voffB);
            PG8_BAR; PG8_WAIT_L(0); PG8_MMA(0, 1, At, B1); PG8_BAR;
            PG8_LDA(At, 1, 1); PG8_STAGE(PG8_SA(1, 0), a3, voffA);
            PG8_BAR; PG8_WAIT_L(0); PG8_MMA(1, 0, At, B0); PG8_BAR; PG8_SCHED;
            PG8_STAGE(PG8_SB(1, 1), b3 + hstep, voffB);
            PG8_WAIT_V(6); PG8_BAR; PG8_MMA(1, 1, At, B1); PG8_BAR;
            }
        }
        if constexpr (ALIGN_EPI) { if (wr == 0) PG8_BAR; }
        if constexpr (!Epi::AFTER_DRAIN) { E(acc, cur, wr, wc, fr, fq); S.done(cur); }
        if (!has_next) break;
#pragma unroll
        for (int a = 0; a < 2; ++a)
#pragma unroll
            for (int b = 0; b < 2; ++b)
#pragma unroll
                for (int m = 0; m < 4; ++m)
#pragma unroll
                    for (int n = 0; n < 2; ++n) acc[a][b][m][n] = (f32x4){0.f, 0.f, 0.f, 0.f};
        cur = nxt; cA = nA; cB = nB; ++ui;
        if constexpr (ALIGN_EPI) { if (wr == 1) PG8_BAR; }
    }
    PG8_WAIT_V(0);
    if constexpr (!ALIGN_EPI) { if (wr == 0) PG8_BAR; }
    PG8_BAR;
    if constexpr (Epi::AFTER_DRAIN) { E.fused(acc, cur, wr, wc, fr, fq, lds, wid, lane); S.done(cur); }
#undef PG8_SA
#undef PG8_SB
#undef PG8_STAGE
#undef PG8_LDA
#undef PG8_LDB
#undef PG8_MMA
#undef PG8_WAIT_V
#undef PG8_WAIT_L
#undef PG8_BAR
#undef PG8_SCHED
}
}

namespace mk {
typedef unsigned short bf16;
typedef float f32x4 __attribute__((ext_vector_type(4)));
typedef float f32x2 __attribute__((ext_vector_type(2)));
typedef unsigned u32x4 __attribute__((ext_vector_type(4)));
typedef unsigned u32x2 __attribute__((ext_vector_type(2)));
typedef short bf16x8 __attribute__((ext_vector_type(8)));
#define LAS __attribute__((address_space(3)))

constexpr int NTOK = 16384, DM = 1024, SEQ = 8192, NBATCH = 2;
constexpr int QL = 384, KVL = 256, NINP = 1280;
constexpr float ALPHA = 1.18920711500272f;
constexpr float C2Q = 0.10206207261596575f * 1.4426950408889634f;
constexpr float XSC = 0.0625f * 1.4426950408889634f;
constexpr float LN_EPS = 1e-5f, RMS_EPS = 1e-6f;

constexpr size_t MiB = 1u << 20;
constexpr size_t WS_CTL = 0, CTL_ZERO_BYTES = 1 * MiB;
constexpr size_t W_WINT = 1 * MiB;
constexpr size_t W_WUQT = W_WINT + (size_t)1280 * 1024 * 2;
constexpr size_t W_WUKVT = W_WUQT + (size_t)768 * 384 * 2;
constexpr size_t W_WGLUT = W_WUKVT + (size_t)1024 * 256 * 2;
constexpr size_t W_WOUTT = W_WGLUT + (size_t)512 * 512 * 2;
constexpr size_t W_XKVT = W_WOUTT + (size_t)1024 * 1024 * 2;
constexpr size_t W_XQH = W_XKVT + (size_t)2048 * 1024 * 2;
constexpr size_t W_XOTH = W_XQH + (size_t)4 * 1024 * 256 * 2;
constexpr size_t W_MB = W_XOTH + (size_t)4 * 1024 * 256 * 2;
constexpr size_t W_VOT = W_MB + (size_t)2 * 1024 * 1024 * 2;
constexpr size_t W_K2V2 = W_VOT + (size_t)2 * 1024 * 1024 * 2;
constexpr size_t W_WQR = W_K2V2 + (size_t)2 * 2 * 4 * 256 * 256 * 2;
constexpr size_t W_SKP = W_WQR + (size_t)16 * 1024 * 256 * 2;
constexpr size_t W_WSC = W_SKP + (size_t)2 * 256 * 256 * 2;
constexpr size_t W_TH = W_WSC + (size_t)2048 * 1024 * 2;
constexpr size_t W_GM = W_TH + (size_t)32 * 512 * 640 * 2;
constexpr size_t W_MEMB = W_GM + (size_t)32 * 256 * 640 * 2;
constexpr size_t W_ROPE = W_MEMB + (size_t)512 * 1024 * 2;
constexpr size_t W_SSQ = W_ROPE + (size_t)16384 * 16 * 8;
constexpr size_t W_END = W_SSQ + (size_t)16384 * 20 * 4;
static_assert(W_END <= 80 * MiB, "weights region");
constexpr size_t A_UT = 80 * MiB, A_VT = 112 * MiB;
constexpr size_t A_SCHI = 80 * MiB;
constexpr size_t A_CQ = 144 * MiB, A_CKV = 156 * MiB, A_UP = 164 * MiB, A_QH = 184 * MiB, A_KH = 208 * MiB, A_VH = 232 * MiB, A_LS = 248 * MiB;
constexpr size_t A_OA = 144 * MiB, A_MIXN = 184 * MiB, A_X1 = 216 * MiB, A_P = 144 * MiB, A_X2 = 176 * MiB, A_IDS = 144 * MiB, A_GATES = 152 * MiB;
constexpr size_t WS_NEED = 256 * MiB;
constexpr size_t O_XB = 0, O_YS = 0, O_OS = 16 * MiB;
constexpr int CW_TMO = 0, CW_BAR = 4096, CW_SSQQ = 16384, CW_SSQKV = 32768, CW_DBG = 65536;
constexpr int RING_BYTES = 131072, EXCH_OFF = 131072, MISC_OFF = EXCH_OFF + 8192, LDS_BYTES = 147456;

__device__ __forceinline__ unsigned cvtpk(float lo, float hi) { unsigned r; asm volatile("v_cvt_pk_bf16_f32 %0, %1, %2" : "=v"(r) : "v"(lo), "v"(hi)); return r; }
__device__ __forceinline__ u32x4 pack8(f32x4 a, f32x4 b) { u32x4 w; w.x = cvtpk(a[0], a[1]); w.y = cvtpk(a[2], a[3]); w.z = cvtpk(b[0], b[1]); w.w = cvtpk(b[2], b[3]); return w; }
__device__ __forceinline__ float bflo(unsigned w) { return __uint_as_float(w << 16); }
__device__ __forceinline__ float bfhi(unsigned w) { return __uint_as_float(w & 0xffff0000u); }
__device__ __forceinline__ void unpack8(u32x4 w, f32x4& a, f32x4& b) { a = (f32x4){bflo(w.x), bfhi(w.x), bflo(w.y), bfhi(w.y)}; b = (f32x4){bflo(w.z), bfhi(w.z), bflo(w.w), bfhi(w.w)}; }
__device__ __forceinline__ float gelu_tanh(float v) {
    const float z = v * (1.0f + 0.044715f * v * v) * (-2.0f * 0.7978845608028654f * 1.4426950408889634f);
    return v * __builtin_amdgcn_rcpf(1.0f + __builtin_amdgcn_exp2f(z));
}
__device__ __forceinline__ float sigmoidf_(float z) { return __builtin_amdgcn_rcpf(1.0f + __builtin_amdgcn_exp2f(-1.4426950408889634f * z)); }

template <class Dec> struct ListSched {
    int n, G, c; Dec dec;
    __device__ __forceinline__ bool next(int i, pg8::Unit& u) const { const long L = (long)i * G + c; if (L >= n) return false; dec((int)L, u); return true; }
    __device__ __forceinline__ void a_ready(const pg8::Unit&) const {}
    __device__ __forceinline__ void done(const pg8::Unit&) const {}
};
struct BigSched {
    pg8::StaticOrder so; int bt;
    __device__ __forceinline__ bool next(int i, pg8::Unit& u) const { if (!so.next(i, u)) return false; u.pn += (u.pm >> 5) * bt; return true; }
    __device__ __forceinline__ void a_ready(const pg8::Unit&) const {}
    __device__ __forceinline__ void done(const pg8::Unit&) const {}
};
struct DecLS  { __device__ __forceinline__ void operator()(int L, pg8::Unit& u) const { const int g = L >> 1, b = L & 1; u.pm = 2 * g + b; u.pn = g; } };
struct DecY   { __device__ __forceinline__ void operator()(int L, pg8::Unit& u) const { const int g = L >> 2, b = (L >> 1) & 1, n = L & 1; u.pm = 2 * g + b; u.pn = 2 * g + n; } };
struct DecKV2 { __device__ __forceinline__ void operator()(int L, pg8::Unit& u) const { u.pm = L >> 3; u.pn = L & 7; } };
struct DecMb  { __device__ __forceinline__ void operator()(int L, pg8::Unit& u) const { const int bh = L >> 2, kt = L & 3; u.pm = bh; u.pn = (bh & 3) * 4 + kt; } };
struct DecVOT { __device__ __forceinline__ void operator()(int L, pg8::Unit& u) const { const int bh = L >> 2, ct = L & 3; u.pm = (bh & 3) * 4 + ct; u.pn = bh; } };
struct DecWsc { __device__ __forceinline__ void operator()(int L, pg8::Unit& u) const { const int hh = L >> 2, kt = L & 3; u.pm = hh & 1; u.pn = hh * 4 + kt; } };

typedef f32x4 AccT[2][2][4][2];
#define EPI_ROWS_BEGIN _Pragma("unroll") for (int ai = 0; ai < 2; ++ai) _Pragma("unroll") for (int m = 0; m < 4; ++m) { const int rt = ai * 128 + wr * 64 + m * 16 + fr;
#define EPI_ROWS_END asm volatile("" ::: "memory"); }

__device__ __forceinline__ void rope8(f32x4& v0, f32x4& v1, const float2* cs) {
#pragma unroll
    for (int j = 0; j < 4; ++j) { const float2 c = cs[j]; const float a = v0[j], b = v1[j]; v0[j] = a * c.x - b * c.y; v1[j] = b * c.x + a * c.y; }
}

struct EpiWin {
    static constexpr bool PERM = true, AFTER_DRAIN = false;
    bf16* CQ; bf16* CKV; bf16* KH; bf16* UP; const float2* rope; float* ssqp;
    __device__ __forceinline__ void operator()(AccT& acc, const pg8::Unit& u, int wr, int wc, int fr, int fq) const { asm volatile("" : "+v"(fr), "+v"(fq));
#pragma unroll
        for (int bj = 0; bj < 2; ++bj) {
            const int s = 8 * u.pn + 4 * bj + wc;
            if (s >= 21 && s < 24) continue;
            const int c0 = 32 * s + 8 * fq;
            EPI_ROWS_BEGIN {
                const int t = u.pm * 256 + rt; f32x4 v0 = acc[ai][bj][m][0], v1 = acc[ai][bj][m][1];
                if (s < 20) {
                    float q = (v0[0] * v0[0] + v0[1] * v0[1]) + (v0[2] * v0[2] + v0[3] * v0[3]) + (v1[0] * v1[0] + v1[1] * v1[1]) + (v1[2] * v1[2] + v1[3] * v1[3]);
                    q += __shfl_xor(q, 16); q += __shfl_xor(q, 32);
                    if (fq == 0) ssqp[(size_t)t * 20 + s] = q;
                    if (s < 12) *(u32x4*)(CQ + (size_t)t * QL + c0) = pack8(v0, v1);
                    else *(u32x4*)(CKV + (size_t)t * KVL + (c0 - 384)) = pack8(v0, v1);
                } else if (s == 20) {
                    rope8(v0, v1, rope + (size_t)t * 16 + 4 * fq);
                    const u32x4 w = pack8(v0, v1); const int b = t >> 13, tl = t & 8191;
#pragma unroll
                    for (int h = 0; h < 8; ++h) *(u32x4*)(KH + ((size_t)(b * 8 + h) * SEQ + tl) * 96 + 64 + 8 * fq) = w;
                } else {
                    const int ch = c0 - 768, g = ch >> 4, h8 = ch & 15, b = t >> 13, tl = t & 8191, chunk = b * 256 + (tl >> 5), j = tl & 31;
                    *(u32x4*)(UP + ((size_t)(g * 512 + chunk) * 640) + j * 16 + h8) = pack8(v0, v1);
                }
            } EPI_ROWS_END
        }
    }
};
struct EpiQ {
    static constexpr bool PERM = true, AFTER_DRAIN = false;
    bf16* QH; const float2* rope; const float* ssqp;
    __device__ __forceinline__ void operator()(AccT& acc, const pg8::Unit& u, int wr, int wc, int fr, int fq) const { asm volatile("" : "+v"(fr), "+v"(fq));
#pragma unroll
        for (int bj = 0; bj < 2; ++bj) {
            const int s = 8 * u.pn + 4 * bj + wc, h = s / 3, sl = s - 3 * h, d0 = sl * 32 + 8 * fq;
            EPI_ROWS_BEGIN {
                const int t = u.pm * 256 + rt; const f32x4 qa = *(const f32x4*)(ssqp + (size_t)t * 20), qb = *(const f32x4*)(ssqp + (size_t)t * 20 + 4), qc = *(const f32x4*)(ssqp + (size_t)t * 20 + 8);
                const float sq = ((qa[0] + qa[1]) + (qa[2] + qa[3])) + ((qb[0] + qb[1]) + (qb[2] + qb[3])) + ((qc[0] + qc[1]) + (qc[2] + qc[3]));
                const float rq = rsqrtf(sq * (1.0f / QL) + RMS_EPS) * C2Q;
                f32x4 v0 = acc[ai][bj][m][0] * rq, v1 = acc[ai][bj][m][1] * rq;
                if (sl == 2) rope8(v0, v1, rope + (size_t)t * 16 + 4 * fq);
                const int b = t >> 13, tl = t & 8191;
                *(u32x4*)(QH + ((size_t)(b * 8 + h) * SEQ + tl) * 96 + d0) = pack8(v0, v1);
            } EPI_ROWS_END
        }
    }
};
struct EpiKV {
    static constexpr bool PERM = true, AFTER_DRAIN = false;
    bf16* KH; bf16* VH; const float* ssqp;
    __device__ __forceinline__ void operator()(AccT& acc, const pg8::Unit& u, int wr, int wc, int fr, int fq) const { asm volatile("" : "+v"(fr), "+v"(fq));
#pragma unroll
        for (int bj = 0; bj < 2; ++bj) {
            const int s = 8 * u.pn + 4 * bj + wc, h = s >> 2, sl = s & 3, j0 = sl * 32 + 8 * fq;
            EPI_ROWS_BEGIN {
                const int t = u.pm * 256 + rt; const f32x4 qa = *(const f32x4*)(ssqp + (size_t)t * 20 + 12), qb = *(const f32x4*)(ssqp + (size_t)t * 20 + 16);
                const float rk = rsqrtf((((qa[0] + qa[1]) + (qa[2] + qa[3])) + ((qb[0] + qb[1]) + (qb[2] + qb[3]))) * (1.0f / KVL) + RMS_EPS);
                const f32x4 v0 = acc[ai][bj][m][0] * rk, v1 = acc[ai][bj][m][1] * rk; const int b = t >> 13, tl = t & 8191;
                if (sl < 2) *(u32x4*)(KH + ((size_t)(b * 8 + h) * SEQ + tl) * 96 + j0) = pack8(v0, v1);
                else *(u32x4*)(VH + ((size_t)(b * 8 + h) * SEQ + tl) * 64 + (j0 - 64)) = pack8(v0, v1);
            } EPI_ROWS_END
        }
    }
};
struct EpiLS {
    static constexpr bool PERM = false, AFTER_DRAIN = false;
    float* LS;
    __device__ __forceinline__ void operator()(AccT& acc, const pg8::Unit& u, int wr, int wc, int fr, int fq) const { asm volatile("" : "+v"(fr), "+v"(fq));
        const int g = u.pn, b = u.pm & 1;
        EPI_ROWS_BEGIN {
            float* rowp = LS + ((size_t)(g * 512 + b * 256 + rt)) * 128 + wc * 32 + 4 * fq;
            *(f32x4*)(rowp) = acc[ai][0][m][0]; *(f32x4*)(rowp + 16) = acc[ai][0][m][1];
        } EPI_ROWS_END
    }
};
struct EpiY {
    static constexpr bool PERM = true, AFTER_DRAIN = false;
    bf16* YS;
    __device__ __forceinline__ void operator()(AccT& acc, const pg8::Unit& u, int wr, int wc, int fr, int fq) const { asm volatile("" : "+v"(fr), "+v"(fq));
        const int g = u.pm >> 1, b = u.pm & 1, nt = u.pn & 1;
#pragma unroll
        for (int bj = 0; bj < 2; ++bj) {
            const int n0 = nt * 256 + bj * 128 + wc * 32 + 8 * fq, i = n0 >> 4, h8 = n0 & 15;
            EPI_ROWS_BEGIN {
                const int t = b * SEQ + rt * 32 + i; f32x4 v0 = acc[ai][bj][m][0], v1 = acc[ai][bj][m][1];
#pragma unroll
                for (int j = 0; j < 4; ++j) { v0[j] = gelu_tanh(v0[j]); v1[j] = gelu_tanh(v1[j]); }
                *(u32x4*)(YS + (size_t)t * 512 + g * 16 + h8) = pack8(v0, v1);
            } EPI_ROWS_END
        }
    }
};
struct EpiGlu {
    static constexpr bool PERM = true, AFTER_DRAIN = false;
    const bf16* YS; bf16* OS; const float* bglu;
    __device__ __forceinline__ void operator()(AccT& acc, const pg8::Unit& u, int wr, int wc, int fr, int fq) const { asm volatile("" : "+v"(fr), "+v"(fq));
#pragma unroll
        for (int bj = 0; bj < 2; ++bj) {
            const int c0 = u.pn * 256 + bj * 128 + wc * 32 + 8 * fq;
            const f32x4 b0 = *(const f32x4*)(bglu + c0), b1 = *(const f32x4*)(bglu + c0 + 4);
            EPI_ROWS_BEGIN {
                const int t = u.pm * 256 + rt; f32x4 y0, y1; unpack8(*(const u32x4*)(YS + (size_t)t * 512 + c0), y0, y1);
                f32x4 z0 = acc[ai][bj][m][0] + b0, z1 = acc[ai][bj][m][1] + b1;
#pragma unroll
                for (int j = 0; j < 4; ++j) { z0[j] = y0[j] * sigmoidf_(z0[j]); z1[j] = y1[j] * sigmoidf_(z1[j]); }
                *(u32x4*)(OS + (size_t)t * 512 + c0) = pack8(z0, z1);
            } EPI_ROWS_END
        }
    }
};
template <int MODE  > struct EpiPre {
    static constexpr bool PERM = false, AFTER_DRAIN = false;
    const float* resf; const bf16* resb; float* PRE;
    __device__ __forceinline__ void operator()(AccT& acc, const pg8::Unit& u, int wr, int wc, int fr, int fq) const { asm volatile("" : "+v"(fr), "+v"(fq));
        const int cb = (u.pn & 3) * 256 + wc * 32 + 4 * fq;
        EPI_ROWS_BEGIN {
            const size_t ro = (size_t)(u.pm * 256 + rt) * DM + cb;
#pragma unroll
            for (int bj = 0; bj < 2; ++bj)
#pragma unroll
                for (int n = 0; n < 2; ++n) { const size_t o = ro + bj * 128 + n * 16; f32x4 r;
                    if (MODE == 0) r = *(const f32x4*)(resf + o);
                    else { const u32x2 w = *(const u32x2*)(resb + o); r = (f32x4){bflo(w.x), bfhi(w.x), bflo(w.y), bfhi(w.y)}; }
                    *(f32x4*)(PRE + o) = r * ALPHA + acc[ai][bj][m][n]; }
        } EPI_ROWS_END
    }
};
struct EpiXS {
    static constexpr bool PERM = true, AFTER_DRAIN = false;
    bf16* P; LAS unsigned char* lds;
    __device__ __forceinline__ void operator()(AccT& acc, const pg8::Unit& u, int wr, int wc, int fr, int fq) const { asm volatile("" : "+v"(fr), "+v"(fq));
        LAS float* exm = (LAS float*)(lds + EXCH_OFF); LAS float* exs = exm + 1024;
        EPI_ROWS_BEGIN {
            float mx = -3.0e38f;
#pragma unroll
            for (int bj = 0; bj < 2; ++bj)
#pragma unroll
                for (int n = 0; n < 2; ++n) { const f32x4 x = acc[ai][bj][m][n]; mx = fmaxf(mx, fmaxf(fmaxf(x[0], x[1]), fmaxf(x[2], x[3]))); }
            mx = fmaxf(mx, __shfl_xor(mx, 16)); mx = fmaxf(mx, __shfl_xor(mx, 32));
            if (fq == 0) exm[rt * 4 + wc] = mx;
        } EPI_ROWS_END
        asm volatile("s_waitcnt lgkmcnt(0)" ::: "memory"); __builtin_amdgcn_s_barrier(); asm volatile("" ::: "memory");
        EPI_ROWS_BEGIN {
            const f32x4 mm = *(const LAS f32x4*)(exm + rt * 4); const float M = fmaxf(fmaxf(mm[0], mm[1]), fmaxf(mm[2], mm[3])); float s = 0.f;
#pragma unroll
            for (int bj = 0; bj < 2; ++bj)
#pragma unroll
                for (int n = 0; n < 2; ++n) { f32x4 x = acc[ai][bj][m][n];
#pragma unroll
                    for (int j = 0; j < 4; ++j) { x[j] = __builtin_amdgcn_exp2f(x[j] - M); s += x[j]; }
                    acc[ai][bj][m][n] = x; }
            s += __shfl_xor(s, 16); s += __shfl_xor(s, 32);
            if (fq == 0) exs[rt * 4 + wc] = s;
        } EPI_ROWS_END
        asm volatile("s_waitcnt lgkmcnt(0)" ::: "memory"); __builtin_amdgcn_s_barrier(); asm volatile("" ::: "memory");
        const int cb = (u.pn & 3) * 256 + wc * 32 + 8 * fq;
        EPI_ROWS_BEGIN {
            const f32x4 ss = *(const LAS f32x4*)(exs + rt * 4); const float inv = __builtin_amdgcn_rcpf((ss[0] + ss[1]) + (ss[2] + ss[3]));
            bf16* rowp = P + (size_t)(u.pm * 256 + rt) * DM + cb;
#pragma unroll
            for (int bj = 0; bj < 2; ++bj) *(u32x4*)(rowp + bj * 128) = pack8(acc[ai][bj][m][0] * inv, acc[ai][bj][m][1] * inv);
        } EPI_ROWS_END
    }
};
struct EpiSC {
    static constexpr bool PERM = false, AFTER_DRAIN = false;
    float* SCLO; float* SCHI;
    __device__ __forceinline__ void operator()(AccT& acc, const pg8::Unit& u, int wr, int wc, int fr, int fq) const { asm volatile("" : "+v"(fr), "+v"(fq));
        float* base = (u.pn < 4 ? SCLO : SCHI) + (u.pn & 3) * 256 + wc * 32 + 4 * fq;
        EPI_ROWS_BEGIN {
            float* rowp = base + (size_t)(u.pm * 256 + rt) * 1024;
#pragma unroll
            for (int bj = 0; bj < 2; ++bj)
#pragma unroll
                for (int n = 0; n < 2; ++n) *(f32x4*)(rowp + bj * 128 + n * 16) = acc[ai][bj][m][n];
        } EPI_ROWS_END
    }
};
struct EpiK2V2 {
    static constexpr bool PERM = true, AFTER_DRAIN = false;
    bf16* O;
    __device__ __forceinline__ void operator()(AccT& acc, const pg8::Unit& u, int wr, int wc, int fr, int fq) const { asm volatile("" : "+v"(fr), "+v"(fq));
        const int b = u.pm, kv = u.pn >> 2, h = u.pn & 3;
        EPI_ROWS_BEGIN {
            bf16* rowp = O + ((size_t)(((kv * 2 + b) * 4 + h) * 256 + rt)) * 256 + wc * 32 + 8 * fq;
#pragma unroll
            for (int bj = 0; bj < 2; ++bj) *(u32x4*)(rowp + bj * 128) = pack8(acc[ai][bj][m][0], acc[ai][bj][m][1]);
        } EPI_ROWS_END
    }
};
struct EpiMb {
    static constexpr bool PERM = true, AFTER_DRAIN = false;
    bf16* O;
    __device__ __forceinline__ void operator()(AccT& acc, const pg8::Unit& u, int wr, int wc, int fr, int fq) const { asm volatile("" : "+v"(fr), "+v"(fq));
        const int b = u.pm >> 2, h = u.pm & 3, kt = u.pn & 3;
        EPI_ROWS_BEGIN {
            bf16* rowp = O + ((size_t)(b * 1024 + h * 256 + rt)) * 1024 + kt * 256 + wc * 32 + 8 * fq;
#pragma unroll
            for (int bj = 0; bj < 2; ++bj) *(u32x4*)(rowp + bj * 128) = pack8(acc[ai][bj][m][0] * XSC, acc[ai][bj][m][1] * XSC);
        } EPI_ROWS_END
    }
};
struct EpiVOT {
    static constexpr bool PERM = true, AFTER_DRAIN = false;
    bf16* O;
    __device__ __forceinline__ void operator()(AccT& acc, const pg8::Unit& u, int wr, int wc, int fr, int fq) const { asm volatile("" : "+v"(fr), "+v"(fq));
        const int h = u.pm >> 2, ct = u.pm & 3, b = u.pn >> 2;
        EPI_ROWS_BEGIN {
            bf16* rowp = O + ((size_t)(b * 1024 + ct * 256 + rt)) * 1024 + h * 256 + wc * 32 + 8 * fq;
#pragma unroll
            for (int bj = 0; bj < 2; ++bj) *(u32x4*)(rowp + bj * 128) = pack8(acc[ai][bj][m][0], acc[ai][bj][m][1]);
        } EPI_ROWS_END
    }
};
struct EpiWsc {
    static constexpr bool PERM = true, AFTER_DRAIN = false;
    bf16* O;
    __device__ __forceinline__ void operator()(AccT& acc, const pg8::Unit& u, int wr, int wc, int fr, int fq) const { asm volatile("" : "+v"(fr), "+v"(fq));
        const int hh = u.pn >> 2, kt = u.pn & 3;
#pragma unroll
        for (int m = 0; m < 4; ++m) { const int key = wr * 64 + m * 16 + fr;
            bf16* rowp = O + ((size_t)(hh * 128 + key)) * 1024 + kt * 256 + wc * 32 + 8 * fq;
#pragma unroll
            for (int bj = 0; bj < 2; ++bj) *(u32x4*)(rowp + bj * 128) = pack8(acc[0][bj][m][0], acc[0][bj][m][1]); }
    }
};
}
namespace att {
typedef unsigned short bf16;
typedef short bf16x8 __attribute__((ext_vector_type(8)));
typedef short s16x4 __attribute__((ext_vector_type(4)));
typedef float f32x16 __attribute__((ext_vector_type(16)));
typedef float f32x4 __attribute__((ext_vector_type(4)));
typedef unsigned u32x4 __attribute__((ext_vector_type(4)));
constexpr int DQ = 96, DV = 64, NW = 8, QBLK = 32, KVBLK = 64, QB = NW * QBLK, SEQ = 8192, OPITCH = 512;
constexpr int SHM_V = 16384, SHM_K = 16384;
constexpr int LDS_BYTES = 2 * SHM_V + 2 * SHM_K + NW * 64 * 4;
constexpr float THR = 8.f;
constexpr unsigned WBIG = 0x7fffffffu;

#define KSWZ(row, colB) ((row) * 256 + ((colB) ^ (((row) & 7) << 4)))
#define SBAR() __builtin_amdgcn_sched_barrier(0)
__device__ __forceinline__ int v_st(int k, int c) { const int kk = (k & ~0xC) | ((k & 4) << 1) | ((k & 8) >> 1); return ((kk >> 3) * 4 + (c >> 5)) * 512 + ((kk & 7) * 32 + (c & 31)) * 2; }
__device__ __forceinline__ int v_rd_base(int lane) { return ((lane & 3) << 3) | (((lane >> 2) & 3) << 6) | (((lane >> 4) & 1) << 5) | (((lane >> 5) & 1) << 8); }
constexpr int v_rd_off(int d0, int ks, int half) { return d0 * 512 + ks * 4096 + half * 2048; }
__device__ __forceinline__ int crow(int r, int hi) { return (r & 3) + 8 * (r >> 2) + 4 * hi; }
__device__ __forceinline__ unsigned cvtpk(float lo, float hi) { unsigned r; asm volatile("v_cvt_pk_bf16_f32 %0, %1, %2" : "=v"(r) : "v"(lo), "v"(hi)); return r; }

__device__ __forceinline__ void mask_tile(f32x16& p0, f32x16& p1, int dq, unsigned W) {
    const float NEG = -__builtin_inff();
#pragma unroll
    for (int r = 0; r < 16; ++r) {
        const int c = (r & 3) + 8 * (r >> 2);
        if ((unsigned)(dq - c) >= W) p0[r] = NEG;
        if ((unsigned)(dq - c - 32) >= W) p1[r] = NEG;
    }
}
__device__ __forceinline__ void partialSM(f32x16& p0, f32x16& p1, float& m_reg, float& mn, float& alpha) {
    float pmax = p0[0];
#pragma unroll
    for (int r = 1; r < 16; ++r) pmax = fmaxf(pmax, p0[r]);
#pragma unroll
    for (int r = 0; r < 16; ++r) pmax = fmaxf(pmax, p1[r]);
    { auto rr = __builtin_amdgcn_permlane32_swap(__float_as_uint(pmax), __float_as_uint(pmax), false, false);
      pmax = fmaxf(__uint_as_float(rr[0]), __uint_as_float(rr[1])); }
    if (__builtin_expect(__all((pmax - m_reg) <= THR), 1)) { mn = m_reg; alpha = 1.f; }
    else { mn = fmaxf(m_reg, pmax); alpha = __builtin_amdgcn_exp2f(m_reg - mn); m_reg = mn; }
#pragma unroll
    for (int r = 0; r < 16; ++r) p0[r] = p0[r] - mn;
#pragma unroll
    for (int r = 0; r < 16; ++r) p1[r] = p1[r] - mn;
#pragma unroll
    for (int r = 0; r < 16; ++r) p0[r] = __builtin_amdgcn_exp2f(p0[r]);
}
__device__ __forceinline__ void finishSM(f32x16& p0, f32x16& p1, float alpha, float& l_reg, bf16x8& pa0, bf16x8& pa1, bf16x8& pa2, bf16x8& pa3) {
#pragma unroll
    for (int r = 0; r < 16; ++r) p1[r] = __builtin_amdgcn_exp2f(p1[r]);
    float ps = 0;
#pragma unroll
    for (int r = 0; r < 16; ++r) ps += p0[r];
#pragma unroll
    for (int r = 0; r < 16; ++r) ps += p1[r];
    { auto rr = __builtin_amdgcn_permlane32_swap(__float_as_uint(ps), __float_as_uint(ps), false, false);
      ps = __uint_as_float(rr[0]) + __uint_as_float(rr[1]); }
    l_reg = l_reg * alpha + ps;
#define PK4(P, B_, OUT) do { unsigned a0 = cvtpk(P[B_+0], P[B_+1]), a1 = cvtpk(P[B_+2], P[B_+3]);                          \
        unsigned b0 = cvtpk(P[B_+4], P[B_+5]), b1 = cvtpk(P[B_+6], P[B_+7]);                                             \
        auto r0 = __builtin_amdgcn_permlane32_swap(a0, b0, false, false); auto r1 = __builtin_amdgcn_permlane32_swap(a1, b1, false, false); \
        u32x4 w = {r0[0], r1[0], r0[1], r1[1]}; OUT = *reinterpret_cast<bf16x8*>(&w); } while (0)
    PK4(p0, 0, pa0); PK4(p0, 8, pa1); PK4(p1, 0, pa2); PK4(p1, 8, pa3);
#undef PK4
}
template <int KB>
__device__ __forceinline__ void qkt(f32x16& p0, f32x16& p1, const char* K_lds, int r32, int hi, const bf16x8* qr) {
    p0 = f32x16{}; p1 = f32x16{};
    const char* kb[4];
#pragma unroll
    for (int dd = 0; dd < 4; ++dd) kb[dd] = K_lds + KB * SHM_K + KSWZ(r32, (dd * 16 + hi * 8) * 2);
#pragma unroll
    for (int d0 = 0; d0 < 6; ++d0) { const char* a = kb[d0 & 3] + (d0 >> 2) * 128;
        bf16x8 b0 = *reinterpret_cast<const bf16x8*>(a);
        bf16x8 b1 = *reinterpret_cast<const bf16x8*>(a + 32 * 256);
        p0 = __builtin_amdgcn_mfma_f32_32x32x16_bf16(b0, qr[d0], p0, 0, 0, 0);
        p1 = __builtin_amdgcn_mfma_f32_32x32x16_bf16(b1, qr[d0], p1, 0, 0, 0); }
}
template <int VB>
__device__ __forceinline__ void pv_tile(f32x16* o, int vb0, bf16x8 pa0, bf16x8 pa1, bf16x8 pa2, bf16x8 pa3) {
#define TRRD(dst, off) asm volatile("ds_read_b64_tr_b16 %0, %1 offset:%2" : "=&v"(dst) : "v"(vb0), "i"(off) : "memory")
#define PV_D0(d0) do { s16x4 l0, l1, l2, l3, h0, h1, h2, h3; constexpr int b_ = VB * SHM_V + v_rd_off(d0, 0, 0); \
        TRRD(l0, b_); TRRD(h0, b_ + 2048); TRRD(l1, b_ + 4096); TRRD(h1, b_ + 6144); TRRD(l2, b_ + 8192); TRRD(h2, b_ + 10240); TRRD(l3, b_ + 12288); TRRD(h3, b_ + 14336); \
        asm volatile("s_waitcnt lgkmcnt(0)" ::: "memory"); SBAR(); \
        o[d0] = __builtin_amdgcn_mfma_f32_32x32x16_bf16(pa0, (bf16x8){l0[0], l0[1], l0[2], l0[3], h0[0], h0[1], h0[2], h0[3]}, o[d0], 0, 0, 0);   \
        o[d0] = __builtin_amdgcn_mfma_f32_32x32x16_bf16(pa1, (bf16x8){l1[0], l1[1], l1[2], l1[3], h1[0], h1[1], h1[2], h1[3]}, o[d0], 0, 0, 0);   \
        o[d0] = __builtin_amdgcn_mfma_f32_32x32x16_bf16(pa2, (bf16x8){l2[0], l2[1], l2[2], l2[3], h2[0], h2[1], h2[2], h2[3]}, o[d0], 0, 0, 0);   \
        o[d0] = __builtin_amdgcn_mfma_f32_32x32x16_bf16(pa3, (bf16x8){l3[0], l3[1], l3[2], l3[3], h3[0], h3[1], h3[2], h3[3]}, o[d0], 0, 0, 0); } while (0)
    PV_D0(0); PV_D0(1);
#undef PV_D0
#undef TRRD
}

struct BlockRef { const bf16* Q; const bf16* K; const bf16* V; bf16* O; int P0; };
struct Seam { bf16x8 qr[6]; bf16x8 st_v0, st_k0, st_k1; };
#define KROW(p, k0, rr) ((p) + (size_t)((k0) + (rr)) * DQ + scl)
#define VROW(p, k0) ((p) + (size_t)((k0) + vr) * DV + vc)
#define VMW() asm volatile("s_waitcnt vmcnt(0)" ::: "memory")
#define VMWN(n) asm volatile("s_waitcnt vmcnt(%0)" :: "i"(n) : "memory")
#define SLOAD_H(Kp, Vp, k0) do { S.st_v0 = *reinterpret_cast<const bf16x8*>(VROW(Vp, k0)); \
                         S.st_k0 = *reinterpret_cast<const bf16x8*>(KROW(Kp, k0, sr)); S.st_k1 = *reinterpret_cast<const bf16x8*>(KROW(Kp, k0, 32 + sr)); } while (0)
#define SWRITE_HK(bf) do { *(bf16x8*)(K_lds + (bf) * SHM_K + kws) = S.st_k0; *(bf16x8*)(K_lds + (bf) * SHM_K + kws + 32 * 256) = S.st_k1; } while (0)
#define SWRITE_HV(bf) do { *(bf16x8*)(V_lds + (bf) * SHM_V + vst0) = S.st_v0; } while (0)
#define SWRITE_H(bf) do { SWRITE_HV(bf); SWRITE_HK(bf); } while (0)
__device__ __forceinline__ void attn_prime(const BlockRef& cur, char* lds, Seam& S) {
    int tid_ = threadIdx.x; asm volatile("" : "+v"(tid_)); const int tid = tid_, wid = __builtin_amdgcn_readfirstlane(tid >> 6), lane = tid & 63, r32 = lane & 31, hi = lane >> 5;
    const int sr = tid >> 4, sc = (tid & 15) * 8, scl = sc < DQ ? sc : DQ - 8, kws = KSWZ(sr, sc * 2), vr = tid >> 3, vc = (tid & 7) * 8; char* K_lds = lds + 2 * SHM_V;
#pragma unroll
    for (int d0 = 0; d0 < 6; ++d0) S.qr[d0] = *reinterpret_cast<const bf16x8*>(cur.Q + (size_t)(wid * QBLK + r32) * DQ + d0 * 16 + hi * 8);
    SLOAD_H(cur.K, cur.V, 0); VMW(); SWRITE_HK(0);
    __syncthreads();
}
__device__ __forceinline__ void attn_block(const BlockRef& cur, const BlockRef& nxt, char* lds, Seam& S) {
    int tid_ = threadIdx.x; asm volatile("" : "+v"(tid_)); const int tid = tid_, wid = __builtin_amdgcn_readfirstlane(tid >> 6), lane = tid & 63, r32 = lane & 31, hi = lane >> 5;
    const int NT = (cur.P0 + QB - 1) / KVBLK + 1;
    const int qlo = cur.P0 + wid * QBLK, qm = qlo + r32 - 4 * hi;
    char* V_lds = lds; char* K_lds = lds + 2 * SHM_V;
    float* ws = (float*)(lds + 2 * SHM_V + 2 * SHM_K) + wid * 64; float* li_l = ws, * al_l = ws + 32;
    float m_reg = -1e30f, l_reg = 0; f32x16 o[2] = {};
    const int sr = tid >> 4, sc = (tid & 15) * 8, scl = sc < DQ ? sc : DQ - 8, kws = KSWZ(sr, sc * 2), vr = tid >> 3, vc = (tid & 7) * 8, vst0 = v_st(vr, vc);
    const int vb0 = (int)(uintptr_t)V_lds + v_rd_base(lane);
    const bf16* Kh = cur.K; const bf16* Vh = cur.V;
#define RESC(a) do { if (__any((a) < 1.f)) { if (hi == 0) al_l[r32] = (a); asm volatile("s_waitcnt lgkmcnt(0)" ::: "memory");              \
                     _Pragma("unroll") for (int d_ = 0; d_ < 2; ++d_) _Pragma("unroll") for (int r = 0; r < 16; ++r) o[d_][r] *= al_l[crow(r, hi)]; } } while (0)
#define KBASE(t) ((t) * KVBLK)
#define MASKT(P0_, P1_, t) do { const int kb_ = KBASE(t); if (kb_ + KVBLK - 1 > qlo) mask_tile(P0_, P1_, qm - kb_, WBIG); } while (0)
    constexpr int NQL = 6;
#define SEAM_K0() do { VMWN(NQL); SWRITE_HK(0); SBAR(); } while (0)
    f32x16 pA0, pA1, pB0, pB1; float mnA, mnB, alA, alB; bf16x8 pa0, pa1, pa2, pa3;
    SWRITE_HV(0); SBAR();
    SLOAD_H(Kh, Vh, KBASE(1));
    SBAR(); qkt<0>(pA0, pA1, K_lds, r32, hi, S.qr);
    MASKT(pA0, pA1, 0); partialSM(pA0, pA1, m_reg, mnA, alA);
    VMW(); SWRITE_H(1);
    __syncthreads();
#define HALF_STEP(PX0, PX1, mnX, alX, PY0, PY1, alY, t, KB, VB, SB) do {                                                      \
        SBAR(); qkt<KB>(PX0, PX1, K_lds, r32, hi, S.qr);                                                                      \
        finishSM(PY0, PY1, alY, l_reg, pa0, pa1, pa2, pa3); SBAR();                                                           \
        if ((t) + 1 < NT) { SLOAD_H(Kh, Vh, KBASE((t) + 1)); SBAR(); }                                                        \
        pv_tile<VB>(o, vb0, pa0, pa1, pa2, pa3); MASKT(PX0, PX1, (t)); partialSM(PX0, PX1, m_reg, mnX, alX);                  \
        __syncthreads();                                                                                                      \
        if ((t) + 1 < NT) { VMW(); SWRITE_H(SB); }                                                                            \
        RESC(alX); __syncthreads(); } while (0)
    for (int t = 1; t + 1 < NT; t += 2) {
        HALF_STEP(pB0, pB1, mnB, alB, pA0, pA1, alA, t, 1, 0, 0);
        HALF_STEP(pA0, pA1, mnA, alA, pB0, pB1, alB, t + 1, 0, 1, 1);
    }
    SBAR(); qkt<1>(pB0, pB1, K_lds, r32, hi, S.qr); SBAR();
    SLOAD_H(nxt.K, nxt.V, 0); SBAR();
#pragma unroll
    for (int d0 = 0; d0 < 6; ++d0) S.qr[d0] = *reinterpret_cast<const bf16x8*>(nxt.Q + (size_t)(wid * QBLK + r32) * DQ + d0 * 16 + hi * 8);
    SBAR();
    finishSM(pA0, pA1, alA, l_reg, pa0, pa1, pa2, pa3); SBAR();
    pv_tile<0>(o, vb0, pa0, pa1, pa2, pa3);
    MASKT(pB0, pB1, NT - 1); partialSM(pB0, pB1, m_reg, mnB, alB); __syncthreads(); RESC(alB);
    finishSM(pB0, pB1, alB, l_reg, pa0, pa1, pa2, pa3); SBAR(); pv_tile<1>(o, vb0, pa0, pa1, pa2, pa3);
    SBAR(); SEAM_K0();
    if (hi == 0) li_l[r32] = l_reg; asm volatile("s_waitcnt lgkmcnt(0)" ::: "memory");
    float rli[16];
#pragma unroll
    for (int r = 0; r < 16; ++r) rli[r] = __builtin_amdgcn_rcpf(li_l[crow(r, hi)]);
    bf16* Ow = cur.O + (size_t)(wid * QBLK) * OPITCH;
#pragma unroll
    for (int r = 0; r < 16; ++r) { const int orow = crow(r, hi);
#pragma unroll
        for (int d0 = 0; d0 < 2; ++d0) { const float v = o[d0][r] * rli[r]; const float vn = __shfl_xor(v, 1);
            if ((r32 & 1) == 0) *(unsigned*)(Ow + (size_t)orow * OPITCH + d0 * 32 + r32) = cvtpk(v, vn); } }
    __syncthreads();
#undef RESC
#undef KBASE
#undef MASKT
#undef SEAM_K0
#undef HALF_STEP
}
#undef KROW
#undef VROW
#undef VMW
#undef VMWN
#undef SLOAD_H
#undef SWRITE_HK
#undef SWRITE_HV
#undef SWRITE_H
#undef KSWZ
#undef SBAR
}
using namespace mk;
typedef __attribute__((address_space(1))) unsigned gu32;
#define RLX_AGENT __ATOMIC_RELAXED, __HIP_MEMORY_SCOPE_AGENT
#define LDS_WAIT() asm volatile("s_waitcnt lgkmcnt(0)" ::: "memory")
#define VM_WAIT() asm volatile("s_waitcnt vmcnt(0)" ::: "memory")
constexpr int NWAVES = 8, NPH = 16;

#define XB_TMO      128
#define XB_XCNT(j)  (256  + 64 * (j))
#define XB_XSUB(j)  (1280 + 64 * (j))
#define XB_XGEN(j)  (2304 + 64 * (j))
#define XB_TOP      3328
#define XB_TOPGEN   3392
#define XCD_BAR_WORDS 3456
#define XB_SPIN_CAP (1u << 18)

__device__ __forceinline__ unsigned xb_ld(unsigned* p)              { return __hip_atomic_load(p, __ATOMIC_RELAXED, __HIP_MEMORY_SCOPE_AGENT); }
__device__ __forceinline__ unsigned xb_add(unsigned* p, unsigned v) { return __hip_atomic_fetch_add(p, v, __ATOMIC_RELAXED, __HIP_MEMORY_SCOPE_AGENT); }
__device__ __forceinline__ unsigned xb_xcc_id() { return (unsigned)__builtin_amdgcn_s_getreg((3 << 11) | 20) & 0xFu; }
#define XB_SPIN(cond, bar) do { unsigned _sp = 0; while (cond) { __builtin_amdgcn_s_sleep(1); \
    if ((++_sp & 255u) == 0u) { if (xb_ld(&(bar)[XB_TMO])) break; if (_sp > XB_SPIN_CAP) { atomicAdd(&(bar)[XB_TMO], 1u); break; } } } } while (0)

struct XcdBarrier {
    unsigned* bar; unsigned x;
    volatile LAS unsigned* st;
};

__device__ __forceinline__ XcdBarrier xcd_barrier_post(unsigned* bar, volatile LAS unsigned* st) {
    XcdBarrier b; b.bar = bar; b.x = xb_xcc_id(); b.st = st;
    if (threadIdx.x == 0) (void)xb_add(&bar[XB_XCNT(b.x)], 1u);
    return b;
}
__device__ __forceinline__ void xcd_barrier_complete(unsigned* bar, unsigned x, unsigned& nloc, unsigned& nx) {
    const unsigned G = gridDim.x * gridDim.y * gridDim.z;
    unsigned sum, cnt, mine, sp = 0u;
    for (;;) {
        sum = 0u; cnt = 0u; mine = 0u;
#pragma unroll
        for (unsigned j = 0; j < 16; ++j) { const unsigned c = xb_ld(&bar[XB_XCNT(j)]); sum += c; cnt += (c > 0u) ? 1u : 0u; mine = (j == x) ? c : mine; }
        if (sum == G) break;
        __builtin_amdgcn_s_sleep(1);
        if ((++sp & 255u) == 0u) { if (xb_ld(&bar[XB_TMO])) break; if (sp > XB_SPIN_CAP) { atomicAdd(&bar[XB_TMO], 1u); break; } }
    }
    nloc = mine > 0u ? mine : 1u; nx = cnt > 0u ? cnt : 1u;
}

__device__ __forceinline__ void xcd_barrier(const XcdBarrier& b) {
    asm volatile("s_waitcnt vmcnt(0)" ::: "memory");
    __syncthreads();
    if (threadIdx.x == 0) {
        unsigned* bar = b.bar;
        __builtin_amdgcn_s_waitcnt(0);
        unsigned nloc = b.st[0], nx = b.st[1];
        if (nloc == 0u) { xcd_barrier_complete(bar, b.x, nloc, nx); b.st[0] = nloc; b.st[1] = nx; }
        const unsigned old = xb_add(&bar[XB_XSUB(b.x)], 1u);
        const unsigned gen = old / nloc;
        if (old + 1u == (gen + 1u) * nloc) {
            __builtin_amdgcn_fence(__ATOMIC_RELEASE, "agent");
            asm volatile("s_waitcnt vmcnt(0)" ::: "memory");
            const unsigned og = xb_add(&bar[XB_TOP], 1u);
            const unsigned tg = og / nx;
            if (og + 1u == (tg + 1u) * nx) xb_add(&bar[XB_TOPGEN], 1u);
            else XB_SPIN(xb_ld(&bar[XB_TOPGEN]) == tg, bar);
            __builtin_amdgcn_fence(__ATOMIC_ACQUIRE, "agent");
            xb_add(&bar[XB_XGEN(b.x)], 1u);
            asm volatile("s_waitcnt vmcnt(0)" ::: "memory");
        } else {
            XB_SPIN(xb_ld(&bar[XB_XGEN(b.x)]) == gen, bar);
            __builtin_amdgcn_fence(__ATOMIC_ACQUIRE, "agent");
            asm volatile("s_waitcnt vmcnt(0)" ::: "memory");
        }
    }
    __syncthreads();
}


struct Args { const void* in[36]; float* out; unsigned char* ws; int ph_lo, ph_hi; };
typedef const __attribute__((address_space(4))) Args* KArgs;
__device__ __forceinline__ KArgs kargs() { KArgs p = (KArgs)__builtin_amdgcn_kernarg_segment_ptr(); asm volatile("" : "+s"(p)); return p; }
struct Frame {
    LAS unsigned char* lds; unsigned char* ws; unsigned char* ob;
    unsigned* ctl; int tid, lane, wave, vcu, G, gw, ngw;
    __device__ __forceinline__ void refresh() { int t = threadIdx.x; asm volatile("" : "+v"(t)); tid = t; lane = t & 63; wave = __builtin_amdgcn_readfirstlane(t >> 6); gw = vcu * 8 + wave; }
};

__device__ __forceinline__ float wave_sum(float v) {
#pragma unroll
    for (int o = 1; o < 64; o <<= 1) v += __shfl_xor(v, o);
    return v;
}
__device__ __forceinline__ unsigned pk2(float lo, float hi) { return cvtpk(lo, hi); }

__device__ __forceinline__ int ropeperm(int n) { const int b = n >> 3, j = n & 7; return j < 4 ? 4 * b + j : 16 + 4 * b + (j - 4); }
__device__ __forceinline__ void tr_item(const float* W, int ldw, int k0, int scol0, bf16* WT, int ldt, int drow0, const float* kscale, bool perm, LAS float* scr, int lane) {
#pragma unroll 8
    for (int i = 0; i < 32; ++i) { const int kk = 2 * i + (lane >> 5); const float sc = kscale ? kscale[k0 + kk] : 1.0f;
        scr[kk * 33 + (lane & 31)] = W[(size_t)(k0 + kk) * ldw + scol0 + (lane & 31)] * sc; }
    LDS_WAIT(); asm volatile("" ::: "memory");
    const int c = lane & 7;
#pragma unroll
    for (int j = 0; j < 4; ++j) { const int n = (lane >> 3) + 8 * j, ns = perm ? ropeperm(n) : n; const LAS float* s = scr + (8 * c) * 33 + ns;
        u32x4 o; o.x = pk2(s[0 * 33], s[1 * 33]); o.y = pk2(s[2 * 33], s[3 * 33]); o.z = pk2(s[4 * 33], s[5 * 33]); o.w = pk2(s[6 * 33], s[7 * 33]);
        *(u32x4*)(WT + (size_t)(drow0 + n) * ldt + k0 + 8 * c) = o; }
    LDS_WAIT(); asm volatile("" ::: "memory");
}
__device__ __forceinline__ void ssm_precompute(const Frame& F, KArgs A, int g) {
    const float* lam_re = (const float*)A->in[8] + g * 64; const float* lam_im = (const float*)A->in[9] + g * 64; const float dt = expf(((const float*)A->in[10])[g]);
    const float* b_re = (const float*)A->in[11] + g * 1024; const float* b_im = (const float*)A->in[12] + g * 1024;
    const float* c_re = (const float*)A->in[13] + g * 1024; const float* c_im = (const float*)A->in[14] + g * 1024;
    const float* dsk = (const float*)A->in[15] + g * 16;
    LAS float* apr = (LAS float*)F.lds; LAS float* api = apr + 33 * 64; LAS float* bbr = api + 33 * 64; LAS float* bbi = bbr + 1024;
    LAS float* crs = bbi + 1024; LAS float* cis = crs + 1024; LAS float* Kt = cis + 1024;
    const int tid = F.tid;
    for (int e = tid; e < 33 * 64; e += 512) { const int m = e >> 6, p = e & 63; const float lr = lam_re[p], li = lam_im[p];
        const float mag = expf(lr * dt * (float)m); float sn, cs; sincosf(li * dt * (float)m, &sn, &cs); apr[e] = mag * cs; api[e] = mag * sn; }
    for (int e = tid; e < 1024; e += 512) { crs[e] = c_re[e]; cis[e] = c_im[e]; }
    __syncthreads();
    for (int e = tid; e < 1024; e += 512) { const int p = e >> 4; const float lr = lam_re[p], li = lam_im[p], den = lr * lr + li * li;
        const float nr = apr[64 + p] - 1.0f, ni = api[64 + p]; const float fr_ = (nr * lr + ni * li) / den, fi_ = (ni * lr - nr * li) / den;
        const float br = b_re[e], bi = b_im[e]; bbr[e] = fr_ * br - fi_ * bi; bbi[e] = fr_ * bi + fi_ * br; }
    __syncthreads();
    for (int e = tid; e < 8192; e += 512) { const int m = e >> 8, h = (e >> 4) & 15, hp = e & 15; float s = 0.f;
        for (int p = 0; p < 64; ++p) { const float cr = crs[h * 64 + p], ci = cis[h * 64 + p], ar = apr[m * 64 + p], ai = api[m * 64 + p];
            const float er = cr * ar - ci * ai, ei = cr * ai + ci * ar; s += er * bbr[p * 16 + hp] - ei * bbi[p * 16 + hp]; }
        if (m == 0 && h == hp) s += dsk[h];
        Kt[e] = s; }
    __syncthreads();
    bf16* TH = (bf16*)(F.ws + W_TH) + (size_t)g * 512 * 640; bf16* GM = (bf16*)(F.ws + W_GM) + (size_t)g * 256 * 640;
    for (int e = tid; e < 512 * 64; e += 512) { const int n = e >> 6, cg = e & 63, i = n >> 4, h = n & 15, j = cg >> 1, h0 = (cg & 1) * 8; u32x4 o = {0u, 0u, 0u, 0u};
        if (j <= i) { const LAS float* k = Kt + (i - j) * 256 + h * 16 + h0; o.x = pk2(k[0], k[1]); o.y = pk2(k[2], k[3]); o.z = pk2(k[4], k[5]); o.w = pk2(k[6], k[7]); }
        *(u32x4*)(TH + (size_t)n * 640 + cg * 8) = o; }
    for (int e = tid; e < 512 * 16; e += 512) { const int n = e >> 4, cg = e & 15, i = n >> 4, h = n & 15; float v[8];
#pragma unroll
        for (int q = 0; q < 8; ++q) { const int sidx = cg * 8 + q, p = sidx & 63; const float cr = crs[h * 64 + p], ci = cis[h * 64 + p], ar = apr[(i + 1) * 64 + p], ai = api[(i + 1) * 64 + p];
            v[q] = sidx < 64 ? (cr * ar - ci * ai) : -(cr * ai + ci * ar); }
        u32x4 o; o.x = pk2(v[0], v[1]); o.y = pk2(v[2], v[3]); o.z = pk2(v[4], v[5]); o.w = pk2(v[6], v[7]);
        *(u32x4*)(TH + (size_t)n * 640 + 512 + cg * 8) = o; }
    for (int e = tid; e < 256 * 80; e += 512) { const int n = e / 80, cg = e - n * 80; u32x4 o = {0u, 0u, 0u, 0u};
        if (n < 128 && cg < 64) { const int p = n & 63, im = n >> 6, j = cg >> 1, h0 = (cg & 1) * 8; const float ar = apr[(31 - j) * 64 + p], ai = api[(31 - j) * 64 + p]; float v[8];
#pragma unroll
            for (int q = 0; q < 8; ++q) { const float br = bbr[p * 16 + h0 + q], bi = bbi[p * 16 + h0 + q]; v[q] = im ? (ar * bi + ai * br) : (ar * br - ai * bi); }
            o.x = pk2(v[0], v[1]); o.y = pk2(v[2], v[3]); o.z = pk2(v[4], v[5]); o.w = pk2(v[6], v[7]); }
        *(u32x4*)(GM + (size_t)n * 640 + cg * 8) = o; }
    __syncthreads();
}
__device__ __forceinline__ void cvt_row1024(const float* src, bf16* dst, int lane) {
#pragma unroll
    for (int j = 0; j < 4; ++j) { const f32x4 v = *(const f32x4*)(src + (j * 64 + lane) * 4); u32x2 o; o.x = pk2(v[0], v[1]); o.y = pk2(v[2], v[3]); *(u32x2*)(dst + (j * 64 + lane) * 4) = o; }
}
__device__ __forceinline__ void p0_prologue(const Frame& F, KArgs A) {
    for (int g = blockIdx.x; g < 32; g += F.G) ssm_precompute(F, A, g);
    LAS float* scr = (LAS float*)(F.lds + F.wave * 16384);
    const int lane = F.lane;
    const float* x = (const float*)A->in[0]; const float* mem = (const float*)A->in[1]; const int* pos = (const int*)A->in[2];
    const float* w_in = (const float*)A->in[3]; const float* g_cq = (const float*)A->in[4]; const float* w_uq = (const float*)A->in[5]; const float* g_ckv = (const float*)A->in[6];
    const float* w_ukv = (const float*)A->in[7]; const float* w_glu = (const float*)A->in[16]; const float* g_mla = (const float*)A->in[18]; const float* g_ssm = (const float*)A->in[19];
    const float* w_out = (const float*)A->in[20]; const float* xq = (const float*)A->in[23]; const float* xk = (const float*)A->in[24]; const float* xv = (const float*)A->in[25];
    const float* xo = (const float*)A->in[26]; const float* w_query = (const float*)A->in[29]; const float* sk1 = (const float*)A->in[30]; const float* sk2 = (const float*)A->in[31];
    bf16* WINT = (bf16*)(F.ws + W_WINT); bf16* WUQT = (bf16*)(F.ws + W_WUQT); bf16* WUKVT = (bf16*)(F.ws + W_WUKVT); bf16* WGLUT = (bf16*)(F.ws + W_WGLUT); bf16* WOUTT = (bf16*)(F.ws + W_WOUTT);
    bf16* XKVT = (bf16*)(F.ws + W_XKVT); bf16* XQH = (bf16*)(F.ws + W_XQH); bf16* XOTH = (bf16*)(F.ws + W_XOTH); bf16* WQR = (bf16*)(F.ws + W_WQR); bf16* SKP = (bf16*)(F.ws + W_SKP);
    bf16* MEMB = (bf16*)(F.ws + W_MEMB); float2* ROPE = (float2*)(F.ws + W_ROPE); bf16* XB = (bf16*)(F.ob + O_XB); bf16* UP = (bf16*)(F.ws + A_UP);
    constexpr int I0 = 37 * 16, I1 = 24 * 6, I2 = 32 * 4, I3 = 16 * 8, I4 = 32 * 16, I5 = 32 * 16, I6 = 32 * 16, I7 = 4 * 32 * 4;
    constexpr int I8 = 16384, I9 = 512, I10 = 1024, I11 = 1024, I12 = 512, I13 = 4096, I14 = 4096, I15 = 96;
    constexpr int NIT = I0 + I1 + I2 + I3 + I4 + I5 + I6 + I7 + I8 + I9 + I10 + I11 + I12 + I13 + I14 + I15;
    for (int it = F.gw; it < NIT; it += F.ngw) {
        int r = it;
        if (r < I0) { const int nb = r >> 4, kb = r & 15; tr_item(w_in, 1184, kb * 64, nb * 32, WINT, 1024, nb * 32 + (nb >= 21 ? 96 : 0), nullptr, nb == 20, scr, lane); continue; } r -= I0;
        if (r < I1) { const int nb = r / 6, kb = r - nb * 6; tr_item(w_uq, 768, kb * 64, nb * 32, WUQT, 384, nb * 32, g_cq, (nb % 3) == 2, scr, lane); continue; } r -= I1;
        if (r < I2) { const int nb = r >> 2, kb = r & 3; tr_item(w_ukv, 1024, kb * 64, nb * 32, WUKVT, 256, nb * 32, g_ckv, false, scr, lane); continue; } r -= I2;
        if (r < I3) { const int nb = r >> 3, kb = r & 7; tr_item(w_glu, 512, kb * 64, nb * 32, WGLUT, 512, nb * 32, nullptr, false, scr, lane); continue; } r -= I3;
        if (r < I4) { const int nb = r >> 4, kb = r & 15; tr_item(w_out, 1024, kb * 64, nb * 32, WOUTT, 1024, nb * 32, kb < 8 ? g_mla : g_ssm - 512, false, scr, lane); continue; } r -= I4;
        if (r < I5) { const int nb = r >> 4, kb = r & 15; tr_item(xk, 1024, kb * 64, nb * 32, XKVT, 1024, nb * 32, nullptr, false, scr, lane); continue; } r -= I5;
        if (r < I6) { const int nb = r >> 4, kb = r & 15; tr_item(xv, 1024, kb * 64, nb * 32, XKVT, 1024, 1024 + nb * 32, nullptr, false, scr, lane); continue; } r -= I6;
        if (r < I7) { const int h = r >> 7, nb = (r >> 2) & 31, kb = r & 3; tr_item(xo + (size_t)h * 256 * 1024, 1024, kb * 64, nb * 32, XOTH + (size_t)h * 1024 * 256, 256, nb * 32, nullptr, false, scr, lane); continue; } r -= I7;
        if (r < I8) { cvt_row1024(x + (size_t)r * 1024, XB + (size_t)r * 1024, lane); continue; } r -= I8;
        if (r < I9) { cvt_row1024(mem + (size_t)r * 1024, MEMB + (size_t)r * 1024, lane); continue; } r -= I9;
        if (r < I10) {
#pragma unroll
            for (int j = 0; j < 4; ++j) { const int e = (j * 64 + lane) * 4, h = e >> 8, jj = e & 255; const f32x4 v = *(const f32x4*)(xq + (size_t)r * 1024 + e);
                u32x2 o; o.x = pk2(v[0], v[1]); o.y = pk2(v[2], v[3]); *(u32x2*)(XQH + ((size_t)h * 1024 + r) * 256 + jj) = o; }
            continue; } r -= I10;
        if (r < I11) {
#pragma unroll
            for (int j = 0; j < 8; ++j) { const int e = (j * 64 + lane) * 4, hh = e >> 7, d = e & 127; const f32x4 v = *(const f32x4*)(w_query + (size_t)r * 2048 + e);
                u32x2 o; o.x = pk2(v[0], v[1]); o.y = pk2(v[2], v[3]); bf16* dp = WQR + ((size_t)hh * 1024 + r) * 256 + d; *(u32x2*)dp = o; *(u32x2*)(dp + 128) = (u32x2){0u, 0u}; }
            continue; } r -= I11;
        if (r < I12) { const int half = r >> 8, key = r & 255, d = lane * 4; u32x2 o = {0u, 0u};
            if (key < 128 && d < 128) { const f32x4 v = *(const f32x4*)((half ? sk2 : sk1) + key * 128 + d); o.x = pk2(v[0], v[1]); o.y = pk2(v[2], v[3]); }
            *(u32x2*)(SKP + ((size_t)half * 256 + key) * 256 + d) = o; continue; } r -= I12;
        if (r < I13) { const int t = r * 4 + (lane >> 4), i = lane & 15; const float fq_ = exp2f(-(float)i * (13.287712379549449f / 16.0f));
            const float ang = (float)pos[t] * fq_; float sn, cs; sincosf(ang, &sn, &cs); ROPE[(size_t)t * 16 + i] = make_float2(cs, sn); continue; } r -= I13;
        if (r < I14) { const int row = r * 4 + (lane >> 4); *(u32x4*)(UP + (size_t)row * 640 + 512 + (lane & 15) * 8) = (u32x4){0u, 0u, 0u, 0u}; continue; } r -= I14;
        { const int row = 672 + r; *(u32x4*)(WINT + (size_t)row * 1024 + lane * 16) = (u32x4){0u, 0u, 0u, 0u}; *(u32x4*)(WINT + (size_t)row * 1024 + lane * 16 + 8) = (u32x4){0u, 0u, 0u, 0u}; }
    }
}
__device__ __forceinline__ void p3_scan(const Frame& F, KArgs A) {
    if (F.wave != 0) return;
    for (int task = blockIdx.x; task < 64; task += F.G) {
        const int g = task >> 1, b = task & 1, p = F.lane;
        const float lr = ((const float*)A->in[8])[g * 64 + p], li = ((const float*)A->in[9])[g * 64 + p], dt = expf(((const float*)A->in[10])[g]);
        const float mag = expf(lr * dt * 32.f); float sn, cs; sincosf(li * dt * 32.f, &sn, &cs); const float ar = mag * cs, ai = mag * sn;
        const float* LS = (const float*)(F.ws + A_LS) + (size_t)(g * 512 + b * 256) * 128; bf16* UP = (bf16*)(F.ws + A_UP) + (size_t)(g * 512 + b * 256) * 640 + 512;
        float sr = 0.f, si = 0.f;
#pragma unroll 8
        for (int c = 0; c < 256; ++c) {
            UP[(size_t)c * 640 + p] = (bf16)(cvtpk(sr, 0.f) & 0xffffu); UP[(size_t)c * 640 + 64 + p] = (bf16)(cvtpk(si, 0.f) & 0xffffu);
            const float l0 = LS[c * 128 + p], l1 = LS[c * 128 + 64 + p];
            const float nr = ar * sr - ai * si + l0, ni = ar * si + ai * sr + l1; sr = nr; si = ni;
        }
    }
}
__device__ __forceinline__ void p6_rmsnorm(const Frame& F) {
    const bf16* OA = (const bf16*)(F.ws + A_OA); const bf16* OS = (const bf16*)(F.ob + O_OS); bf16* MIXN = (bf16*)(F.ws + A_MIXN);
    for (int t = F.gw; t < NTOK; t += F.ngw) {
        f32x4 a0, a1, s0, s1; unpack8(*(const u32x4*)(OA + (size_t)t * 512 + F.lane * 8), a0, a1); unpack8(*(const u32x4*)(OS + (size_t)t * 512 + F.lane * 8), s0, s1);
        float qa = 0.f, qs = 0.f;
#pragma unroll
        for (int j = 0; j < 4; ++j) { qa += a0[j] * a0[j] + a1[j] * a1[j]; qs += s0[j] * s0[j] + s1[j] * s1[j]; }
        const float ra = rsqrtf(wave_sum(qa) * (1.f / 512.f) + RMS_EPS), rs = rsqrtf(wave_sum(qs) * (1.f / 512.f) + RMS_EPS);
        *(u32x4*)(MIXN + (size_t)t * 1024 + F.lane * 8) = pack8(a0 * ra, a1 * ra); *(u32x4*)(MIXN + (size_t)t * 1024 + 512 + F.lane * 8) = pack8(s0 * rs, s1 * rs);
    }
}
__device__ __forceinline__ void ln_rows(const Frame& F, const float* PRE, const float* gam, const float* bet, bf16* X) {
    for (int t = F.gw; t < NTOK; t += F.ngw) {
        f32x4 v[4]; float s = 0.f;
#pragma unroll
        for (int j = 0; j < 4; ++j) { v[j] = *(const f32x4*)(PRE + (size_t)t * 1024 + (j * 64 + F.lane) * 4); s += (v[j][0] + v[j][1]) + (v[j][2] + v[j][3]); }
        const float mean = wave_sum(s) * (1.f / 1024.f); float q = 0.f;
#pragma unroll
        for (int j = 0; j < 4; ++j) { v[j] = v[j] - mean; q += (v[j][0] * v[j][0] + v[j][1] * v[j][1]) + (v[j][2] * v[j][2] + v[j][3] * v[j][3]); }
        const float rstd = rsqrtf(wave_sum(q) * (1.f / 1024.f) + LN_EPS);
#pragma unroll
        for (int j = 0; j < 4; ++j) { const int c = (j * 64 + F.lane) * 4; const f32x4 gg = *(const f32x4*)(gam + c), bb = *(const f32x4*)(bet + c); const f32x4 o = v[j] * rstd * gg + bb;
            u32x2 w; w.x = pk2(o[0], o[1]); w.y = pk2(o[2], o[3]); *(u32x2*)(X + (size_t)t * 1024 + c) = w; }
    }
}
__device__ const unsigned char PAIRTAB[64] = {0x00,0x01,0x02,0x03,0x04,0x05,0x06,0x07,0x08,0x09,0x0a,0x0b,0x0c,0x0d,0x0e,0x0f,0x10,0x11,0x12,0x13,0x14,0x15,0x16,0x17,0x20,0x21,0x22,0x23,0x24,0x30,0x31,0x32,
    0x33,0x40,0x41,0x42,0x50,0x51,0x60,0x61,0x70,0x71,0x80,0x90,0xa0,0xb0,0xc0,0xd0,0xe0,0xf0,0xff,0xff,0xff,0xff,0xff,0xff,0xff,0xff,0xff,0xff,0xff,0xff,0xff,0xff};
__device__ __forceinline__ unsigned f2sort(float f) { const unsigned u = __float_as_uint(f); return u ^ ((u >> 31) ? 0xffffffffu : 0x80000000u); }
__device__ __forceinline__ float sort2f(unsigned k) { return __uint_as_float((k & 0x80000000u) ? (k ^ 0x80000000u) : ~k); }
__device__ __forceinline__ unsigned umax_(unsigned a, unsigned b) { return a > b ? a : b; }
__device__ __forceinline__ unsigned gmax16(unsigned v) { v = umax_(v, (unsigned)__shfl_xor((int)v, 1)); v = umax_(v, (unsigned)__shfl_xor((int)v, 2)); v = umax_(v, (unsigned)__shfl_xor((int)v, 4)); v = umax_(v, (unsigned)__shfl_xor((int)v, 8)); return v; }
__device__ __forceinline__ void p13_topk(const Frame& F) {
    const float* SCLO = (const float*)F.ob; const float* SCHI = (const float*)(F.ws + A_SCHI); int* IDS = (int*)(F.ws + A_IDS); float* GATES = (float*)(F.ws + A_GATES);
    const int lane = F.lane, l = lane & 15, gbase = lane & 48;
    for (int w = F.gw; w < NTOK * 2; w += F.ngw) {
        const int t = w >> 1, h = (w & 1) * 4 + (lane >> 4);
        const float* src = (h < 4 ? SCLO : SCHI) + (size_t)t * 1024 + (h & 3) * 256;
        const f32x4 a0 = *(const f32x4*)(src + 4 * l), a1 = *(const f32x4*)(src + 64 + 4 * l), b0 = *(const f32x4*)(src + 128 + 4 * l), b1 = *(const f32x4*)(src + 192 + 4 * l);
        unsigned k1[8], k2[8];
#pragma unroll
        for (int e = 0; e < 4; ++e) { k1[e] = (f2sort(a0[e]) & ~127u) | (unsigned)(4 * l + e); k1[4 + e] = (f2sort(a1[e]) & ~127u) | (unsigned)(64 + 4 * l + e);
                                      k2[e] = (f2sort(b0[e]) & ~127u) | (unsigned)(4 * l + e); k2[4 + e] = (f2sort(b1[e]) & ~127u) | (unsigned)(64 + 4 * l + e); }
        unsigned r1 = 0u, r2 = 0u;
        for (int k = 0; k < 16; ++k) {
            unsigned m1 = umax_(umax_(umax_(k1[0], k1[1]), umax_(k1[2], k1[3])), umax_(umax_(k1[4], k1[5]), umax_(k1[6], k1[7])));
            unsigned m2 = umax_(umax_(umax_(k2[0], k2[1]), umax_(k2[2], k2[3])), umax_(umax_(k2[4], k2[5]), umax_(k2[6], k2[7])));
            m1 = gmax16(m1); m2 = gmax16(m2);
            if (l == k) { r1 = m1; r2 = m2; }
#pragma unroll
            for (int e = 0; e < 8; ++e) { if (k1[e] == m1) k1[e] = 0u; if (k2[e] == m2) k2[e] = 0u; }
        }
        unsigned ck[4];
#pragma unroll
        for (int s = 0; s < 4; ++s) { const unsigned pr = PAIRTAB[s * 16 + l]; const bool valid = pr != 0xffu; const int i = valid ? (int)(pr >> 4) : 0, j = valid ? (int)(pr & 15u) : 0;
            const unsigned ki = (unsigned)__shfl((int)r1, gbase + i), kj = (unsigned)__shfl((int)r2, gbase + j);
            const float sum = sort2f(ki & ~127u) + sort2f(kj & ~127u);
            ck[s] = valid ? ((f2sort(sum) & ~255u) | pr) : 0u; }
        unsigned res = 0u;
        for (int k = 0; k < 16; ++k) {
            unsigned m = gmax16(umax_(umax_(ck[0], ck[1]), umax_(ck[2], ck[3])));
            if (l == k) res = m;
#pragma unroll
            for (int s = 0; s < 4; ++s) if (ck[s] == m) ck[s] = 0u;
        }
        const int i = (int)((res >> 4) & 15u), j = (int)(res & 15u);
        const unsigned ki = (unsigned)__shfl((int)r1, gbase + i), kj = (unsigned)__shfl((int)r2, gbase + j);
        const float val = sort2f(ki & ~127u) + sort2f(kj & ~127u); const int id = (int)(ki & 127u) * 128 + (int)(kj & 127u);
        float mx = val; mx = fmaxf(mx, __shfl_xor(mx, 1)); mx = fmaxf(mx, __shfl_xor(mx, 2)); mx = fmaxf(mx, __shfl_xor(mx, 4)); mx = fmaxf(mx, __shfl_xor(mx, 8));
        const float ex = __expf(val - mx); float sm = ex; sm += __shfl_xor(sm, 1); sm += __shfl_xor(sm, 2); sm += __shfl_xor(sm, 4); sm += __shfl_xor(sm, 8);
        IDS[(size_t)t * 128 + h * 16 + l] = id; GATES[(size_t)t * 128 + h * 16 + l] = ex / sm;
    }
}
constexpr float USCALE = 32.0f;
__device__ __forceinline__ unsigned pk4_fp8(f32x4 v) { int w = __builtin_amdgcn_cvt_pk_fp8_f32(v[0], v[1], 0, false); w = __builtin_amdgcn_cvt_pk_fp8_f32(v[2], v[3], w, true); return (unsigned)w; }
__device__ __forceinline__ void cvt_row1024_fp8(const float* src, unsigned char* dst, int lane, float sc) {
    const f32x4 a = *(const f32x4*)(src + 16 * lane) * sc, b = *(const f32x4*)(src + 16 * lane + 4) * sc, c = *(const f32x4*)(src + 16 * lane + 8) * sc, d = *(const f32x4*)(src + 16 * lane + 12) * sc;
    u32x4 o; o.x = pk4_fp8(a); o.y = pk4_fp8(b); o.z = pk4_fp8(c); o.w = pk4_fp8(d); *(u32x4*)(dst + 16 * lane) = o;
}
__device__ __forceinline__ void p14_tables(const Frame& F, KArgs A) {
    const float* u_tab = (const float*)A->in[32]; const float* v_tab = (const float*)A->in[33]; unsigned char* UT = F.ws + A_UT; unsigned char* VT = F.ws + A_VT;
    for (int r = F.gw; r < 32768; r += F.ngw) { const int e = r & 16383; if (r < 16384) cvt_row1024_fp8(u_tab + (size_t)e * 1024, UT + (size_t)e * 1024, F.lane, USCALE); else cvt_row1024_fp8(v_tab + (size_t)e * 1024, VT + (size_t)e * 1024, F.lane, 1.0f); }
}
__device__ __forceinline__ void unpack16_fp8(u32x4 w, f32x4& a, f32x4& b, f32x4& c, f32x4& d) {
    const f32x2 a0 = __builtin_amdgcn_cvt_pk_f32_fp8((int)w.x, false), a1 = __builtin_amdgcn_cvt_pk_f32_fp8((int)w.x, true), b0 = __builtin_amdgcn_cvt_pk_f32_fp8((int)w.y, false), b1 = __builtin_amdgcn_cvt_pk_f32_fp8((int)w.y, true);
    const f32x2 c0 = __builtin_amdgcn_cvt_pk_f32_fp8((int)w.z, false), c1 = __builtin_amdgcn_cvt_pk_f32_fp8((int)w.z, true), d0 = __builtin_amdgcn_cvt_pk_f32_fp8((int)w.w, false), d1 = __builtin_amdgcn_cvt_pk_f32_fp8((int)w.w, true);
    a = (f32x4){a0.x, a0.y, a1.x, a1.y}; b = (f32x4){b0.x, b0.y, b1.x, b1.y}; c = (f32x4){c0.x, c0.y, c1.x, c1.y}; d = (f32x4){d0.x, d0.y, d1.x, d1.y};
}
__device__ __forceinline__ float hsum4(f32x4 v) { return (v[0] + v[1]) + (v[2] + v[3]); }
__device__ __forceinline__ void p15_gather(const Frame& F, KArgs A) {
    const bf16* X2 = (const bf16*)(F.ws + A_X2); const int* IDS = (const int*)(F.ws + A_IDS); const float* GATES = (const float*)(F.ws + A_GATES);
    const unsigned char* UT = F.ws + A_UT; const unsigned char* VT = F.ws + A_VT; const float* g3 = (const float*)A->in[34]; const float* b3 = (const float*)A->in[35];
    float* out = (float*)F.ob; const int lane = F.lane; const bool b5 = lane & 32, b4 = lane & 16, b3_ = lane & 8;
    const int srcl = ((lane >> 2) & 1) * 32 + ((lane >> 1) & 1) * 16 + (lane & 1) * 8;
    for (int t = F.gw; t < NTOK; t += F.ngw) {
        f32x4 x0, x1, x2, x3; unpack8(*(const u32x4*)(X2 + (size_t)t * 1024 + 16 * lane), x0, x1); unpack8(*(const u32x4*)(X2 + (size_t)t * 1024 + 16 * lane + 8), x2, x3);
        const int id0 = IDS[(size_t)t * 128 + lane], id1 = IDS[(size_t)t * 128 + 64 + lane]; const float g0 = GATES[(size_t)t * 128 + lane], g1 = GATES[(size_t)t * 128 + 64 + lane];
        float c0 = 0.f, c1 = 0.f;
        for (int bi = 0; bi < 16; ++bi) {
            const int idv = bi < 8 ? id0 : id1; float p[8];
#pragma unroll
            for (int r = 0; r < 8; ++r) { const int id = __builtin_amdgcn_readlane(idv, (bi & 7) * 8 + r);
                f32x4 u0, u1, u2, u3; unpack16_fp8(*(const u32x4*)(UT + (size_t)id * 1024 + 16 * lane), u0, u1, u2, u3);
                p[r] = hsum4(x0 * u0 + x1 * u1 + x2 * u2 + x3 * u3); }
            float q[4], s2[2];
#pragma unroll
            for (int r = 0; r < 4; ++r) { const float keep = b5 ? p[r + 4] : p[r], send = b5 ? p[r] : p[r + 4]; q[r] = keep + __shfl_xor(send, 32); }
#pragma unroll
            for (int r = 0; r < 2; ++r) { const float keep = b4 ? q[r + 2] : q[r], send = b4 ? q[r] : q[r + 2]; s2[r] = keep + __shfl_xor(send, 16); }
            float v; { const float keep = b3_ ? s2[1] : s2[0], send = b3_ ? s2[0] : s2[1]; v = keep + __shfl_xor(send, 8); }
            v += __shfl_xor(v, 4); v += __shfl_xor(v, 2); v += __shfl_xor(v, 1);
            const float tv = __shfl(v, srcl);
            if ((lane >> 3) == (bi & 7)) { if (bi < 8) c0 = tv; else c1 = tv; }
        }
        c0 = g0 * gelu_tanh(c0 * (1.0f / USCALE)); c1 = g1 * gelu_tanh(c1 * (1.0f / USCALE));
        f32x4 acc[4] = {};
        for (int bi = 0; bi < 16; ++bi) {
            const int idv = bi < 8 ? id0 : id1; const float cv = bi < 8 ? c0 : c1;
#pragma unroll
            for (int r = 0; r < 8; ++r) { const int kk = (bi & 7) * 8 + r; const int id = __builtin_amdgcn_readlane(idv, kk);
                const float s = __uint_as_float(__builtin_amdgcn_readlane(__float_as_uint(cv), kk));
                f32x4 v0, v1, v2, v3; unpack16_fp8(*(const u32x4*)(VT + (size_t)id * 1024 + 16 * lane), v0, v1, v2, v3);
                acc[0] += v0 * s; acc[1] += v1 * s; acc[2] += v2 * s; acc[3] += v3 * s; }
        }
        acc[0] += x0 * ALPHA; acc[1] += x1 * ALPHA; acc[2] += x2 * ALPHA; acc[3] += x3 * ALPHA;
        float s = 0.f;
#pragma unroll
        for (int j = 0; j < 4; ++j) s += hsum4(acc[j]);
        const float mean = wave_sum(s) * (1.f / 1024.f); float qv = 0.f;
#pragma unroll
        for (int j = 0; j < 4; ++j) { acc[j] = acc[j] - mean; qv += hsum4(acc[j] * acc[j]); }
        const float rstd = rsqrtf(wave_sum(qv) * (1.f / 1024.f) + LN_EPS);
#pragma unroll
        for (int j = 0; j < 4; ++j) { const int c = 16 * lane + 4 * j; const f32x4 gg = *(const f32x4*)(g3 + c), bb = *(const f32x4*)(b3 + c);
            *(f32x4*)(out + (size_t)t * 1024 + c) = acc[j] * rstd * gg + bb; }
    }
}

__global__ void __launch_bounds__(NWAVES * 64, 2) mk_fwd(Args args) {
    extern __shared__ __attribute__((aligned(16))) unsigned char lds[];
    Frame F;
    F.lds = (LAS unsigned char*)lds; F.ws = args.ws; F.ob = (unsigned char*)args.out; F.ctl = (unsigned*)(args.ws + WS_CTL);
    F.tid = threadIdx.x; F.lane = F.tid & 63; F.wave = __builtin_amdgcn_readfirstlane(F.tid >> 6);
    F.G = gridDim.x; { const int bx = blockIdx.x; F.vcu = (F.G % 8 == 0) ? (bx % 8) * (F.G / 8) + bx / 8 : bx; }
    F.gw = F.vcu * NWAVES + F.wave; F.ngw = F.G * NWAVES;
    volatile LAS unsigned* MISC = (volatile LAS unsigned*)(F.lds + MISC_OFF);
    if (F.tid < 32) MISC[F.tid] = 0u;
    __syncthreads();
    const int lo = args.ph_lo, hi = args.ph_hi;
    XcdBarrier bar; bar.bar = F.ctl + CW_BAR; bar.x = 0; bar.st = nullptr;
    if (hi - lo > 1) bar = xcd_barrier_post(F.ctl + CW_BAR, MISC + 8);
#define IN(k) (lo <= (k) && (k) < hi)
#define SEAM(k) do { if (IN(k) && IN((k) + 1)) xcd_barrier(bar); } while (0)
    const int bx = (int)blockIdx.x;

    if (IN(0)) { F.refresh(); p0_prologue(F, kargs()); SEAM(0); }

    if (IN(1)) {
        { pg8::Gemm g{(const bf16*)(F.ob + O_XB), (const bf16*)(F.ws + W_WINT), NTOK, NINP, DM}; BigSched S; S.so.init(NTOK, NINP, F.G, bx); S.bt = 0;
          EpiWin E{(bf16*)(F.ws + A_CQ), (bf16*)(F.ws + A_CKV), (bf16*)(F.ws + A_KH), (bf16*)(F.ws + A_UP), (const float2*)(F.ws + W_ROPE), (float*)(F.ws + W_SSQ)};
          pg8::gemm_phase<EpiWin, BigSched, true, true>(F.lds, g, S, E); }
        { pg8::Gemm g{(const bf16*)(F.ws + W_MEMB), (const bf16*)(F.ws + W_XKVT), 512, 2048, DM}; ListSched<DecKV2> S{16, F.G, (bx + F.G - 64) % F.G, DecKV2{}};
          EpiK2V2 E{(bf16*)(F.ws + W_K2V2)};
          pg8::gemm_phase<EpiK2V2, ListSched<DecKV2>, true, true>(F.lds, g, S, E); }
        SEAM(1);
    }
    if (IN(2)) {
        { pg8::Gemm g{(const bf16*)(F.ws + A_CQ), (const bf16*)(F.ws + W_WUQT), NTOK, 768, QL}; BigSched S; S.so.init(NTOK, 768, F.G, bx); S.bt = 0;
          EpiQ E{(bf16*)(F.ws + A_QH), (const float2*)(F.ws + W_ROPE), (const float*)(F.ws + W_SSQ)};
          pg8::gemm_phase<EpiQ, BigSched, true, true>(F.lds, g, S, E); }
        { pg8::Gemm g{(const bf16*)(F.ws + A_UP), (const bf16*)(F.ws + W_GM), 16384, 8192, 640}; ListSched<DecLS> S{64, F.G, (bx + F.G - 192) % F.G, DecLS{}};
          EpiLS E{(float*)(F.ws + A_LS)};
          pg8::gemm_phase<EpiLS, ListSched<DecLS>, true, true>(F.lds, g, S, E); }
        { pg8::Gemm g{(const bf16*)(F.ws + A_CKV), (const bf16*)(F.ws + W_WUKVT), NTOK, 1024, KVL}; BigSched S; S.so.init(NTOK, 1024, F.G, bx); S.bt = 0;
          EpiKV E{(bf16*)(F.ws + A_KH), (bf16*)(F.ws + A_VH), (const float*)(F.ws + W_SSQ)};
          pg8::gemm_phase<EpiKV, BigSched, true, true>(F.lds, g, S, E); }
        { pg8::Gemm g{(const bf16*)(F.ws + W_K2V2), (const bf16*)(F.ws + W_XQH), 2048, 4096, 256}; ListSched<DecMb> S{32, F.G, bx, DecMb{}};
          EpiMb E{(bf16*)(F.ws + W_MB)};
          pg8::gemm_phase<EpiMb, ListSched<DecMb>, true, true>(F.lds, g, S, E); }
        { pg8::Gemm g{(const bf16*)(F.ws + W_XOTH), (const bf16*)(F.ws + W_K2V2) + (size_t)2 * 4 * 256 * 256, 4096, 2048, 256}; ListSched<DecVOT> S{32, F.G, (bx + F.G - 32) % F.G, DecVOT{}};
          EpiVOT E{(bf16*)(F.ws + W_VOT)};
          pg8::gemm_phase<EpiVOT, ListSched<DecVOT>, true, true>(F.lds, g, S, E); }
        { pg8::Gemm g{(const bf16*)(F.ws + W_SKP), (const bf16*)(F.ws + W_WQR), 512, 16384, 256}; ListSched<DecWsc> S{64, F.G, (bx + F.G - 64) % F.G, DecWsc{}};
          EpiWsc E{(bf16*)(F.ws + W_WSC)};
          pg8::gemm_phase<EpiWsc, ListSched<DecWsc>, true, true>(F.lds, g, S, E); }
        SEAM(2);
    }
    if (IN(3)) { F.refresh(); p3_scan(F, kargs()); SEAM(3); }
    if (IN(4)) {
        for (int L = F.vcu; L < 256; L += F.G) {
            const int bh = L >> 4, xq_ = L & 15, q0 = xq_, q1 = 31 - xq_, b = bh >> 3, h = bh & 7;
            const att::bf16* Qb = (const att::bf16*)(F.ws + A_QH) + (size_t)bh * SEQ * 96; const att::bf16* Kb = (const att::bf16*)(F.ws + A_KH) + (size_t)bh * SEQ * 96;
            const att::bf16* Vb = (const att::bf16*)(F.ws + A_VH) + (size_t)bh * SEQ * 64; att::bf16* Ob = (att::bf16*)(F.ws + A_OA) + (size_t)b * SEQ * 512 + h * 64;
            const att::BlockRef r0{Qb + (size_t)q0 * 256 * 96, Kb, Vb, Ob + (size_t)q0 * 256 * 512, q0 * 256};
            const att::BlockRef r1{Qb + (size_t)q1 * 256 * 96, Kb, Vb, Ob + (size_t)q1 * 256 * 512, q1 * 256};
            att::Seam S;
            att::attn_prime(r0, (char*)lds, S);
            att::attn_block(r0, r1, (char*)lds, S);
            att::attn_block(r1, r1, (char*)lds, S);
        }
        { pg8::Gemm g{(const bf16*)(F.ws + A_UP), (const bf16*)(F.ws + W_TH), 16384, 16384, 640}; ListSched<DecY> S{128, F.G, bx, DecY{}};
          EpiY E{(bf16*)(F.ob + O_YS)};
          pg8::gemm_phase<EpiY, ListSched<DecY>, true, true>(F.lds, g, S, E); }
        SEAM(4);
    }
    if (IN(5)) {
        pg8::Gemm g{(const bf16*)(F.ob + O_YS), (const bf16*)(F.ws + W_WGLUT), NTOK, 512, 512}; BigSched S; S.so.init(NTOK, 512, F.G, bx); S.bt = 0;
        EpiGlu E{(const bf16*)(F.ob + O_YS), (bf16*)(F.ob + O_OS), (const float*)kargs()->in[17]};
        pg8::gemm_phase<EpiGlu, BigSched, true, true>(F.lds, g, S, E);
        SEAM(5);
    }
    if (IN(6)) { F.refresh(); p6_rmsnorm(F); SEAM(6); }
    if (IN(7)) {
        pg8::Gemm g{(const bf16*)(F.ws + A_MIXN), (const bf16*)(F.ws + W_WOUTT), NTOK, DM, DM}; BigSched S; S.so.init(NTOK, DM, F.G, bx); S.bt = 0;
        EpiPre<0> E{(const float*)kargs()->in[0], nullptr, (float*)F.ob};
        pg8::gemm_phase<EpiPre<0>, BigSched, true, true>(F.lds, g, S, E);
        SEAM(7);
    }
    if (IN(8)) { F.refresh(); ln_rows(F, (const float*)F.ob, (const float*)kargs()->in[21], (const float*)kargs()->in[22], (bf16*)(F.ws + A_X1)); SEAM(8); }
    if (IN(9)) {
        pg8::Gemm g{(const bf16*)(F.ws + A_X1), (const bf16*)(F.ws + W_MB), NTOK, DM, DM}; BigSched S; S.so.init(NTOK, DM, F.G, bx); S.bt = 4;
        EpiXS E{(bf16*)(F.ws + A_P), F.lds};
        pg8::gemm_phase<EpiXS, BigSched, true, true>(F.lds, g, S, E);
        SEAM(9);
    }
    if (IN(10)) {
        pg8::Gemm g{(const bf16*)(F.ws + A_P), (const bf16*)(F.ws + W_VOT), NTOK, DM, DM}; BigSched S; S.so.init(NTOK, DM, F.G, bx); S.bt = 4;
        EpiPre<1> E{nullptr, (const bf16*)(F.ws + A_X1), (float*)F.ob};
        pg8::gemm_phase<EpiPre<1>, BigSched, true, true>(F.lds, g, S, E);
        SEAM(10);
    }
    if (IN(11)) { F.refresh(); ln_rows(F, (const float*)F.ob, (const float*)kargs()->in[27], (const float*)kargs()->in[28], (bf16*)(F.ws + A_X2)); SEAM(11); }
    if (IN(12)) {
        pg8::Gemm g{(const bf16*)(F.ws + A_X2), (const bf16*)(F.ws + W_WSC), NTOK, 2048, DM}; BigSched S; S.so.init(NTOK, 2048, F.G, bx); S.bt = 0;
        EpiSC E{(float*)F.ob, (float*)(F.ws + A_SCHI)};
        pg8::gemm_phase<EpiSC, BigSched, true, true>(F.lds, g, S, E);
        SEAM(12);
    }
    if (IN(13)) { for (int rep = 0; rep < 1 + ((MK_REP >> 13) & 1); ++rep) { F.refresh(); p13_topk(F); } SEAM(13); }
    if (IN(14)) { F.refresh(); p14_tables(F, kargs()); SEAM(14); }
    if (IN(15)) { for (int rep = 0; rep < 1 + ((MK_REP >> 15) & 1); ++rep) { F.refresh(); p15_gather(F, kargs()); } }
#undef IN
#undef SEAM
}

#if MK_DBG
struct DArgs { const void* in[36]; float* out; unsigned char* ws; };
__device__ __forceinline__ unsigned hsh(unsigned x) { x ^= x >> 16; x *= 0x7feb352du; x ^= x >> 15; x *= 0x846ca68bu; x ^= x >> 16; return x; }
__device__ __forceinline__ float bf2f(bf16 v) { return __uint_as_float((unsigned)v << 16); }
__device__ __forceinline__ void dbg_report(unsigned char* ws, int code, bool bad) { if (bad) atomicMax((unsigned*)(ws + WS_CTL) + CW_DBG, (unsigned)(32 - code)); }
__device__ __forceinline__ bool far(float got, float ref, float scale) { return !(fabsf(got - ref) <= 0.03f * scale + 0.03f * fabsf(ref)); }
__device__ __forceinline__ int ropepos(int i, int second) { return (i >> 2) * 8 + (i & 3) + 4 * second; }

__global__ void chk1(DArgs a) {
    const int i = blockIdx.x * blockDim.x + threadIdx.x; const unsigned h0 = hsh(i * 2 + 1), h1 = hsh(i * 2 + 2);
    const int t = h0 % NTOK; int col = h1 % 1184; const float* x = (const float*)a.in[0]; const float* w = (const float*)a.in[3]; const int* pos = (const int*)a.in[2];
    const int b = t >> 13, tl = t & 8191;
    if (col >= 640 && col < 672) { const int ii = (col - 640) & 15; float x1 = 0.f, x2 = 0.f;
        for (int k = 0; k < 1024; ++k) { x1 += x[(size_t)t * 1024 + k] * w[(size_t)k * 1184 + 640 + ii]; x2 += x[(size_t)t * 1024 + k] * w[(size_t)k * 1184 + 656 + ii]; }
        const float ang = (float)pos[t] * powf(10000.f, -(float)ii / 16.f); const float c = cosf(ang), s = sinf(ang); const int hh = h1 % 8;
        const bf16* kr = (const bf16*)(a.ws + A_KH) + ((size_t)(b * 8 + hh) * SEQ + tl) * 96 + 64;
        dbg_report(a.ws, 1, far(bf2f(kr[ropepos(ii, 0)]), x1 * c - x2 * s, 1.f) || far(bf2f(kr[ropepos(ii, 1)]), x2 * c + x1 * s, 1.f)); return; }
    float r = 0.f; for (int k = 0; k < 1024; ++k) r += x[(size_t)t * 1024 + k] * w[(size_t)k * 1184 + col];
    float got;
    if (col < 384) got = bf2f(((const bf16*)(a.ws + A_CQ))[(size_t)t * 384 + col]);
    else if (col < 640) got = bf2f(((const bf16*)(a.ws + A_CKV))[(size_t)t * 256 + col - 384]);
    else { const int ch = col - 672, g = ch >> 4, hp = ch & 15; got = bf2f(((const bf16*)(a.ws + A_UP))[((size_t)(g * 512 + b * 256 + (tl >> 5)) * 640) + (tl & 31) * 16 + hp]); }
    dbg_report(a.ws, 1, far(got, r, 1.f));
}
__global__ void chk2(DArgs a) {
    const int i = blockIdx.x * blockDim.x + threadIdx.x; const unsigned h0 = hsh(i * 3 + 11), h1 = hsh(i * 3 + 12), h2 = hsh(i * 3 + 13);
    const int t = h0 % NTOK, h = h1 % 8, b = t >> 13, tl = t & 8191; const int* pos = (const int*)a.in[2];
    if (h2 & 1) {
        const bf16* cq = (const bf16*)(a.ws + A_CQ) + (size_t)t * 384; const float* g = (const float*)a.in[4]; const float* w = (const float*)a.in[5];
        float ss = 0.f; for (int k = 0; k < 384; ++k) ss += bf2f(cq[k]) * bf2f(cq[k]);
        const float rr = rsqrtf(ss / 384.f + 1e-6f); const int d = (h2 >> 1) % 96; const bf16* q = (const bf16*)(a.ws + A_QH) + ((size_t)(b * 8 + h) * SEQ + tl) * 96;
        if (d < 64) { float r = 0.f; for (int k = 0; k < 384; ++k) r += bf2f(cq[k]) * g[k] * w[(size_t)k * 768 + h * 96 + d]; dbg_report(a.ws, 2, far(bf2f(q[d]), r * rr * C2Q, 0.15f)); }
        else { const int ii = (d - 64) & 15; float x1 = 0.f, x2 = 0.f;
            for (int k = 0; k < 384; ++k) { const float v = bf2f(cq[k]) * g[k]; x1 += v * w[(size_t)k * 768 + h * 96 + 64 + ii]; x2 += v * w[(size_t)k * 768 + h * 96 + 80 + ii]; }
            x1 *= rr * C2Q; x2 *= rr * C2Q; const float ang = (float)pos[t] * powf(10000.f, -(float)ii / 16.f); const float c = cosf(ang), s = sinf(ang);
            dbg_report(a.ws, 2, far(bf2f(q[64 + ropepos(ii, 0)]), x1 * c - x2 * s, 0.15f) || far(bf2f(q[64 + ropepos(ii, 1)]), x2 * c + x1 * s, 0.15f)); }
    } else {
        const bf16* ck = (const bf16*)(a.ws + A_CKV) + (size_t)t * 256; const float* g = (const float*)a.in[6]; const float* w = (const float*)a.in[7];
        float ss = 0.f; for (int k = 0; k < 256; ++k) ss += bf2f(ck[k]) * bf2f(ck[k]);
        const float rr = rsqrtf(ss / 256.f + 1e-6f); const int j = (h2 >> 1) % 128; float r = 0.f;
        for (int k = 0; k < 256; ++k) r += bf2f(ck[k]) * g[k] * w[(size_t)k * 1024 + h * 128 + j];
        const float got = j < 64 ? bf2f(((const bf16*)(a.ws + A_KH))[((size_t)(b * 8 + h) * SEQ + tl) * 96 + j]) : bf2f(((const bf16*)(a.ws + A_VH))[((size_t)(b * 8 + h) * SEQ + tl) * 64 + j - 64]);
        dbg_report(a.ws, 2, far(got, r * rr, 1.f));
    }
}
__global__ void chk3(DArgs a) {
    const int i = blockIdx.x * (blockDim.x >> 6) + (threadIdx.x >> 6), lane = threadIdx.x & 63; const unsigned h0 = hsh(i * 3 + 21), h1 = hsh(i * 3 + 22), h2 = hsh(i * 3 + 23);
    int t = h0 % NTOK; if ((i & 3) == 0) t = (t & ~8191) + (h0 >> 16) % 300; const int h = h1 % 8, d = h2 % 64, b = t >> 13, tl = t & 8191;
    const bf16* q = (const bf16*)(a.ws + A_QH) + ((size_t)(b * 8 + h) * SEQ + tl) * 96; const bf16* K = (const bf16*)(a.ws + A_KH) + (size_t)(b * 8 + h) * SEQ * 96; const bf16* V = (const bf16*)(a.ws + A_VH) + (size_t)(b * 8 + h) * SEQ * 64;
    float mx = -1e30f;
    for (int k = lane; k <= tl; k += 64) { float s = 0.f; for (int e = 0; e < 96; ++e) s += bf2f(q[e]) * bf2f(K[(size_t)k * 96 + e]); mx = fmaxf(mx, s); }
    for (int o = 1; o < 64; o <<= 1) mx = fmaxf(mx, __shfl_xor(mx, o));
    float l = 0.f, acc = 0.f;
    for (int k = lane; k <= tl; k += 64) { float s = 0.f; for (int e = 0; e < 96; ++e) s += bf2f(q[e]) * bf2f(K[(size_t)k * 96 + e]); const float p = exp2f(s - mx); l += p; acc += p * bf2f(V[(size_t)k * 64 + d]); }
    l = wave_sum(l); acc = wave_sum(acc);
    const float got = bf2f(((const bf16*)(a.ws + A_OA))[(size_t)t * 512 + h * 64 + d]);
    if (lane == 0) dbg_report(a.ws, 3, far(got, acc / l, 0.05f));
}
__global__ void chk4(DArgs a) {
    const int i = blockIdx.x * (blockDim.x >> 6) + (threadIdx.x >> 6), p = threadIdx.x & 63; const unsigned h0 = hsh(i * 3 + 31), h1 = hsh(i * 3 + 32);
    const int b = h0 & 1, tl = (h0 >> 1) % 420, ch = h1 % 512, g = ch >> 4, h = ch & 15;
    const float lr = ((const float*)a.in[8])[g * 64 + p], li = ((const float*)a.in[9])[g * 64 + p], dt = expf(((const float*)a.in[10])[g]);
    const float mag = expf(lr * dt), ar = mag * cosf(li * dt), ai = mag * sinf(li * dt), den = lr * lr + li * li, nr = ar - 1.f, ni = ai;
    const float fr_ = (nr * lr + ni * li) / den, fi_ = (ni * lr - nr * li) / den;
    const float* bre = (const float*)a.in[11] + g * 1024 + p * 16; const float* bim = (const float*)a.in[12] + g * 1024 + p * 16;
    const bf16* UP = (const bf16*)(a.ws + A_UP);
    float sr = 0.f, si = 0.f, ulast = 0.f;
    for (int tau = 0; tau <= tl; ++tau) { const bf16* ur = UP + ((size_t)(g * 512 + b * 256 + (tau >> 5)) * 640) + (tau & 31) * 16; float br = 0.f, bi = 0.f;
        for (int hp = 0; hp < 16; ++hp) { const float uu = bf2f(ur[hp]); const float bbr = fr_ * bre[hp] - fi_ * bim[hp], bbi = fr_ * bim[hp] + fi_ * bre[hp]; br += bbr * uu; bi += bbi * uu; }
        const float n0 = ar * sr - ai * si + br, n1 = ar * si + ai * sr + bi; sr = n0; si = n1; ulast = bf2f(ur[h]); }
    const float cr = ((const float*)a.in[13])[g * 1024 + h * 64 + p], ci = ((const float*)a.in[14])[g * 1024 + h * 64 + p];
    float y = wave_sum(cr * sr - ci * si) + ((const float*)a.in[15])[g * 16 + h] * ulast;
    const float k0 = 0.7978845608f; y = 0.5f * y * (1.f + tanhf(k0 * (y + 0.044715f * y * y * y)));
    const float got = bf2f(((const bf16*)((unsigned char*)a.out + O_YS))[(size_t)(b * SEQ + tl) * 512 + ch]);
    if (p == 0) dbg_report(a.ws, 4, far(got, y, 0.3f));
}
__global__ void chk5(DArgs a) {
    const int i = blockIdx.x * blockDim.x + threadIdx.x; const unsigned h0 = hsh(i * 2 + 41), h1 = hsh(i * 2 + 42); const int t = h0 % NTOK, c = h1 % 512;
    const bf16* y = (const bf16*)((unsigned char*)a.out + O_YS) + (size_t)t * 512; const float* w = (const float*)a.in[16]; float z = ((const float*)a.in[17])[c];
    for (int k = 0; k < 512; ++k) z += bf2f(y[k]) * w[(size_t)k * 512 + c];
    const float r = bf2f(y[c]) / (1.f + expf(-z)); dbg_report(a.ws, 5, far(bf2f(((const bf16*)((unsigned char*)a.out + O_OS))[(size_t)t * 512 + c]), r, 0.3f));
}
__global__ void chk7(DArgs a) {
    const int i = blockIdx.x * blockDim.x + threadIdx.x; const unsigned h0 = hsh(i * 2 + 51), h1 = hsh(i * 2 + 52); const int t = h0 % NTOK, c = h1 % 1024;
    const bf16* oa = (const bf16*)(a.ws + A_OA) + (size_t)t * 512; const bf16* os = (const bf16*)((unsigned char*)a.out + O_OS) + (size_t)t * 512;
    const bf16* mx = (const bf16*)(a.ws + A_MIXN) + (size_t)t * 1024; const float* w = (const float*)a.in[20]; const float* ga = (const float*)a.in[18]; const float* gs = (const float*)a.in[19];
    float ss = 0.f; for (int k = 0; k < 512; ++k) ss += bf2f(oa[k]) * bf2f(oa[k]);
    const float ra = rsqrtf(ss / 512.f + 1e-6f); const int kk = h1 % 512; const bool badn = far(bf2f(mx[kk]), bf2f(oa[kk]) * ra, 1.f); (void)os;
    float r = 0.f; for (int k = 0; k < 1024; ++k) r += bf2f(mx[k]) * (k < 512 ? ga[k] : gs[k - 512]) * w[(size_t)k * 1024 + c];
    r += ALPHA * ((const float*)a.in[0])[(size_t)t * 1024 + c];
    dbg_report(a.ws, 6, badn || far(a.out[(size_t)t * 1024 + c], r, 1.f));
}
__global__ void chk8(DArgs a, int which) {
    const int i = blockIdx.x * blockDim.x + threadIdx.x; const unsigned h0 = hsh(i * 2 + 61), h1 = hsh(i * 2 + 62); const int t = h0 % NTOK, c = h1 % 1024; const float* pre = a.out + (size_t)t * 1024;
    float m = 0.f; for (int k = 0; k < 1024; ++k) m += pre[k]; m /= 1024.f; float v = 0.f; for (int k = 0; k < 1024; ++k) v += (pre[k] - m) * (pre[k] - m); v /= 1024.f;
    const float* g = (const float*)a.in[which ? 27 : 21]; const float* bb = (const float*)a.in[which ? 28 : 22]; const float r = (pre[c] - m) * rsqrtf(v + 1e-5f) * g[c] + bb[c];
    dbg_report(a.ws, 7, far(bf2f(((const bf16*)(a.ws + (which ? A_X2 : A_X1)))[(size_t)t * 1024 + c]), r, 1.f));
}
__global__ void chk_k2(DArgs a) {
    const int i = blockIdx.x * blockDim.x + threadIdx.x; const unsigned h0 = hsh(i * 2 + 71), h1 = hsh(i * 2 + 72); const int bm = h0 % 512, n = h1 % 1024, kv = (h1 >> 12) & 1;
    const float* mem = (const float*)a.in[1] + (size_t)bm * 1024; const float* w = (const float*)a.in[kv ? 25 : 24]; float r = 0.f; for (int k = 0; k < 1024; ++k) r += mem[k] * w[(size_t)k * 1024 + n];
    const int b = bm >> 8, m = bm & 255, h = n >> 8, j = n & 255;
    dbg_report(a.ws, 8, far(bf2f(((const bf16*)(a.ws + W_K2V2))[((size_t)(((kv * 2 + b) * 4 + h) * 256 + m)) * 256 + j]), r, 1.f));
}
__global__ void chk10(DArgs a) {
    __shared__ float q[1024], s[1024], o[1024]; __shared__ float red[4];
    const int i = blockIdx.x, tid = threadIdx.x; const unsigned h0 = hsh(i * 2 + 81), h1 = hsh(i * 2 + 82); const int t = h0 % NTOK, c = h1 % 1024, b = t >> 13;
    const bf16* x1 = (const bf16*)(a.ws + A_X1) + (size_t)t * 1024; const float* xq = (const float*)a.in[23]; const float* xo = (const float*)a.in[26];
    const bf16* K2 = (const bf16*)(a.ws + W_K2V2) + (size_t)(0 * 2 + b) * 4 * 256 * 256; const bf16* V2 = (const bf16*)(a.ws + W_K2V2) + (size_t)(1 * 2 + b) * 4 * 256 * 256;
    for (int n = tid; n < 1024; n += 256) { float r = 0.f; for (int k = 0; k < 1024; ++k) r += bf2f(x1[k]) * xq[(size_t)k * 1024 + n]; q[n] = r; }
    __syncthreads();
    for (int n = tid; n < 1024; n += 256) { const int h = n >> 8, m = n & 255; float r = 0.f; for (int j = 0; j < 256; ++j) r += q[h * 256 + j] * bf2f(K2[((size_t)h * 256 + m) * 256 + j]); s[n] = r * 0.0625f; }
    __syncthreads();
    if (tid < 4) { float mx = -1e30f; for (int m = 0; m < 256; ++m) mx = fmaxf(mx, s[tid * 256 + m]); float l = 0.f; for (int m = 0; m < 256; ++m) l += expf(s[tid * 256 + m] - mx); red[tid] = mx; __threadfence_block();
        for (int m = 0; m < 256; ++m) s[tid * 256 + m] = expf(s[tid * 256 + m] - mx) / l; }
    __syncthreads();
    for (int n = tid; n < 1024; n += 256) { const int h = n >> 8, j = n & 255; float r = 0.f; for (int m = 0; m < 256; ++m) r += s[h * 256 + m] * bf2f(V2[((size_t)h * 256 + m) * 256 + j]); o[n] = r; }
    __syncthreads();
    if (tid == 0) { float r = 0.f; for (int n = 0; n < 1024; ++n) r += o[n] * xo[(size_t)n * 1024 + c]; const float res = ALPHA * bf2f(x1[c]);
        dbg_report(a.ws, 9, far(a.out[(size_t)t * 1024 + c] - res, r, 0.06f)); }
}
__global__ void chk12(DArgs a) {
    const int i = blockIdx.x * blockDim.x + threadIdx.x; const unsigned h0 = hsh(i * 2 + 91), h1 = hsh(i * 2 + 92); const int t = h0 % NTOK, hh = h1 % 16, key = (h1 >> 8) % 128;
    const bf16* x2 = (const bf16*)(a.ws + A_X2) + (size_t)t * 1024; const float* wq = (const float*)a.in[29]; const float* sk = (const float*)a.in[(hh & 1) ? 31 : 30] + key * 128; float r = 0.f;
    for (int d = 0; d < 128; ++d) { float qd = 0.f; for (int k = 0; k < 1024; ++k) qd += bf2f(x2[k]) * wq[(size_t)k * 2048 + hh * 128 + d]; r += qd * sk[d]; }
    const int h = hh >> 1; const float* sc = (h < 4 ? a.out : (const float*)(a.ws + A_SCHI)) + (size_t)t * 1024 + (h & 3) * 256 + (hh & 1) * 128 + key;
    dbg_report(a.ws, 10, far(*sc, r, 1.f));
}
__global__ void chk13(DArgs a) {
    __shared__ float s1[128], s2[128]; __shared__ int cnt;
    const int i = blockIdx.x, tid = threadIdx.x; const unsigned h0 = hsh(i * 2 + 101), h1 = hsh(i * 2 + 102); const int t = h0 % NTOK, h = h1 % 8;
    const float* sc = (h < 4 ? a.out : (const float*)(a.ws + A_SCHI)) + (size_t)t * 1024 + (h & 3) * 256;
    s1[tid] = sc[tid]; s1[tid + 64] = sc[tid + 64]; s2[tid] = sc[128 + tid]; s2[tid + 64] = sc[192 + tid]; if (tid == 0) cnt = 0; __syncthreads();
    const int* ids = (const int*)(a.ws + A_IDS) + (size_t)t * 128 + h * 16; const float* gt = (const float*)(a.ws + A_GATES) + (size_t)t * 128 + h * 16;
    float smin = 1e30f, smax = -1e30f; bool bad = false;
    for (int k = 0; k < 16; ++k) { const int id = ids[k]; if (id < 0 || id >= 16384) { bad = true; continue; } const float v = s1[id >> 7] + s2[id & 127]; smin = fminf(smin, v); smax = fmaxf(smax, v); for (int k2 = 0; k2 < k; ++k2) if (ids[k2] == id) bad = true; }
    float l = 0.f; for (int k = 0; k < 16; ++k) { const int id = ids[k] & 16383; l += expf(s1[id >> 7] + s2[id & 127] - smax); }
    for (int k = 0; k < 16; ++k) { const int id = ids[k] & 16383; if (far(gt[k], expf(s1[id >> 7] + s2[id & 127] - smax) / l, 0.02f)) bad = true; }
    int c = 0; for (int e = tid; e < 16384; e += 64) if (s1[e >> 7] + s2[e & 127] > smin + 2e-3f) ++c;
    atomicAdd(&cnt, c); __syncthreads();
    if (tid == 0) dbg_report(a.ws, 11, bad || cnt > 15);
}
__global__ void chk15(DArgs a) {
    __shared__ float hc[128], row[1024], red[256];
    const int i = blockIdx.x, tid = threadIdx.x; const int t = hsh(i * 2 + 111) % NTOK; const bf16* x2 = (const bf16*)(a.ws + A_X2) + (size_t)t * 1024;
    const int* ids = (const int*)(a.ws + A_IDS) + (size_t)t * 128; const float* gt = (const float*)(a.ws + A_GATES) + (size_t)t * 128; const float* ut = (const float*)a.in[32]; const float* vt = (const float*)a.in[33];
    if (tid < 128) { const float* u = ut + (size_t)(ids[tid] & 16383) * 1024; float d = 0.f; for (int k = 0; k < 1024; ++k) d += bf2f(x2[k]) * u[k];
        hc[tid] = gt[tid] * 0.5f * d * (1.f + tanhf(0.7978845608f * (d + 0.044715f * d * d * d))); }
    __syncthreads();
    for (int c = tid; c < 1024; c += 256) { float r = ALPHA * bf2f(x2[c]); for (int k = 0; k < 128; ++k) r += hc[k] * vt[(size_t)(ids[k] & 16383) * 1024 + c]; row[c] = r; }
    __syncthreads();
    float m = 0.f; for (int c = tid; c < 1024; c += 256) m += row[c]; red[tid] = m; __syncthreads(); if (tid == 0) { float s = 0.f; for (int k = 0; k < 256; ++k) s += red[k]; red[0] = s / 1024.f; } __syncthreads(); m = red[0]; __syncthreads();
    float v = 0.f; for (int c = tid; c < 1024; c += 256) v += (row[c] - m) * (row[c] - m); red[tid] = v; __syncthreads(); if (tid == 0) { float s = 0.f; for (int k = 0; k < 256; ++k) s += red[k]; red[0] = s / 1024.f; } __syncthreads(); v = red[0];
    bool bad = false; for (int c = tid; c < 1024; c += 256) { const float r = (row[c] - m) * rsqrtf(v + 1e-5f) * ((const float*)a.in[34])[c] + ((const float*)a.in[35])[c]; if (far(a.out[(size_t)t * 1024 + c], r, 1.f)) bad = true; }
    dbg_report(a.ws, 12, bad);
}
__global__ void dbg_poison(DArgs a) {
    const unsigned f = ((const unsigned*)(a.ws + WS_CTL))[CW_DBG]; if (!f) return; const int code = 32 - (int)f; float sc = 1.f; for (int k = 0; k < code; ++k) sc *= 10.f;
    for (size_t e = (size_t)blockIdx.x * blockDim.x + threadIdx.x; e < (size_t)NTOK * DM; e += (size_t)gridDim.x * blockDim.x) a.out[e] *= sc;
}
#endif

extern "C" void kernel_launch(void* const* d_in, const int* in_sizes, int n_in, void* d_out, int out_size, void* d_ws, size_t ws_size, hipStream_t stream) {
    static int grid = 0;
    if (grid == 0) {
        if (n_in != 36 || in_sizes[0] != NTOK * DM || out_size != NTOK * DM || ws_size < WS_NEED) {
            fprintf(stderr, "kernel_launch: unexpected shapes (n_in %d, in0 %d, out %d, ws %zu); nothing launched\n", n_in, n_in > 0 ? in_sizes[0] : -1, out_size, ws_size); grid = -1; return; }
        int dev = 0, cus = 0, per_cu = 0;
        if (hipGetDevice(&dev) != hipSuccess || hipDeviceGetAttribute(&cus, hipDeviceAttributeMultiprocessorCount, dev) != hipSuccess) { grid = -1; return; }
        if (hipFuncSetAttribute((const void*)mk_fwd, hipFuncAttributeMaxDynamicSharedMemorySize, LDS_BYTES) != hipSuccess) { fprintf(stderr, "kernel_launch: hipFuncSetAttribute failed\n"); grid = -1; return; }
        if (hipOccupancyMaxActiveBlocksPerMultiprocessor(&per_cu, (const void*)mk_fwd, NWAVES * 64, LDS_BYTES) != hipSuccess || per_cu < 1)
            fprintf(stderr, "kernel_launch: note: occupancy query reports %d workgroups per CU\n", per_cu);
        (void)hipGetLastError();
        grid = cus;
    }
    if (grid < 0) return;
    if (hipMemsetAsync((char*)d_ws + WS_CTL, 0, CTL_ZERO_BYTES, stream) != hipSuccess) return;
    Args a{};
    for (int i = 0; i < 36; ++i) a.in[i] = d_in[i];
    a.out = (float*)d_out; a.ws = (unsigned char*)d_ws;
#if MK_DBG
    DArgs da{}; for (int i = 0; i < 36; ++i) da.in[i] = d_in[i]; da.out = (float*)d_out; da.ws = (unsigned char*)d_ws;
    for (int p = 0; p < NPH; ++p) { a.ph_lo = p; a.ph_hi = p + 1; hipLaunchKernelGGL(mk_fwd, dim3(grid), dim3(NWAVES * 64), LDS_BYTES, stream, a);
        if (p == 1) { hipLaunchKernelGGL(chk1, dim3(8), dim3(256), 0, stream, da); hipLaunchKernelGGL(chk_k2, dim3(8), dim3(256), 0, stream, da); }
        if (p == 2) hipLaunchKernelGGL(chk2, dim3(8), dim3(256), 0, stream, da);
        if (p == 4) { hipLaunchKernelGGL(chk3, dim3(64), dim3(256), 0, stream, da); hipLaunchKernelGGL(chk4, dim3(64), dim3(256), 0, stream, da); }
        if (p == 5) hipLaunchKernelGGL(chk5, dim3(8), dim3(256), 0, stream, da);
        if (p == 7) hipLaunchKernelGGL(chk7, dim3(8), dim3(256), 0, stream, da);
        if (p == 8) hipLaunchKernelGGL(chk8, dim3(8), dim3(256), 0, stream, da, 0);
        if (p == 10) hipLaunchKernelGGL(chk10, dim3(64), dim3(256), 0, stream, da);
        if (p == 11) hipLaunchKernelGGL(chk8, dim3(8), dim3(256), 0, stream, da, 1);
        if (p == 12) hipLaunchKernelGGL(chk12, dim3(8), dim3(256), 0, stream, da);
        if (p == 13) hipLaunchKernelGGL(chk13, dim3(512), dim3(64), 0, stream, da);
        if (p == 15) { hipLaunchKernelGGL(chk15, dim3(64), dim3(256), 0, stream, da); hipLaunchKernelGGL(dbg_poison, dim3(1024), dim3(256), 0, stream, da); } }
#elif MK_PER_PHASE
    for (int p = 0; p < NPH; ++p) { a.ph_lo = p; a.ph_hi = p + 1; hipLaunchKernelGGL(mk_fwd, dim3(grid), dim3(NWAVES * 64), LDS_BYTES, stream, a); }
#else
    a.ph_lo = 0; a.ph_hi = NPH; hipLaunchKernelGGL(mk_fwd, dim3(grid), dim3(NWAVES * 64), LDS_BYTES, stream, a);
#endif
}
```

```cpp
#include <hip/hip_runtime.h>
#include <hip/hip_bf16.h>
#include <cstdio>
#include <cstdint>
#include <cmath>

#ifndef MK_PER_PHASE
#define MK_PER_PHASE 0
#endif
#ifndef MK_DBG
#define MK_DBG 0
#endif
#ifndef MK_REP
#define MK_REP 0
#endif
namespace pg8 {
#define PG8_LAS __attribute__((address_space(3)))
typedef unsigned short bf16_t;
typedef short bf16x8 __attribute__((ext_vector_type(8)));
typedef float f32x4 __attribute__((ext_vector_type(4)));
typedef unsigned u32x4 __attribute__((ext_vector_type(4)));
constexpr int BM = 256, BK = 64, HALF = 128, HTB = HALF * BK * 2  , STAGE_BYTES = 8 * HTB, NXCD = 8, WGM = 8;

__host__ __device__ __forceinline__ int lds_byte(int r, int c) { const int st = (r >> 4) * 2 + (c >> 5), rr = r & 15, cc = c & 31, ob = rr * 64 + cc * 2; return st * 1024 + (ob ^ (((ob >> 9) & 1) << 5)); }
__host__ __device__ __forceinline__ void stage_rc(int b, int& R, int& C) { const int st = b / 1024, sb = b % 1024, swz = sb ^ (((sb >> 9) & 1) << 5); R = (st >> 1) * 16 + swz / 64; C = (st & 1) * 32 + (swz % 64) / 2; }
__host__ __device__ __forceinline__ int perm32(int rho) { const int n = rho >> 4, i = rho & 15; return 8 * (i >> 2) + 4 * n + (i & 3); }

struct Unit { int pm, pn; };
struct Gemm { const bf16_t* A; const bf16_t* Bt; int M, N, K; };

struct StaticOrder {
    int nM, nN, nwg, G, c;
    __host__ __device__ void init(int M, int N, int G_, int c_) { nM = M / BM; nN = N / BM; nwg = nM * nN; G = G_; c = c_; }
    __host__ __device__ bool next(int i, Unit& u) const {
        const long L = (long)i * G + c; if (L >= nwg) return false;
        int wgid = (int)L; { const int q = nwg / NXCD, r = nwg % NXCD, xcd = wgid % NXCD, off = wgid / NXCD; wgid = (xcd < r ? xcd * (q + 1) : r * (q + 1) + (xcd - r) * q) + off; }
        const int nig = WGM * nN, gid = wgid / nig, fm = gid * WGM, gsz = (nM - fm) < WGM ? (nM - fm) : WGM;
        u.pm = fm + ((wgid % nig) % gsz); u.pn = (wgid % nig) / gsz; return true;
    }
    __device__ __forceinline__ void a_ready(const Unit&) const {}
    __device__ __forceinline__ void done(const Unit&) const {}
};

__device__ __forceinline__ unsigned cvt_pk_bf16(float lo, float hi) { unsigned r; asm volatile("v_cvt_pk_bf16_f32 %0, %1, %2" : "=v"(r) : "v"(lo), "v"(hi)); return r; }
typedef float f32x2 __attribute__((ext_vector_type(2)));
__device__ __forceinline__ f32x2 gelu_pk(f32x2 v) {
    const f32x2 av = __builtin_elementwise_abs(v), d = av * 0.2316418882f + 1.0f;
    f32x2 t; t.x = __builtin_amdgcn_rcpf(d.x); t.y = __builtin_amdgcn_rcpf(d.y);
    f32x2 q = t * 0.5307027145f + (-0.7265760135f); q = q * t + 0.7107068705f; q = q * t + (-0.142248368f); q = q * t + 0.127414796f; q = q * t;
    const f32x2 s = (v * v) * (-0.72134752044f);
    f32x2 e; e.x = __builtin_amdgcn_exp2f(s.x); e.y = __builtin_amdgcn_exp2f(s.y);
    const f32x2 m = v * (q * e), r = v - m;
    f32x2 o; o.x = v.x < 0.f ? m.x : r.x; o.y = v.y < 0.f ? m.y : r.y; return o;
}

template <int ACT  > struct EpiBf16 {
    static constexpr bool PERM = true, AFTER_DRAIN = false; static_assert(ACT == 0 || ACT == 1, "EpiBf16: ACT is 0 (none) or 1 (gelu_pk)");
    bf16_t* O; int ldc; const float* bias; int split_cols; size_t split_stride; float scale0;
    __device__ __forceinline__ void operator()(const f32x4 (&acc)[2][2][4][2], const Unit& u, int wr, int wc, int fr, int fq) const {
        const int row0 = u.pm * BM + wr * 64 + fr; int colt = u.pn * BM; bf16_t* base = O;
        float sc = 1.f; if (split_cols) { const int t = colt / split_cols; base += (size_t)t * split_stride; colt -= t * split_cols; if (t == 0) sc = scale0; }
        const int col0 = colt + wc * 32 + 8 * fq, bcol0 = u.pn * BM + wc * 32 + 8 * fq;
        f32x4 bv[2][2];
#pragma unroll
        for (int bj = 0; bj < 2; ++bj)
#pragma unroll
            for (int n = 0; n < 2; ++n) bv[bj][n] = bias ? *(const f32x4*)(bias + bcol0 + bj * HALF + 4 * n) : (f32x4){0.f, 0.f, 0.f, 0.f};
#pragma unroll
        for (int ai = 0; ai < 2; ++ai)
#pragma unroll
            for (int m = 0; m < 4; ++m) { bf16_t* rowp = base + (size_t)(row0 + ai * HALF + m * 16) * ldc + col0;
#pragma unroll
                for (int bj = 0; bj < 2; ++bj) { f32x4 v0 = acc[ai][bj][m][0] + bv[bj][0], v1 = acc[ai][bj][m][1] + bv[bj][1];
                    if (ACT == 1) { f32x2 a = gelu_pk((f32x2){v0[0], v0[1]}), b = gelu_pk((f32x2){v0[2], v0[3]}), c = gelu_pk((f32x2){v1[0], v1[1]}), d = gelu_pk((f32x2){v1[2], v1[3]});
                        v0 = (f32x4){a.x, a.y, b.x, b.y}; v1 = (f32x4){c.x, c.y, d.x, d.y}; }
                    v0 = v0 * sc; v1 = v1 * sc; u32x4 w; w.x = cvt_pk_bf16(v0[0], v0[1]); w.y = cvt_pk_bf16(v0[2], v0[3]); w.z = cvt_pk_bf16(v1[0], v1[1]); w.w = cvt_pk_bf16(v1[2], v1[3]);
                    *(u32x4*)(rowp + bj * HALF) = w; } }
    }
};

struct PanelStats {
    unsigned* xbuf;
    unsigned* cnt;
    unsigned* tmo;
    int ntn; float eps;
    unsigned code;
    __device__ __forceinline__ bool run(const f32x4 (&v)[2][2][4][2], const Unit& u, int wr, int wc, int fr, int fq, PG8_LAS unsigned char* lds, int wid, int lane) const {
        typedef float f32x2v __attribute__((ext_vector_type(2)));
        PG8_LAS f32x2v* P = (PG8_LAS f32x2v*)lds;
        PG8_LAS f32x2v* S = (PG8_LAS f32x2v*)(lds + 8192);
        PG8_LAS unsigned* flag = (PG8_LAS unsigned*)(lds + 8192 + 2048);
#pragma unroll
        for (int ai = 0; ai < 2; ++ai)
#pragma unroll
            for (int m = 0; m < 4; ++m) {
                float s = 0.f;
#pragma unroll
                for (int bj = 0; bj < 2; ++bj)
#pragma unroll
                    for (int n = 0; n < 2; ++n) { const f32x4 x = v[ai][bj][m][n]; s += (x[0] + x[1]) + (x[2] + x[3]); }
                s += __shfl_xor(s, 16); s += __shfl_xor(s, 32);
                const float mw = s * (1.0f / 64.0f); float q = 0.f;
#pragma unroll
                for (int bj = 0; bj < 2; ++bj)
#pragma unroll
                    for (int n = 0; n < 2; ++n) { const f32x4 d = v[ai][bj][m][n] - mw; q += (d[0] * d[0] + d[1] * d[1]) + (d[2] * d[2] + d[3] * d[3]); }
                q += __shfl_xor(q, 16); q += __shfl_xor(q, 32);
                if (fq == 0) P[(ai * HALF + wr * 64 + m * 16 + fr) * 4 + wc] = (f32x2v){mw, q};
            }
        asm volatile("s_waitcnt lgkmcnt(0)" ::: "memory"); __builtin_amdgcn_s_barrier(); asm volatile("" ::: "memory");
#if defined(BROKEN_EXCHANGE_NO_WAIT)
#warning BROKEN CONTROL BUILD: the row-statistics exchange does not wait; results are wrong by design
        if (blockIdx.x >= 64) { const long long t0_ = clock64(); while (clock64() - t0_ < 60000) __builtin_amdgcn_s_sleep(8); }
#endif
        const int row = wid * 32 + (lane & 31);
        if (lane < 32) {
            const f32x2v a = P[row * 4 + 0], b = P[row * 4 + 1], c = P[row * 4 + 2], d = P[row * 4 + 3];
            const float mt = (a.x + b.x + c.x + d.x) * 0.25f;
            const float da = a.x - mt, db = b.x - mt, dc = c.x - mt, dd = d.x - mt;
            const float m2 = (a.y + b.y) + (c.y + d.y) + 64.0f * ((da * da + db * db) + (dc * dc + dd * dd));
            unsigned long long* slot = (unsigned long long*)xbuf + ((size_t)(u.pm * BM + row) * 4 + u.pn);
            __hip_atomic_store(slot, ((unsigned long long)__float_as_uint(m2) << 32) | __float_as_uint(mt), __ATOMIC_RELAXED, __HIP_MEMORY_SCOPE_AGENT);
        }
        asm volatile("s_waitcnt vmcnt(0)" ::: "memory");
        if (lane == 0) __hip_atomic_fetch_add(cnt + 64 * u.pm, 1u, __ATOMIC_RELAXED, __HIP_MEMORY_SCOPE_AGENT);
        if (wid == 0) {
            bool dead = false; const unsigned long long t0 = __builtin_amdgcn_s_memrealtime(); const unsigned want = 8u * (unsigned)ntn;
            for (;;) {
#if defined(BROKEN_EXCHANGE_NO_WAIT)
                break;
#endif
                if ((unsigned)__builtin_amdgcn_readfirstlane(__hip_atomic_load(cnt + 64 * u.pm, __ATOMIC_RELAXED, __HIP_MEMORY_SCOPE_AGENT)) >= want) break;
                if (__builtin_amdgcn_s_memrealtime() - t0 > 2000000ull) {
                    if (lane == 0) { unsigned expect = 0u; __hip_atomic_compare_exchange_strong(tmo + 1, &expect, code | (unsigned)(u.pm & 0xff), __ATOMIC_RELAXED, __ATOMIC_RELAXED, __HIP_MEMORY_SCOPE_AGENT);
                                     __hip_atomic_store(tmo, 1u, __ATOMIC_RELAXED, __HIP_MEMORY_SCOPE_AGENT); }
                    dead = true; break; }
                __builtin_amdgcn_s_sleep(2);
            }
            __builtin_amdgcn_fence(__ATOMIC_ACQUIRE, "agent");
            if (lane == 0) flag[0] = dead ? 1u : 0u;
        }
        asm volatile("s_waitcnt vmcnt(0) lgkmcnt(0)" ::: "memory"); __builtin_amdgcn_s_barrier(); asm volatile("" ::: "memory");
        const bool bad = flag[0] != 0u;
        if (lane < 32) {
            const unsigned long long* slot = (const unsigned long long*)xbuf + (size_t)(u.pm * BM + row) * 4; float mt[4], m2[4]; float ms = 0.f;
#pragma unroll
            for (int t = 0; t < 4; ++t) { if (t < ntn) { const unsigned long long w = __hip_atomic_load(slot + t, __ATOMIC_RELAXED, __HIP_MEMORY_SCOPE_AGENT); mt[t] = __uint_as_float((unsigned)w); m2[t] = __uint_as_float((unsigned)(w >> 32)); } else { mt[t] = 0.f; m2[t] = 0.f; } ms += mt[t]; }
            const float mean = ms / (float)ntn; float q = 0.f;
#pragma unroll
            for (int t = 0; t < 4; ++t) if (t < ntn) { const float dm = mt[t] - mean; q += m2[t] + 256.0f * dm * dm; }
            S[row] = (f32x2v){mean, 1.0f / sqrtf(q / (256.0f * (float)ntn) + eps)};
        }
        asm volatile("s_waitcnt lgkmcnt(0)" ::: "memory"); __builtin_amdgcn_s_barrier(); asm volatile("" ::: "memory");
        return bad;
    }
};
struct EpiLnRes {
    static constexpr bool PERM = false, AFTER_DRAIN = true;
    const float* base; float* out; int ldc; const float* bias; PanelStats st; unsigned poison;
    __device__ __forceinline__ void fused(f32x4 (&acc)[2][2][4][2], const Unit& u, int wr, int wc, int fr, int fq, PG8_LAS unsigned char* lds, int wid, int lane) const {
        typedef float f32x2v __attribute__((ext_vector_type(2)));
        const PG8_LAS f32x2v* S = (const PG8_LAS f32x2v*)(lds + 8192);
        const int col0 = u.pn * BM + wc * 32 + 4 * fq;
#pragma unroll
        for (int bj = 0; bj < 2; ++bj)
#pragma unroll
            for (int n = 0; n < 2; ++n) { const f32x4 bv = bias ? *(const f32x4*)(bias + col0 + bj * HALF + n * 16) : (f32x4){0.f, 0.f, 0.f, 0.f};
#pragma unroll
                for (int ai = 0; ai < 2; ++ai)
#pragma unroll
                    for (int m = 0; m < 4; ++m) acc[ai][bj][m][n] += bv; }
        f32x4 pre[4][2][2];
#pragma unroll
        for (int m = 0; m < 4; ++m) { const size_t off = (size_t)(u.pm * BM + wr * 64 + m * 16 + fr) * ldc + col0;
#pragma unroll
            for (int bj = 0; bj < 2; ++bj)
#pragma unroll
                for (int n = 0; n < 2; ++n) pre[m][bj][n] = *(const f32x4*)(base + off + bj * HALF + n * 16); }
        const bool bad = st.run(acc, u, wr, wc, fr, fq, lds, wid, lane) || poison != 0u;
        const float qnan = __builtin_nanf("");
#pragma unroll
        for (int ai = 0; ai < 2; ++ai)
#pragma unroll
            for (int m = 0; m < 4; ++m) { const int r = ai * HALF + wr * 64 + m * 16 + fr; const f32x2v sr = S[r]; const size_t off = (size_t)(u.pm * BM + r) * ldc + col0;
#pragma unroll
                for (int bj = 0; bj < 2; ++bj)
#pragma unroll
                    for (int n = 0; n < 2; ++n) { const f32x4 bs = ai == 0 ? pre[m][bj][n] : *(const f32x4*)(base + off + bj * HALF + n * 16); f32x4 o = bs + (acc[ai][bj][m][n] - sr.x) * sr.y;
                        if (bad) o = (f32x4){qnan, qnan, qnan, qnan}; *(f32x4*)(out + off + bj * HALF + n * 16) = o; }
                if (m & 1) asm volatile("" ::: "memory"); }
    }
};
struct EpiLnResLn {
    static constexpr bool PERM = false, AFTER_DRAIN = true;
    const float* base; float* out; bf16_t* xn; int ldc; const float* bias; PanelStats st1, st2; unsigned poison;
    __device__ __forceinline__ void fused(f32x4 (&acc)[2][2][4][2], const Unit& u, int wr, int wc, int fr, int fq, PG8_LAS unsigned char* lds, int wid, int lane) const {
        typedef float f32x2v __attribute__((ext_vector_type(2))); typedef unsigned u32x2v __attribute__((ext_vector_type(2)));
        const PG8_LAS f32x2v* S = (const PG8_LAS f32x2v*)(lds + 8192);
        const int col0 = u.pn * BM + wc * 32 + 4 * fq;
#pragma unroll
        for (int bj = 0; bj < 2; ++bj)
#pragma unroll
            for (int n = 0; n < 2; ++n) { const f32x4 bv = bias ? *(const f32x4*)(bias + col0 + bj * HALF + n * 16) : (f32x4){0.f, 0.f, 0.f, 0.f};
#pragma unroll
                for (int ai = 0; ai < 2; ++ai)
#pragma unroll
                    for (int m = 0; m < 4; ++m) acc[ai][bj][m][n] += bv; }
        bool bad = st1.run(acc, u, wr, wc, fr, fq, lds, wid, lane) || poison != 0u;
        const float qnan = __builtin_nanf("");
#pragma unroll
        for (int ai = 0; ai < 2; ++ai)
#pragma unroll
            for (int m = 0; m < 4; ++m) { const int r = ai * HALF + wr * 64 + m * 16 + fr; const f32x2v sr = S[r]; const size_t off = (size_t)(u.pm * BM + r) * ldc + col0;
#pragma unroll
                for (int bj = 0; bj < 2; ++bj)
#pragma unroll
                    for (int n = 0; n < 2; ++n) { const f32x4 bs = *(const f32x4*)(base + off + bj * HALF + n * 16); acc[ai][bj][m][n] = bs + (acc[ai][bj][m][n] - sr.x) * sr.y; }
                asm volatile("" : "+v"(acc[ai][0][m][0]), "+v"(acc[ai][0][m][1]), "+v"(acc[ai][1][m][0]), "+v"(acc[ai][1][m][1]));
                if (m & 1) asm volatile("" ::: "memory"); }
        const bool bad1 = bad;
        bad = st2.run(acc, u, wr, wc, fr, fq, lds, wid, lane) || bad;
#pragma unroll
        for (int ai = 0; ai < 2; ++ai)
#pragma unroll
            for (int m = 0; m < 4; ++m) { const int r = ai * HALF + wr * 64 + m * 16 + fr; const f32x2v sr = S[r]; const size_t off = (size_t)(u.pm * BM + r) * ldc + col0;
#pragma unroll
                for (int bj = 0; bj < 2; ++bj)
#pragma unroll
                    for (int n = 0; n < 2; ++n) { const f32x4 x1 = acc[ai][bj][m][n]; *(f32x4*)(out + off + bj * HALF + n * 16) = bad1 ? (f32x4){qnan, qnan, qnan, qnan} : x1;
                        const f32x4 o = (x1 - sr.x) * sr.y; u32x2v w; w.x = cvt_pk_bf16(o[0], o[1]); w.y = cvt_pk_bf16(o[2], o[3]);
                        if (bad) { w.x = 0x7fc07fc0u; w.y = 0x7fc07fc0u; } *(u32x2v*)(xn + off + bj * HALF + n * 16) = w; }
                asm volatile("" ::: "memory"); }
    }
};

template <class Epi, class Sched, bool ALIGN_EPI = false, bool SP2 = false>
__device__ __forceinline__ void gemm_phase(PG8_LAS unsigned char* lds, const Gemm g, const Sched& S, const Epi& E) {
    int tid_ = threadIdx.x; asm volatile("" : "+v"(tid_));
    const int tid = tid_, wid = __builtin_amdgcn_readfirstlane(tid >> 6), lane = tid & 63, wr = wid >> 2, wc = wid & 3, fr = lane & 15, fq = lane >> 4;
    const int K = g.K, nt = K / BK;
    unsigned voffA[2], voffB[2];
#pragma unroll
    for (int i = 0; i < 2; ++i) { int R, C; stage_rc(tid * 16 + i * 8192, R, C); const int Rb = Epi::PERM ? ((R & ~31) + perm32(R & 31)) : R;
        voffA[i] = (unsigned)(R * K + C) * 2u; voffB[i] = (unsigned)(Rb * K + C) * 2u; }
    const size_t kstep = (size_t)(BK * 2);
    const size_t hstep = (size_t)HALF * K * 2;
    const size_t tstep = 2 * hstep;
    const unsigned ldsw = (unsigned)wid * 1024u;
    const int aoff = lds_byte(wr * 64 + fr, fq * 8), boff = lds_byte(wc * 32 + fr, fq * 8);
#define PG8_SA(b, h) (((b) * 2 + (h)) * HTB)
#define PG8_SB(b, h) ((4 + (b) * 2 + (h)) * HTB)
#define PG8_STAGE(bufoff, gbase, voff) do { _Pragma("unroll") for (int _i = 0; _i < 2; ++_i) \
        __builtin_amdgcn_global_load_lds((const unsigned*)((const char*)(gbase) + (voff)[_i]), (PG8_LAS unsigned*)(lds + (bufoff) + ldsw + _i * 8192), 16, 0, 0); } while (0)
#define PG8_LDA(dst, b, h) do { _Pragma("unroll") for (int m = 0; m < 4; ++m) _Pragma("unroll") for (int k = 0; k < 2; ++k) dst[m][k] = *(const PG8_LAS bf16x8*)(lds + PG8_SA(b, h) + aoff + m * 2048 + k * 1024); } while (0)
#define PG8_LDB(dst, b, h) do { _Pragma("unroll") for (int n = 0; n < 2; ++n) _Pragma("unroll") for (int k = 0; k < 2; ++k) dst[n][k] = *(const PG8_LAS bf16x8*)(lds + PG8_SB(b, h) + boff + n * 2048 + k * 1024); } while (0)
#define PG8_MMA(ai, bj, At, Bt) do { __builtin_amdgcn_s_setprio(1); _Pragma("unroll") for (int m = 0; m < 4; ++m) _Pragma("unroll") for (int n = 0; n < 2; ++n) _Pragma("unroll") for (int k = 0; k < 2; ++k) \
        acc[ai][bj][m][n] = __builtin_amdgcn_mfma_f32_16x16x32_bf16(Bt[n][k], At[m][k], acc[ai][bj][m][n], 0, 0, 0); __builtin_amdgcn_s_setprio(0); } while (0)
#define PG8_WAIT_V(n) asm volatile("s_waitcnt vmcnt(" #n ")" ::: "memory")
#define PG8_WAIT_L(n) asm volatile("s_waitcnt lgkmcnt(" #n ")" ::: "memory")
#define PG8_BAR __builtin_amdgcn_s_barrier()
#define PG8_SCHED __builtin_amdgcn_sched_barrier(0)
    Unit cur, nxt; int ui = 0;
    if (!S.next(0, cur)) return;
    f32x4 acc[2][2][4][2];
#pragma unroll
    for (int a = 0; a < 2; ++a)
#pragma unroll
        for (int b = 0; b < 2; ++b)
#pragma unroll
            for (int m = 0; m < 4; ++m)
#pragma unroll
                for (int n = 0; n < 2; ++n) acc[a][b][m][n] = (f32x4){0.f, 0.f, 0.f, 0.f};
    bf16x8 At[4][2], B0[2][2], B1[2][2];
    const char* cA = (const char*)g.A + (size_t)cur.pm * tstep; const char* cB = (const char*)g.Bt + (size_t)cur.pn * tstep;
    S.a_ready(cur);
    if constexpr (SP2) {
        PG8_STAGE(PG8_SB(0, 0), cB, voffB); PG8_STAGE(PG8_SB(0, 1), cB + hstep, voffB); PG8_STAGE(PG8_SA(0, 0), cA, voffA); PG8_STAGE(PG8_SA(0, 1), cA + hstep, voffA);
        if (wr == 1) PG8_BAR;
        PG8_WAIT_V(2); PG8_BAR;
        PG8_STAGE(PG8_SB(1, 0), cB + kstep, voffB); PG8_STAGE(PG8_SA(1, 0), cA + kstep, voffA); PG8_STAGE(PG8_SB(1, 1), cB + hstep + kstep, voffB);
        PG8_WAIT_V(6); PG8_BAR;
    } else {
        PG8_STAGE(PG8_SB(0, 0), cB, voffB); PG8_STAGE(PG8_SA(0, 0), cA, voffA); PG8_STAGE(PG8_SB(0, 1), cB + hstep, voffB); PG8_STAGE(PG8_SA(0, 1), cA + hstep, voffA);
        if (wr == 1) PG8_BAR;
        PG8_WAIT_V(4); PG8_BAR;
        PG8_STAGE(PG8_SB(1, 0), cB + kstep, voffB); PG8_STAGE(PG8_SA(1, 0), cA + kstep, voffA); PG8_STAGE(PG8_SB(1, 1), cB + hstep + kstep, voffB);
        PG8_WAIT_V(6); PG8_BAR;
    }
    for (;;) {
        const bool has_next = S.next(ui + 1, nxt);
        const char* nA = has_next ? (const char*)g.A + (size_t)nxt.pm * tstep : cA; const char* nB = has_next ? (const char*)g.Bt + (size_t)nxt.pn * tstep : cB;
#pragma unroll 1
        for (int t = 0; t < nt; t += 2) {
            const bool last = (t == nt - 2);
            const char* a1 = cA + (size_t)(t + 1) * kstep;
            const char* a2 = last ? nA : cA + (size_t)(t + 2) * kstep; const char* b2 = last ? nB : cB + (size_t)(t + 2) * kstep;
            const char* a3 = a2 + kstep; const char* b3 = b2 + kstep;
            if (last && has_next) S.a_ready(nxt);
            if constexpr (SP2) {
            PG8_LDB(B0, 0, 0); PG8_LDB(B1, 0, 1); PG8_SCHED; PG8_LDA(At, 0, 0); PG8_STAGE(PG8_SA(1, 1), a1 + hstep, voffA);
            PG8_WAIT_V(8); PG8_WAIT_L(0); PG8_BAR; PG8_MMA(0, 0, At, B0); PG8_MMA(0, 1, At, B1); PG8_BAR; PG8_SCHED;
            PG8_LDA(At, 0, 1); PG8_STAGE(PG8_SB(0, 0), b2, voffB); PG8_STAGE(PG8_SB(0, 1), b2 + hstep, voffB); PG8_STAGE(PG8_SA(0, 0), a2, voffA);
            PG8_WAIT_V(8); PG8_WAIT_L(0); PG8_BAR; PG8_MMA(1, 0, At, B0); PG8_MMA(1, 1, At, B1); PG8_BAR; PG8_SCHED;
            PG8_LDB(B0, 1, 0); PG8_LDB(B1, 1, 1); PG8_SCHED; PG8_LDA(At, 1, 0); PG8_STAGE(PG8_SA(0, 1), a2 + hstep, voffA);
            PG8_WAIT_V(8); PG8_WAIT_L(0); PG8_BAR; PG8_MMA(0, 0, At, B0); PG8_MMA(0, 1, At, B1); PG8_BAR; PG8_SCHED;
            PG8_LDA(At, 1, 1); PG8_STAGE(PG8_SB(1, 0), b3, voffB); PG8_STAGE(PG8_SB(1, 1), b3 + hstep, voffB); PG8_STAGE(PG8_SA(1, 0), a3, voffA);
            PG8_WAIT_V(8); PG8_WAIT_L(0); PG8_BAR; PG8_MMA(1, 0, At, B0); PG8_MMA(1, 1, At, B1); PG8_BAR; PG8_SCHED;
            } else {
            PG8_LDB(B0, 0, 0); PG8_SCHED; PG8_LDA(At, 0, 0); PG8_STAGE(PG8_SA(1, 1), a1 + hstep, voffA);
            PG8_WAIT_L(8); PG8_BAR; PG8_WAIT_L(0); PG8_MMA(0, 0, At, B0); PG8_BAR; PG8_SCHED;
            PG8_LDB(B1, 0, 1); PG8_STAGE(PG8_SB(0, 0), b2, voffB);
            PG8_BAR; PG8_WAIT_L(0); PG8_MMA(0, 1, At, B1); PG8_BAR;
            PG8_LDA(At, 0, 1); PG8_STAGE(PG8_SA(0, 0), a2, voffA);
            PG8_BAR; PG8_WAIT_L(0); PG8_MMA(1, 0, At, B0); PG8_BAR; PG8_SCHED;
            PG8_STAGE(PG8_SB(0, 1), b2 + hstep, voffB);
            PG8_WAIT_V(6); PG8_BAR; PG8_MMA(1, 1, At, B1); PG8_BAR;
            PG8_LDB(B0, 1, 0); PG8_SCHED; PG8_LDA(At, 1, 0); PG8_STAGE(PG8_SA(0, 1), a2 + hstep, voffA);
            PG8_WAIT_L(8); PG8_BAR; PG8_WAIT_L(0); PG8_MMA(0, 0, At, B0); PG8_BAR; PG8_SCHED;
            PG8_LDB(B1, 1, 1); PG8_STAGE(PG8_SB(1, 0), b3, voffB);
            PG8_BAR; PG8_WAIT_L(0); PG8_MMA(0, 1, At, B1); PG8_BAR;
            PG8_LDA(At, 1, 1); PG8_STAGE(PG8_SA(1, 0), a3, voffA);
            PG8_BAR; PG8_WAIT_L(0); PG8_MMA(1, 0, At, B0); PG8_BAR; PG8_SCHED;
            PG8_STAGE(PG8_SB(1, 1), b3 + hstep, voffB);
            PG8_WAIT_V(6); PG8_BAR; PG8_MMA(1, 1, At, B1); PG8_BAR;
            }
        }
        if constexpr (ALIGN_EPI) { if (wr == 0) PG8_BAR; }
        if constexpr (!Epi::AFTER_DRAIN) { E(acc, cur, wr, wc, fr, fq); S.done(cur); }
        if (!has_next) break;
#pragma unroll
        for (int a = 0; a < 2; ++a)
#pragma unroll
            for (int b = 0; b < 2; ++b)
#pragma unroll
                for (int m = 0; m < 4; ++m)
#pragma unroll
                    for (int n = 0; n < 2; ++n) acc[a][b][m][n] = (f32x4){0.f, 0.f, 0.f, 0.f};
        cur = nxt; cA = nA; cB = nB; ++ui;
        if constexpr (ALIGN_EPI) { if (wr == 1) PG8_BAR; }
    }
    PG8_WAIT_V(0);
    if constexpr (!ALIGN_EPI) { if (wr == 0) PG8_BAR; }
    PG8_BAR;
    if constexpr (Epi::AFTER_DRAIN) { E.fused(acc, cur, wr, wc, fr, fq, lds, wid, lane); S.done(cur); }
#undef PG8_SA
#undef PG8_SB
#undef PG8_STAGE
#undef PG8_LDA
#undef PG8_LDB
#undef PG8_MMA
#undef PG8_WAIT_V
#undef PG8_WAIT_L
#undef PG8_BAR
#undef PG8_SCHED
}
}

namespace mk {
typedef unsigned short bf16;
typedef float f32x4 __attribute__((ext_vector_type(4)));
typedef float f32x2 __attribute__((ext_vector_type(2)));
typedef unsigned u32x4 __attribute__((ext_vector_type(4)));
typedef unsigned u32x2 __attribute__((ext_vector_type(2)));
typedef short bf16x8 __attribute__((ext_vector_type(8)));
#define LAS __attribute__((address_space(3)))

constexpr int NTOK = 16384, DM = 1024, SEQ = 8192, NBATCH = 2;
constexpr int QL = 384, KVL = 256, NINP = 1280;
constexpr float ALPHA = 1.18920711500272f;
constexpr float C2Q = 0.10206207261596575f * 1.4426950408889634f;
constexpr float XSC = 0.0625f * 1.4426950408889634f;
constexpr float LN_EPS = 1e-5f, RMS_EPS = 1e-6f;

constexpr size_t MiB = 1u << 20;
constexpr size_t WS_CTL = 0, CTL_ZERO_BYTES = 1 * MiB;
constexpr size_t W_WINT = 1 * MiB;
constexpr size_t W_WUQT = W_WINT + (size_t)1280 * 1024 * 2;
constexpr size_t W_WUKVT = W_WUQT + (size_t)768 * 384 * 2;
constexpr size_t W_WGLUT = W_WUKVT + (size_t)1024 * 256 * 2;
constexpr size_t W_WOUTT = W_WGLUT + (size_t)512 * 512 * 2;
constexpr size_t W_XKVT = W_WOUTT + (size_t)1024 * 1024 * 2;
constexpr size_t W_XQH = W_XKVT + (size_t)2048 * 1024 * 2;
constexpr size_t W_XOTH = W_XQH + (size_t)4 * 1024 * 256 * 2;
constexpr size_t W_MB = W_XOTH + (size_t)4 * 1024 * 256 * 2;
constexpr size_t W_VOT = W_MB + (size_t)2 * 1024 * 1024 * 2;
constexpr size_t W_K2V2 = W_VOT + (size_t)2 * 1024 * 1024 * 2;
constexpr size_t W_WQR = W_K2V2 + (size_t)2 * 2 * 4 * 256 * 256 * 2;
constexpr size_t W_SKP = W_WQR + (size_t)16 * 1024 * 256 * 2;
constexpr size_t W_WSC = W_SKP + (size_t)2 * 256 * 256 * 2;
constexpr size_t W_TH = W_WSC + (size_t)2048 * 1024 * 2;
constexpr size_t W_GM = W_TH + (size_t)32 * 512 * 640 * 2;
constexpr size_t W_MEMB = W_GM + (size_t)32 * 256 * 640 * 2;
constexpr size_t W_ROPE = W_MEMB + (size_t)512 * 1024 * 2;
constexpr size_t W_SSQ = W_ROPE + (size_t)16384 * 16 * 8;
constexpr size_t W_END = W_SSQ + (size_t)16384 * 20 * 4;
static_assert(W_END <= 80 * MiB, "weights region");
constexpr size_t A_UT = 80 * MiB, A_VT = 96 * MiB;
constexpr size_t A_SCHI = 112 * MiB;
constexpr size_t A_CQ = 144 * MiB, A_CKV = 156 * MiB, A_UP = 164 * MiB, A_QH = 184 * MiB, A_KH = 208 * MiB, A_VH = 232 * MiB, A_LS = 248 * MiB;
constexpr size_t A_OA = 144 * MiB, A_MIXN = 184 * MiB, A_X1 = 216 * MiB, A_P = 144 * MiB, A_X2 = 176 * MiB, A_IDS = 208 * MiB, A_GATES = 216 * MiB;
constexpr size_t WS_NEED = 256 * MiB;
constexpr size_t O_XB = 0, O_YS = 0, O_OS = 16 * MiB;
constexpr int CW_TMO = 0, CW_BAR = 4096, CW_SSQQ = 16384, CW_SSQKV = 32768, CW_DBG = 65536;
constexpr int RING_BYTES = 131072, EXCH_OFF = 131072, MISC_OFF = EXCH_OFF + 8192, LDS_BYTES = 147456;

__device__ __forceinline__ unsigned cvtpk(float lo, float hi) { unsigned r; asm volatile("v_cvt_pk_bf16_f32 %0, %1, %2" : "=v"(r) : "v"(lo), "v"(hi)); return r; }
__device__ __forceinline__ u32x4 pack8(f32x4 a, f32x4 b) { u32x4 w; w.x = cvtpk(a[0], a[1]); w.y = cvtpk(a[2], a[3]); w.z = cvtpk(b[0], b[1]); w.w = cvtpk(b[2], b[3]); return w; }
__device__ __forceinline__ float bflo(unsigned w) { return __uint_as_float(w << 16); }
__device__ __forceinline__ float bfhi(unsigned w) { return __uint_as_float(w & 0xffff0000u); }
__device__ __forceinline__ void unpack8(u32x4 w, f32x4& a, f32x4& b) { a = (f32x4){bflo(w.x), bfhi(w.x), bflo(w.y), bfhi(w.y)}; b = (f32x4){bflo(w.z), bfhi(w.z), bflo(w.w), bfhi(w.w)}; }
__device__ __forceinline__ float gelu_tanh(float v) {
    const float z = v * (1.0f + 0.044715f * v * v) * (-2.0f * 0.7978845608028654f * 1.4426950408889634f);
    return v * __builtin_amdgcn_rcpf(1.0f + __builtin_amdgcn_exp2f(z));
}
__device__ __forceinline__ float sigmoidf_(float z) { return __builtin_amdgcn_rcpf(1.0f + __builtin_amdgcn_exp2f(-1.4426950408889634f * z)); }

template <class Dec> struct ListSched {
    int n, G, c; Dec dec;
    __device__ __forceinline__ bool next(int i, pg8::Unit& u) const { const long L = (long)i * G + c; if (L >= n) return false; dec((int)L, u); return true; }
    __device__ __forceinline__ void a_ready(const pg8::Unit&) const {}
    __device__ __forceinline__ void done(const pg8::Unit&) const {}
};
struct BigSched {
    pg8::StaticOrder so; int bt;
    __device__ __forceinline__ bool next(int i, pg8::Unit& u) const { if (!so.next(i, u)) return false; u.pn += (u.pm >> 5) * bt; return true; }
    __device__ __forceinline__ void a_ready(const pg8::Unit&) const {}
    __device__ __forceinline__ void done(const pg8::Unit&) const {}
};
struct DecLS  { __device__ __forceinline__ void operator()(int L, pg8::Unit& u) const { const int g = L >> 1, b = L & 1; u.pm = 2 * g + b; u.pn = g; } };
struct DecY   { __device__ __forceinline__ void operator()(int L, pg8::Unit& u) const { const int g = L >> 2, b = (L >> 1) & 1, n = L & 1; u.pm = 2 * g + b; u.pn = 2 * g + n; } };
struct DecKV2 { __device__ __forceinline__ void operator()(int L, pg8::Unit& u) const { u.pm = L >> 3; u.pn = L & 7; } };
struct DecMb  { __device__ __forceinline__ void operator()(int L, pg8::Unit& u) const { const int bh = L >> 2, kt = L & 3; u.pm = bh; u.pn = (bh & 3) * 4 + kt; } };
struct DecVOT { __device__ __forceinline__ void operator()(int L, pg8::Unit& u) const { const int bh = L >> 2, ct = L & 3; u.pm = (bh & 3) * 4 + ct; u.pn = bh; } };
struct DecWsc { __device__ __forceinline__ void operator()(int L, pg8::Unit& u) const { const int hh = L >> 2, kt = L & 3; u.pm = hh & 1; u.pn = hh * 4 + kt; } };

typedef f32x4 AccT[2][2][4][2];
#define EPI_ROWS_BEGIN _Pragma("unroll") for (int ai = 0; ai < 2; ++ai) _Pragma("unroll") for (int m = 0; m < 4; ++m) { const int rt = ai * 128 + wr * 64 + m * 16 + fr;
#define EPI_ROWS_END asm volatile("" ::: "memory"); }

__device__ __forceinline__ void rope8(f32x4& v0, f32x4& v1, const float2* cs) {
#pragma unroll
    for (int j = 0; j < 4; ++j) { const float2 c = cs[j]; const float a = v0[j], b = v1[j]; v0[j] = a * c.x - b * c.y; v1[j] = b * c.x + a * c.y; }
}

struct EpiWin {
    static constexpr bool PERM = true, AFTER_DRAIN = false;
    bf16* CQ; bf16* CKV; bf16* KH; bf16* UP; const float2* rope; float* ssqp;
    __device__ __forceinline__ void operator()(AccT& acc, const pg8::Unit& u, int wr, int wc, int fr, int fq) const { asm volatile("" : "+v"(fr), "+v"(fq));
#pragma unroll
        for (int bj = 0; bj < 2; ++bj) {
            const int s = 8 * u.pn + 4 * bj + wc;
            if (s >= 21 && s < 24) continue;
            const int c0 = 32 * s + 8 * fq;
            EPI_ROWS_BEGIN {
                const int t = u.pm * 256 + rt; f32x4 v0 = acc[ai][bj][m][0], v1 = acc[ai][bj][m][1];
                if (s < 20) {
                    float q = (v0[0] * v0[0] + v0[1] * v0[1]) + (v0[2] * v0[2] + v0[3] * v0[3]) + (v1[0] * v1[0] + v1[1] * v1[1]) + (v1[2] * v1[2] + v1[3] * v1[3]);
                    q += __shfl_xor(q, 16); q += __shfl_xor(q, 32);
                    if (fq == 0) ssqp[(size_t)t * 20 + s] = q;
                    if (s < 12) *(u32x4*)(CQ + (size_t)t * QL + c0) = pack8(v0, v1);
                    else *(u32x4*)(CKV + (size_t)t * KVL + (c0 - 384)) = pack8(v0, v1);
                } else if (s == 20) {
                    rope8(v0, v1, rope + (size_t)t * 16 + 4 * fq);
                    const u32x4 w = pack8(v0, v1); const int b = t >> 13, tl = t & 8191;
#pragma unroll
                    for (int h = 0; h < 8; ++h) *(u32x4*)(KH + ((size_t)(b * 8 + h) * SEQ + tl) * 96 + 64 + 8 * fq) = w;
                } else {
                    const int ch = c0 - 768, g = ch >> 4, h8 = ch & 15, b = t >> 13, tl = t & 8191, chunk = b * 256 + (tl >> 5), j = tl & 31;
                    *(u32x4*)(UP + ((size_t)(g * 512 + chunk) * 640) + j * 16 + h8) = pack8(v0, v1);
                }
            } EPI_ROWS_END
        }
    }
};
struct EpiQ {
    static constexpr bool PERM = true, AFTER_DRAIN = false;
    bf16* QH; const float2* rope; const float* ssqp;
    __device__ __forceinline__ void operator()(AccT& acc, const pg8::Unit& u, int wr, int wc, int fr, int fq) const { asm volatile("" : "+v"(fr), "+v"(fq));
#pragma unroll
        for (int bj = 0; bj < 2; ++bj) {
            const int s = 8 * u.pn + 4 * bj + wc, h = s / 3, sl = s - 3 * h, d0 = sl * 32 + 8 * fq;
            EPI_ROWS_BEGIN {
                const int t = u.pm * 256 + rt; const f32x4 qa = *(const f32x4*)(ssqp + (size_t)t * 20), qb = *(const f32x4*)(ssqp + (size_t)t * 20 + 4), qc = *(const f32x4*)(ssqp + (size_t)t * 20 + 8);
                const float sq = ((qa[0] + qa[1]) + (qa[2] + qa[3])) + ((qb[0] + qb[1]) + (qb[2] + qb[3])) + ((qc[0] + qc[1]) + (qc[2] + qc[3]));
                const float rq = rsqrtf(sq * (1.0f / QL) + RMS_EPS) * C2Q;
                f32x4 v0 = acc[ai][bj][m][0] * rq, v1 = acc[ai][bj][m][1] * rq;
                if (sl == 2) rope8(v0, v1, rope + (size_t)t * 16 + 4 * fq);
                const int b = t >> 13, tl = t & 8191;
                *(u32x4*)(QH + ((size_t)(b * 8 + h) * SEQ + tl) * 96 + d0) = pack8(v0, v1);
            } EPI_ROWS_END
        }
    }
};
struct EpiKV {
    static constexpr bool PERM = true, AFTER_DRAIN = false;
    bf16* KH; bf16* VH; const float* ssqp;
    __device__ __forceinline__ void operator()(AccT& acc, const pg8::Unit& u, int wr, int wc, int fr, int fq) const { asm volatile("" : "+v"(fr), "+v"(fq));
#pragma unroll
        for (int bj = 0; bj < 2; ++bj) {
            const int s = 8 * u.pn + 4 * bj + wc, h = s >> 2, sl = s & 3, j0 = sl * 32 + 8 * fq;
            EPI_ROWS_BEGIN {
                const int t = u.pm * 256 + rt; const f32x4 qa = *(const f32x4*)(ssqp + (size_t)t * 20 + 12), qb = *(const f32x4*)(ssqp + (size_t)t * 20 + 16);
                const float rk = rsqrtf((((qa[0] + qa[1]) + (qa[2] + qa[3])) + ((qb[0] + qb[1]) + (qb[2] + qb[3]))) * (1.0f / KVL) + RMS_EPS);
                const f32x4 v0 = acc[ai][bj][m][0] * rk, v1 = acc[ai][bj][m][1] * rk; const int b = t >> 13, tl = t & 8191;
                if (sl < 2) *(u32x4*)(KH + ((size_t)(b * 8 + h) * SEQ + tl) * 96 + j0) = pack8(v0, v1);
                else *(u32x4*)(VH + ((size_t)(b * 8 + h) * SEQ + tl) * 64 + (j0 - 64)) = pack8(v0, v1);
            } EPI_ROWS_END
        }
    }
};
struct EpiLS {
    static constexpr bool PERM = false, AFTER_DRAIN = false;
    float* LS;
    __device__ __forceinline__ void operator()(AccT& acc, const pg8::Unit& u, int wr, int wc, int fr, int fq) const { asm volatile("" : "+v"(fr), "+v"(fq));
        const int g = u.pn, b = u.pm & 1;
        EPI_ROWS_BEGIN {
            float* rowp = LS + ((size_t)(g * 512 + b * 256 + rt)) * 128 + wc * 32 + 4 * fq;
            *(f32x4*)(rowp) = acc[ai][0][m][0]; *(f32x4*)(rowp + 16) = acc[ai][0][m][1];
        } EPI_ROWS_END
    }
};
struct EpiY {
    static constexpr bool PERM = true, AFTER_DRAIN = false;
    bf16* YS;
    __device__ __forceinline__ void operator()(AccT& acc, const pg8::Unit& u, int wr, int wc, int fr, int fq) const { asm volatile("" : "+v"(fr), "+v"(fq));
        const int g = u.pm >> 1, b = u.pm & 1, nt = u.pn & 1;
#pragma unroll
        for (int bj = 0; bj < 2; ++bj) {
            const int n0 = nt * 256 + bj * 128 + wc * 32 + 8 * fq, i = n0 >> 4, h8 = n0 & 15;
            EPI_ROWS_BEGIN {
                const int t = b * SEQ + rt * 32 + i; f32x4 v0 = acc[ai][bj][m][0], v1 = acc[ai][bj][m][1];
#pragma unroll
                for (int j = 0; j < 4; ++j) { v0[j] = gelu_tanh(v0[j]); v1[j] = gelu_tanh(v1[j]); }
                *(u32x4*)(YS + (size_t)t * 512 + g * 16 + h8) = pack8(v0, v1);
            } EPI_ROWS_END
        }
    }
};
struct EpiGlu {
    static constexpr bool PERM = true, AFTER_DRAIN = false;
    const bf16* YS; bf16* OS; const float* bglu;
    __device__ __forceinline__ void operator()(AccT& acc, const pg8::Unit& u, int wr, int wc, int fr, int fq) const { asm volatile("" : "+v"(fr), "+v"(fq));
#pragma unroll
        for (int bj = 0; bj < 2; ++bj) {
            const int c0 = u.pn * 256 + bj * 128 + wc * 32 + 8 * fq;
            const f32x4 b0 = *(const f32x4*)(bglu + c0), b1 = *(const f32x4*)(bglu + c0 + 4);
            EPI_ROWS_BEGIN {
                const int t = u.pm * 256 + rt; f32x4 y0, y1; unpack8(*(const u32x4*)(YS + (size_t)t * 512 + c0), y0, y1);
                f32x4 z0 = acc[ai][bj][m][0] + b0, z1 = acc[ai][bj][m][1] + b1;
#pragma unroll
                for (int j = 0; j < 4; ++j) { z0[j] = y0[j] * sigmoidf_(z0[j]); z1[j] = y1[j] * sigmoidf_(z1[j]); }
                *(u32x4*)(OS + (size_t)t * 512 + c0) = pack8(z0, z1);
            } EPI_ROWS_END
        }
    }
};
template <int MODE  > struct EpiPre {
    static constexpr bool PERM = false, AFTER_DRAIN = false;
    const float* resf; const bf16* resb; float* PRE;
    __device__ __forceinline__ void operator()(AccT& acc, const pg8::Unit& u, int wr, int wc, int fr, int fq) const { asm volatile("" : "+v"(fr), "+v"(fq));
        const int cb = (u.pn & 3) * 256 + wc * 32 + 4 * fq;
        EPI_ROWS_BEGIN {
            const size_t ro = (size_t)(u.pm * 256 + rt) * DM + cb;
#pragma unroll
            for (int bj = 0; bj < 2; ++bj)
#pragma unroll
                for (int n = 0; n < 2; ++n) { const size_t o = ro + bj * 128 + n * 16; f32x4 r;
                    if (MODE == 0) r = *(const f32x4*)(resf + o);
                    else { const u32x2 w = *(const u32x2*)(resb + o); r = (f32x4){bflo(w.x), bfhi(w.x), bflo(w.y), bfhi(w.y)}; }
                    *(f32x4*)(PRE + o) = r * ALPHA + acc[ai][bj][m][n]; }
        } EPI_ROWS_END
    }
};
struct EpiXS {
    static constexpr bool PERM = true, AFTER_DRAIN = false;
    bf16* P; LAS unsigned char* lds;
    __device__ __forceinline__ void operator()(AccT& acc, const pg8::Unit& u, int wr, int wc, int fr, int fq) const { asm volatile("" : "+v"(fr), "+v"(fq));
        LAS float* exm = (LAS float*)(lds + EXCH_OFF); LAS float* exs = exm + 1024;
        EPI_ROWS_BEGIN {
            float mx = -3.0e38f;
#pragma unroll
            for (int bj = 0; bj < 2; ++bj)
#pragma unroll
                for (int n = 0; n < 2; ++n) { const f32x4 x = acc[ai][bj][m][n]; mx = fmaxf(mx, fmaxf(fmaxf(x[0], x[1]), fmaxf(x[2], x[3]))); }
            mx = fmaxf(mx, __shfl_xor(mx, 16)); mx = fmaxf(mx, __shfl_xor(mx, 32));
            if (fq == 0) exm[rt * 4 + wc] = mx;
        } EPI_ROWS_END
        asm volatile("s_waitcnt lgkmcnt(0)" ::: "memory"); __builtin_amdgcn_s_barrier(); asm volatile("" ::: "memory");
        EPI_ROWS_BEGIN {
            const f32x4 mm = *(const LAS f32x4*)(exm + rt * 4); const float M = fmaxf(fmaxf(mm[0], mm[1]), fmaxf(mm[2], mm[3])); float s = 0.f;
#pragma unroll
            for (int bj = 0; bj < 2; ++bj)
#pragma unroll
                for (int n = 0; n < 2; ++n) { f32x4 x = acc[ai][bj][m][n];
#pragma unroll
                    for (int j = 0; j < 4; ++j) { x[j] = __builtin_amdgcn_exp2f(x[j] - M); s += x[j]; }
                    acc[ai][bj][m][n] = x; }
            s += __shfl_xor(s, 16); s += __shfl_xor(s, 32);
            if (fq == 0) exs[rt * 4 + wc] = s;
        } EPI_ROWS_END
        asm volatile("s_waitcnt lgkmcnt(0)" ::: "memory"); __builtin_amdgcn_s_barrier(); asm volatile("" ::: "memory");
        const int cb = (u.pn & 3) * 256 + wc * 32 + 8 * fq;
        EPI_ROWS_BEGIN {
            const f32x4 ss = *(const LAS f32x4*)(exs + rt * 4); const float inv = __builtin_amdgcn_rcpf((ss[0] + ss[1]) + (ss[2] + ss[3]));
            bf16* rowp = P + (size_t)(u.pm * 256 + rt) * DM + cb;
#pragma unroll
            for (int bj = 0; bj < 2; ++bj) *(u32x4*)(rowp + bj * 128) = pack8(acc[ai][bj][m][0] * inv, acc[ai][bj][m][1] * inv);
        } EPI_ROWS_END
    }
};
struct EpiSC {
    static constexpr bool PERM = false, AFTER_DRAIN = false;
    float* SCLO; float* SCHI;
    __device__ __forceinline__ void operator()(AccT& acc, const pg8::Unit& u, int wr, int wc, int fr, int fq) const { asm volatile("" : "+v"(fr), "+v"(fq));
        float* base = (u.pn < 4 ? SCLO : SCHI) + (u.pn & 3) * 256 + wc * 32 + 4 * fq;
        EPI_ROWS_BEGIN {
            float* rowp = base + (size_t)(u.pm * 256 + rt) * 1024;
#pragma unroll
            for (int bj = 0; bj < 2; ++bj)
#pragma unroll
                for (int n = 0; n < 2; ++n) *(f32x4*)(rowp + bj * 128 + n * 16) = acc[ai][bj][m][n];
        } EPI_ROWS_END
    }
};
struct EpiK2V2 {
    static constexpr bool PERM = true, AFTER_DRAIN = false;
    bf16* O;
    __device__ __forceinline__ void operator()(AccT& acc, const pg8::Unit& u, int wr, int wc, int fr, int fq) const { asm volatile("" : "+v"(fr), "+v"(fq));
        const int b = u.pm, kv = u.pn >> 2, h = u.pn & 3;
        EPI_ROWS_BEGIN {
            bf16* rowp = O + ((size_t)(((kv * 2 + b) * 4 + h) * 256 + rt)) * 256 + wc * 32 + 8 * fq;
#pragma unroll
            for (int bj = 0; bj < 2; ++bj) *(u32x4*)(rowp + bj * 128) = pack8(acc[ai][bj][m][0], acc[ai][bj][m][1]);
        } EPI_ROWS_END
    }
};
struct EpiMb {
    static constexpr bool PERM = true, AFTER_DRAIN = false;
    bf16* O;
    __device__ __forceinline__ void operator()(AccT& acc, const pg8::Unit& u, int wr, int wc, int fr, int fq) const { asm volatile("" : "+v"(fr), "+v"(fq));
        const int b = u.pm >> 2, h = u.pm & 3, kt = u.pn & 3;
        EPI_ROWS_BEGIN {
            bf16* rowp = O + ((size_t)(b * 1024 + h * 256 + rt)) * 1024 + kt * 256 + wc * 32 + 8 * fq;
#pragma unroll
            for (int bj = 0; bj < 2; ++bj) *(u32x4*)(rowp + bj * 128) = pack8(acc[ai][bj][m][0] * XSC, acc[ai][bj][m][1] * XSC);
        } EPI_ROWS_END
    }
};
struct EpiVOT {
    static constexpr bool PERM = true, AFTER_DRAIN = false;
    bf16* O;
    __device__ __forceinline__ void operator()(AccT& acc, const pg8::Unit& u, int wr, int wc, int fr, int fq) const { asm volatile("" : "+v"(fr), "+v"(fq));
        const int h = u.pm >> 2, ct = u.pm & 3, b = u.pn >> 2;
        EPI_ROWS_BEGIN {
            bf16* rowp = O + ((size_t)(b * 1024 + ct * 256 + rt)) * 1024 + h * 256 + wc * 32 + 8 * fq;
#pragma unroll
            for (int bj = 0; bj < 2; ++bj) *(u32x4*)(rowp + bj * 128) = pack8(acc[ai][bj][m][0], acc[ai][bj][m][1]);
        } EPI_ROWS_END
    }
};
struct EpiWsc {
    static constexpr bool PERM = true, AFTER_DRAIN = false;
    bf16* O;
    __device__ __forceinline__ void operator()(AccT& acc, const pg8::Unit& u, int wr, int wc, int fr, int fq) const { asm volatile("" : "+v"(fr), "+v"(fq));
        const int hh = u.pn >> 2, kt = u.pn & 3;
#pragma unroll
        for (int m = 0; m < 4; ++m) { const int key = wr * 64 + m * 16 + fr;
            bf16* rowp = O + ((size_t)(hh * 128 + key)) * 1024 + kt * 256 + wc * 32 + 8 * fq;
#pragma unroll
            for (int bj = 0; bj < 2; ++bj) *(u32x4*)(rowp + bj * 128) = pack8(acc[0][bj][m][0], acc[0][bj][m][1]); }
    }
};
}
namespace att {
typedef unsigned short bf16;
typedef short bf16x8 __attribute__((ext_vector_type(8)));
typedef short s16x4 __attribute__((ext_vector_type(4)));
typedef float f32x16 __attribute__((ext_vector_type(16)));
typedef float f32x4 __attribute__((ext_vector_type(4)));
typedef unsigned u32x4 __attribute__((ext_vector_type(4)));
constexpr int DQ = 96, DV = 64, NW = 8, QBLK = 32, KVBLK = 64, QB = NW * QBLK, SEQ = 8192, OPITCH = 512;
constexpr int SHM_V = 16384, SHM_K = 16384;
constexpr int LDS_BYTES = 2 * SHM_V + 2 * SHM_K + NW * 64 * 4;
constexpr float THR = 8.f;
constexpr unsigned WBIG = 0x7fffffffu;

#define KSWZ(row, colB) ((row) * 256 + ((colB) ^ (((row) & 7) << 4)))
#define SBAR() __builtin_amdgcn_sched_barrier(0)
__device__ __forceinline__ int v_st(int k, int c) { const int kk = (k & ~0xC) | ((k & 4) << 1) | ((k & 8) >> 1); return ((kk >> 3) * 4 + (c >> 5)) * 512 + ((kk & 7) * 32 + (c & 31)) * 2; }
__device__ __forceinline__ int v_rd_base(int lane) { return ((lane & 3) << 3) | (((lane >> 2) & 3) << 6) | (((lane >> 4) & 1) << 5) | (((lane >> 5) & 1) << 8); }
constexpr int v_rd_off(int d0, int ks, int half) { return d0 * 512 + ks * 4096 + half * 2048; }
__device__ __forceinline__ int crow(int r, int hi) { return (r & 3) + 8 * (r >> 2) + 4 * hi; }
__device__ __forceinline__ unsigned cvtpk(float lo, float hi) { unsigned r; asm volatile("v_cvt_pk_bf16_f32 %0, %1, %2" : "=v"(r) : "v"(lo), "v"(hi)); return r; }

__device__ __forceinline__ void mask_tile(f32x16& p0, f32x16& p1, int dq, unsigned W) {
    const float NEG = -__builtin_inff();
#pragma unroll
    for (int r = 0; r < 16; ++r) {
        const int c = (r & 3) + 8 * (r >> 2);
        if ((unsigned)(dq - c) >= W) p0[r] = NEG;
        if ((unsigned)(dq - c - 32) >= W) p1[r] = NEG;
    }
}
__device__ __forceinline__ void partialSM(f32x16& p0, f32x16& p1, float& m_reg, float& mn, float& alpha) {
    float pmax = p0[0];
#pragma unroll
    for (int r = 1; r < 16; ++r) pmax = fmaxf(pmax, p0[r]);
#pragma unroll
    for (int r = 0; r < 16; ++r) pmax = fmaxf(pmax, p1[r]);
    { auto rr = __builtin_amdgcn_permlane32_swap(__float_as_uint(pmax), __float_as_uint(pmax), false, false);
      pmax = fmaxf(__uint_as_float(rr[0]), __uint_as_float(rr[1])); }
    if (__builtin_expect(__all((pmax - m_reg) <= THR), 1)) { mn = m_reg; alpha = 1.f; }
    else { mn = fmaxf(m_reg, pmax); alpha = __builtin_amdgcn_exp2f(m_reg - mn); m_reg = mn; }
#pragma unroll
    for (int r = 0; r < 16; ++r) p0[r] = p0[r] - mn;
#pragma unroll
    for (int r = 0; r < 16; ++r) p1[r] = p1[r] - mn;
#pragma unroll
    for (int r = 0; r < 16; ++r) p0[r] = __builtin_amdgcn_exp2f(p0[r]);
}
__device__ __forceinline__ void finishSM(f32x16& p0, f32x16& p1, float alpha, float& l_reg, bf16x8& pa0, bf16x8& pa1, bf16x8& pa2, bf16x8& pa3) {
#pragma unroll
    for (int r = 0; r < 16; ++r) p1[r] = __builtin_amdgcn_exp2f(p1[r]);
    float ps = 0;
#pragma unroll
    for (int r = 0; r < 16; ++r) ps += p0[r];
#pragma unroll
    for (int r = 0; r < 16; ++r) ps += p1[r];
    { auto rr = __builtin_amdgcn_permlane32_swap(__float_as_uint(ps), __float_as_uint(ps), false, false);
      ps = __uint_as_float(rr[0]) + __uint_as_float(rr[1]); }
    l_reg = l_reg * alpha + ps;
#define PK4(P, B_, OUT) do { unsigned a0 = cvtpk(P[B_+0], P[B_+1]), a1 = cvtpk(P[B_+2], P[B_+3]);                          \
        unsigned b0 = cvtpk(P[B_+4], P[B_+5]), b1 = cvtpk(P[B_+6], P[B_+7]);                                             \
        auto r0 = __builtin_amdgcn_permlane32_swap(a0, b0, false, false); auto r1 = __builtin_amdgcn_permlane32_swap(a1, b1, false, false); \
        u32x4 w = {r0[0], r1[0], r0[1], r1[1]}; OUT = *reinterpret_cast<bf16x8*>(&w); } while (0)
    PK4(p0, 0, pa0); PK4(p0, 8, pa1); PK4(p1, 0, pa2); PK4(p1, 8, pa3);
#undef PK4
}
template <int KB>
__device__ __forceinline__ void qkt(f32x16& p0, f32x16& p1, const char* K_lds, int r32, int hi, const bf16x8* qr) {
    p0 = f32x16{}; p1 = f32x16{};
    const char* kb[4];
#pragma unroll
    for (int dd = 0; dd < 4; ++dd) kb[dd] = K_lds + KB * SHM_K + KSWZ(r32, (dd * 16 + hi * 8) * 2);
#pragma unroll
    for (int d0 = 0; d0 < 6; ++d0) { const char* a = kb[d0 & 3] + (d0 >> 2) * 128;
        bf16x8 b0 = *reinterpret_cast<const bf16x8*>(a);
        bf16x8 b1 = *reinterpret_cast<const bf16x8*>(a + 32 * 256);
        p0 = __builtin_amdgcn_mfma_f32_32x32x16_bf16(b0, qr[d0], p0, 0, 0, 0);
        p1 = __builtin_amdgcn_mfma_f32_32x32x16_bf16(b1, qr[d0], p1, 0, 0, 0); }
}
template <int VB>
__device__ __forceinline__ void pv_tile(f32x16* o, int vb0, bf16x8 pa0, bf16x8 pa1, bf16x8 pa2, bf16x8 pa3) {
#define TRRD(dst, off) asm volatile("ds_read_b64_tr_b16 %0, %1 offset:%2" : "=&v"(dst) : "v"(vb0), "i"(off) : "memory")
#define PV_D0(d0) do { s16x4 l0, l1, l2, l3, h0, h1, h2, h3; constexpr int b_ = VB * SHM_V + v_rd_off(d0, 0, 0); \
        TRRD(l0, b_); TRRD(h0, b_ + 2048); TRRD(l1, b_ + 4096); TRRD(h1, b_ + 6144); TRRD(l2, b_ + 8192); TRRD(h2, b_ + 10240); TRRD(l3, b_ + 12288); TRRD(h3, b_ + 14336); \
        asm volatile("s_waitcnt lgkmcnt(0)" ::: "memory"); SBAR(); \
        o[d0] = __builtin_amdgcn_mfma_f32_32x32x16_bf16(pa0, (bf16x8){l0[0], l0[1], l0[2], l0[3], h0[0], h0[1], h0[2], h0[3]}, o[d0], 0, 0, 0);   \
        o[d0] = __builtin_amdgcn_mfma_f32_32x32x16_bf16(pa1, (bf16x8){l1[0], l1[1], l1[2], l1[3], h1[0], h1[1], h1[2], h1[3]}, o[d0], 0, 0, 0);   \
        o[d0] = __builtin_amdgcn_mfma_f32_32x32x16_bf16(pa2, (bf16x8){l2[0], l2[1], l2[2], l2[3], h2[0], h2[1], h2[2], h2[3]}, o[d0], 0, 0, 0);   \
        o[d0] = __builtin_amdgcn_mfma_f32_32x32x16_bf16(pa3, (bf16x8){l3[0], l3[1], l3[2], l3[3], h3[0], h3[1], h3[2], h3[3]}, o[d0], 0, 0, 0); } while (0)
    PV_D0(0); PV_D0(1);
#undef PV_D0
#undef TRRD
}

struct BlockRef { const bf16* Q; const bf16* K; const bf16* V; bf16* O; int P0; };
struct Seam { bf16x8 qr[6]; bf16x8 st_v0, st_k0, st_k1; };
#define KROW(p, k0, rr) ((p) + (size_t)((k0) + (rr)) * DQ + scl)
#define VROW(p, k0) ((p) + (size_t)((k0) + vr) * DV + vc)
#define VMW() asm volatile("s_waitcnt vmcnt(0)" ::: "memory")
#define VMWN(n) asm volatile("s_waitcnt vmcnt(%0)" :: "i"(n) : "memory")
#define SLOAD_H(Kp, Vp, k0) do { S.st_v0 = *reinterpret_cast<const bf16x8*>(VROW(Vp, k0)); \
                         S.st_k0 = *reinterpret_cast<const bf16x8*>(KROW(Kp, k0, sr)); S.st_k1 = *reinterpret_cast<const bf16x8*>(KROW(Kp, k0, 32 + sr)); } while (0)
#define SWRITE_HK(bf) do { *(bf16x8*)(K_lds + (bf) * SHM_K + kws) = S.st_k0; *(bf16x8*)(K_lds + (bf) * SHM_K + kws + 32 * 256) = S.st_k1; } while (0)
#define SWRITE_HV(bf) do { *(bf16x8*)(V_lds + (bf) * SHM_V + vst0) = S.st_v0; } while (0)
#define SWRITE_H(bf) do { SWRITE_HV(bf); SWRITE_HK(bf); } while (0)
__device__ __forceinline__ void attn_prime(const BlockRef& cur, char* lds, Seam& S) {
    int tid_ = threadIdx.x; asm volatile("" : "+v"(tid_)); const int tid = tid_, wid = __builtin_amdgcn_readfirstlane(tid >> 6), lane = tid & 63, r32 = lane & 31, hi = lane >> 5;
    const int sr = tid >> 4, sc = (tid & 15) * 8, scl = sc < DQ ? sc : DQ - 8, kws = KSWZ(sr, sc * 2), vr = tid >> 3, vc = (tid & 7) * 8; char* K_lds = lds + 2 * SHM_V;
#pragma unroll
    for (int d0 = 0; d0 < 6; ++d0) S.qr[d0] = *reinterpret_cast<const bf16x8*>(cur.Q + (size_t)(wid * QBLK + r32) * DQ + d0 * 16 + hi * 8);
    SLOAD_H(cur.K, cur.V, 0); VMW(); SWRITE_HK(0);
    __syncthreads();
}
__device__ __forceinline__ void attn_block(const BlockRef& cur, const BlockRef& nxt, char* lds, Seam& S) {
    int tid_ = threadIdx.x; asm volatile("" : "+v"(tid_)); const int tid = tid_, wid = __builtin_amdgcn_readfirstlane(tid >> 6), lane = tid & 63, r32 = lane & 31, hi = lane >> 5;
    const int NT = (cur.P0 + QB - 1) / KVBLK + 1;
    const int qlo = cur.P0 + wid * QBLK, qm = qlo + r32 - 4 * hi;
    char* V_lds = lds; char* K_lds = lds + 2 * SHM_V;
    float* ws = (float*)(lds + 2 * SHM_V + 2 * SHM_K) + wid * 64; float* li_l = ws, * al_l = ws + 32;
    float m_reg = -1e30f, l_reg = 0; f32x16 o[2] = {};
    const int sr = tid >> 4, sc = (tid & 15) * 8, scl = sc < DQ ? sc : DQ - 8, kws = KSWZ(sr, sc * 2), vr = tid >> 3, vc = (tid & 7) * 8, vst0 = v_st(vr, vc);
    const int vb0 = (int)(uintptr_t)V_lds + v_rd_base(lane);
    const bf16* Kh = cur.K; const bf16* Vh = cur.V;
#define RESC(a) do { if (__any((a) < 1.f)) { if (hi == 0) al_l[r32] = (a); asm volatile("s_waitcnt lgkmcnt(0)" ::: "memory");              \
                     _Pragma("unroll") for (int d_ = 0; d_ < 2; ++d_) _Pragma("unroll") for (int r = 0; r < 16; ++r) o[d_][r] *= al_l[crow(r, hi)]; } } while (0)
#define KBASE(t) ((t) * KVBLK)
#define MASKT(P0_, P1_, t) do { const int kb_ = KBASE(t); if (kb_ + KVBLK - 1 > qlo) mask_tile(P0_, P1_, qm - kb_, WBIG); } while (0)
    constexpr int NQL = 6;
#define SEAM_K0() do { VMWN(NQL); SWRITE_HK(0); SBAR(); } while (0)
    f32x16 pA0, pA1, pB0, pB1; float mnA, mnB, alA, alB; bf16x8 pa0, pa1, pa2, pa3;
    SWRITE_HV(0); SBAR();
    SLOAD_H(Kh, Vh, KBASE(1));
    SBAR(); qkt<0>(pA0, pA1, K_lds, r32, hi, S.qr);
    MASKT(pA0, pA1, 0); partialSM(pA0, pA1, m_reg, mnA, alA);
    VMW(); SWRITE_H(1);
    __syncthreads();
#define HALF_STEP(PX0, PX1, mnX, alX, PY0, PY1, alY, t, KB, VB, SB) do {                                                      \
        SBAR(); qkt<KB>(PX0, PX1, K_lds, r32, hi, S.qr);                                                                      \
        finishSM(PY0, PY1, alY, l_reg, pa0, pa1, pa2, pa3); SBAR();                                                           \
        if ((t) + 1 < NT) { SLOAD_H(Kh, Vh, KBASE((t) + 1)); SBAR(); }                                                        \
        pv_tile<VB>(o, vb0, pa0, pa1, pa2, pa3); MASKT(PX0, PX1, (t)); partialSM(PX0, PX1, m_reg, mnX, alX);                  \
        __syncthreads();                                                                                                      \
        if ((t) + 1 < NT) { VMW(); SWRITE_H(SB); }                                                                            \
        RESC(alX); __syncthreads(); } while (0)
    for (int t = 1; t + 1 < NT; t += 2) {
        HALF_STEP(pB0, pB1, mnB, alB, pA0, pA1, alA, t, 1, 0, 0);
        HALF_STEP(pA0, pA1, mnA, alA, pB0, pB1, alB, t + 1, 0, 1, 1);
    }
    SBAR(); qkt<1>(pB0, pB1, K_lds, r32, hi, S.qr); SBAR();
    SLOAD_H(nxt.K, nxt.V, 0); SBAR();
#pragma unroll
    for (int d0 = 0; d0 < 6; ++d0) S.qr[d0] = *reinterpret_cast<const bf16x8*>(nxt.Q + (size_t)(wid * QBLK + r32) * DQ + d0 * 16 + hi * 8);
    SBAR();
    finishSM(pA0, pA1, alA, l_reg, pa0, pa1, pa2, pa3); SBAR();
    pv_tile<0>(o, vb0, pa0, pa1, pa2, pa3);
    MASKT(pB0, pB1, NT - 1); partialSM(pB0, pB1, m_reg, mnB, alB); __syncthreads(); RESC(alB);
    finishSM(pB0, pB1, alB, l_reg, pa0, pa1, pa2, pa3); SBAR(); pv_tile<1>(o, vb0, pa0, pa1, pa2, pa3);
    SBAR(); SEAM_K0();
    if (hi == 0) li_l[r32] = l_reg; asm volatile("s_waitcnt lgkmcnt(0)" ::: "memory");
    float rli[16];
#pragma unroll
    for (int r = 0; r < 16; ++r) rli[r] = __builtin_amdgcn_rcpf(li_l[crow(r, hi)]);
    bf16* Ow = cur.O + (size_t)(wid * QBLK) * OPITCH;
#pragma unroll
    for (int r = 0; r < 16; ++r) { const int orow = crow(r, hi);
#pragma unroll
        for (int d0 = 0; d0 < 2; ++d0) { const float v = o[d0][r] * rli[r]; const float vn = __shfl_xor(v, 1);
            if ((r32 & 1) == 0) *(unsigned*)(Ow + (size_t)orow * OPITCH + d0 * 32 + r32) = cvtpk(v, vn); } }
    __syncthreads();
#undef RESC
#undef KBASE
#undef MASKT
#undef SEAM_K0
#undef HALF_STEP
}
#undef KROW
#undef VROW
#undef VMW
#undef VMWN
#undef SLOAD_H
#undef SWRITE_HK
#undef SWRITE_HV
#undef SWRITE_H
#undef KSWZ
#undef SBAR
}
using namespace mk;
typedef __attribute__((address_space(1))) unsigned gu32;
#define RLX_AGENT __ATOMIC_RELAXED, __HIP_MEMORY_SCOPE_AGENT
#define LDS_WAIT() asm volatile("s_waitcnt lgkmcnt(0)" ::: "memory")
#define VM_WAIT() asm volatile("s_waitcnt vmcnt(0)" ::: "memory")
constexpr int NWAVES = 8, NPH = 16;

#define XB_TMO      128
#define XB_XCNT(j)  (256  + 64 * (j))
#define XB_XSUB(j)  (1280 + 64 * (j))
#define XB_XGEN(j)  (2304 + 64 * (j))
#define XB_TOP      3328
#define XB_TOPGEN   3392
#define XCD_BAR_WORDS 3456
#define XB_SPIN_CAP (1u << 18)

__device__ __forceinline__ unsigned xb_ld(unsigned* p)              { return __hip_atomic_load(p, __ATOMIC_RELAXED, __HIP_MEMORY_SCOPE_AGENT); }
__device__ __forceinline__ unsigned xb_add(unsigned* p, unsigned v) { return __hip_atomic_fetch_add(p, v, __ATOMIC_RELAXED, __HIP_MEMORY_SCOPE_AGENT); }
__device__ __forceinline__ unsigned xb_xcc_id() { return (unsigned)__builtin_amdgcn_s_getreg((3 << 11) | 20) & 0xFu; }
#define XB_SPIN(cond, bar) do { unsigned _sp = 0; while (cond) { __builtin_amdgcn_s_sleep(1); \
    if ((++_sp & 255u) == 0u) { if (xb_ld(&(bar)[XB_TMO])) break; if (_sp > XB_SPIN_CAP) { atomicAdd(&(bar)[XB_TMO], 1u); break; } } } } while (0)

struct XcdBarrier {
    unsigned* bar; unsigned x;
    volatile LAS unsigned* st;
};

__device__ __forceinline__ XcdBarrier xcd_barrier_post(unsigned* bar, volatile LAS unsigned* st) {
    XcdBarrier b; b.bar = bar; b.x = xb_xcc_id(); b.st = st;
    if (threadIdx.x == 0) (void)xb_add(&bar[XB_XCNT(b.x)], 1u);
    return b;
}
__device__ __forceinline__ void xcd_barrier_complete(unsigned* bar, unsigned x, unsigned& nloc, unsigned& nx) {
    const unsigned G = gridDim.x * gridDim.y * gridDim.z;
    unsigned sum, cnt, mine, sp = 0u;
    for (;;) {
        sum = 0u; cnt = 0u; mine = 0u;
#pragma unroll
        for (unsigned j = 0; j < 16; ++j) { const unsigned c = xb_ld(&bar[XB_XCNT(j)]); sum += c; cnt += (c > 0u) ? 1u : 0u; mine = (j == x) ? c : mine; }
        if (sum == G) break;
        __builtin_amdgcn_s_sleep(1);
        if ((++sp & 255u) == 0u) { if (xb_ld(&bar[XB_TMO])) break; if (sp > XB_SPIN_CAP) { atomicAdd(&bar[XB_TMO], 1u); break; } }
    }
    nloc = mine > 0u ? mine : 1u; nx = cnt > 0u ? cnt : 1u;
}

__device__ __forceinline__ void xcd_barrier(const XcdBarrier& b) {
    asm volatile("s_waitcnt vmcnt(0)" ::: "memory");
    __syncthreads();
    if (threadIdx.x == 0) {
        unsigned* bar = b.bar;
        __builtin_amdgcn_s_waitcnt(0);
        unsigned nloc = b.st[0], nx = b.st[1];
        if (nloc == 0u) { xcd_barrier_complete(bar, b.x, nloc, nx); b.st[0] = nloc; b.st[1] = nx; }
        const unsigned old = xb_add(&bar[XB_XSUB(b.x)], 1u);
        const unsigned gen = old / nloc;
        if (old + 1u == (gen + 1u) * nloc) {
            __builtin_amdgcn_fence(__ATOMIC_RELEASE, "agent");
            asm volatile("s_waitcnt vmcnt(0)" ::: "memory");
            const unsigned og = xb_add(&bar[XB_TOP], 1u);
            const unsigned tg = og / nx;
            if (og + 1u == (tg + 1u) * nx) xb_add(&bar[XB_TOPGEN], 1u);
            else XB_SPIN(xb_ld(&bar[XB_TOPGEN]) == tg, bar);
            __builtin_amdgcn_fence(__ATOMIC_ACQUIRE, "agent");
            xb_add(&bar[XB_XGEN(b.x)], 1u);
            asm volatile("s_waitcnt vmcnt(0)" ::: "memory");
        } else {
            XB_SPIN(xb_ld(&bar[XB_XGEN(b.x)]) == gen, bar);
            __builtin_amdgcn_fence(__ATOMIC_ACQUIRE, "agent");
            asm volatile("s_waitcnt vmcnt(0)" ::: "memory");
        }
    }
    __syncthreads();
}


struct Args { const void* in[36]; float* out; unsigned char* ws; int ph_lo, ph_hi; };
typedef const __attribute__((address_space(4))) Args* KArgs;
__device__ __forceinline__ KArgs kargs() { KArgs p = (KArgs)__builtin_amdgcn_kernarg_segment_ptr(); asm volatile("" : "+s"(p)); return p; }
struct Frame {
    LAS unsigned char* lds; unsigned char* ws; unsigned char* ob;
    unsigned* ctl; int tid, lane, wave, vcu, G, gw, ngw;
    __device__ __forceinline__ void refresh() { int t = threadIdx.x; asm volatile("" : "+v"(t)); tid = t; lane = t & 63; wave = __builtin_amdgcn_readfirstlane(t >> 6); gw = vcu * 8 + wave; }
};

__device__ __forceinline__ float wave_sum(float v) {
#pragma unroll
    for (int o = 1; o < 64; o <<= 1) v += __shfl_xor(v, o);
    return v;
}
__device__ __forceinline__ unsigned pk2(float lo, float hi) { return cvtpk(lo, hi); }

__device__ __forceinline__ int ropeperm(int n) { const int b = n >> 3, j = n & 7; return j < 4 ? 4 * b + j : 16 + 4 * b + (j - 4); }
__device__ __forceinline__ void tr_item(const float* W, int ldw, int k0, int scol0, bf16* WT, int ldt, int drow0, const float* kscale, bool perm, LAS float* scr, int lane) {
#pragma unroll 8
    for (int i = 0; i < 32; ++i) { const int kk = 2 * i + (lane >> 5); const float sc = kscale ? kscale[k0 + kk] : 1.0f;
        scr[kk * 33 + (lane & 31)] = W[(size_t)(k0 + kk) * ldw + scol0 + (lane & 31)] * sc; }
    LDS_WAIT(); asm volatile("" ::: "memory");
    const int c = lane & 7;
#pragma unroll
    for (int j = 0; j < 4; ++j) { const int n = (lane >> 3) + 8 * j, ns = perm ? ropeperm(n) : n; const LAS float* s = scr + (8 * c) * 33 + ns;
        u32x4 o; o.x = pk2(s[0 * 33], s[1 * 33]); o.y = pk2(s[2 * 33], s[3 * 33]); o.z = pk2(s[4 * 33], s[5 * 33]); o.w = pk2(s[6 * 33], s[7 * 33]);
        *(u32x4*)(WT + (size_t)(drow0 + n) * ldt + k0 + 8 * c) = o; }
    LDS_WAIT(); asm volatile("" ::: "memory");
}
__device__ __forceinline__ void ssm_precompute(const Frame& F, KArgs A, int g) {
    const float* lam_re = (const float*)A->in[8] + g * 64; const float* lam_im = (const float*)A->in[9] + g * 64; const float dt = expf(((const float*)A->in[10])[g]);
    const float* b_re = (const float*)A->in[11] + g * 1024; const float* b_im = (const float*)A->in[12] + g * 1024;
    const float* c_re = (const float*)A->in[13] + g * 1024; const float* c_im = (const float*)A->in[14] + g * 1024;
    const float* dsk = (const float*)A->in[15] + g * 16;
    LAS float* apr = (LAS float*)F.lds; LAS float* api = apr + 33 * 64; LAS float* bbr = api + 33 * 64; LAS float* bbi = bbr + 1024;
    LAS float* crs = bbi + 1024; LAS float* cis = crs + 1024; LAS float* Kt = cis + 1024;
    const int tid = F.tid;
    for (int e = tid; e < 33 * 64; e += 512) { const int m = e >> 6, p = e & 63; const float lr = lam_re[p], li = lam_im[p];
        const float mag = expf(lr * dt * (float)m); float sn, cs; sincosf(li * dt * (float)m, &sn, &cs); apr[e] = mag * cs; api[e] = mag * sn; }
    for (int e = tid; e < 1024; e += 512) { crs[e] = c_re[e]; cis[e] = c_im[e]; }
    __syncthreads();
    for (int e = tid; e < 1024; e += 512) { const int p = e >> 4; const float lr = lam_re[p], li = lam_im[p], den = lr * lr + li * li;
        const float nr = apr[64 + p] - 1.0f, ni = api[64 + p]; const float fr_ = (nr * lr + ni * li) / den, fi_ = (ni * lr - nr * li) / den;
        const float br = b_re[e], bi = b_im[e]; bbr[e] = fr_ * br - fi_ * bi; bbi[e] = fr_ * bi + fi_ * br; }
    __syncthreads();
    for (int e = tid; e < 8192; e += 512) { const int m = e >> 8, h = (e >> 4) & 15, hp = e & 15; float s = 0.f;
        for (int p = 0; p < 64; ++p) { const float cr = crs[h * 64 + p], ci = cis[h * 64 + p], ar = apr[m * 64 + p], ai = api[m * 64 + p];
            const float er = cr * ar - ci * ai, ei = cr * ai + ci * ar; s += er * bbr[p * 16 + hp] - ei * bbi[p * 16 + hp]; }
        if (m == 0 && h == hp) s += dsk[h];
        Kt[e] = s; }
    __syncthreads();
    bf16* TH = (bf16*)(F.ws + W_TH) + (size_t)g * 512 * 640; bf16* GM = (bf16*)(F.ws + W_GM) + (size_t)g * 256 * 640;
    for (int e = tid; e < 512 * 64; e += 512) { const int n = e >> 6, cg = e & 63, i = n >> 4, h = n & 15, j = cg >> 1, h0 = (cg & 1) * 8; u32x4 o = {0u, 0u, 0u, 0u};
        if (j <= i) { const LAS float* k = Kt + (i - j) * 256 + h * 16 + h0; o.x = pk2(k[0], k[1]); o.y = pk2(k[2], k[3]); o.z = pk2(k[4], k[5]); o.w = pk2(k[6], k[7]); }
        *(u32x4*)(TH + (size_t)n * 640 + cg * 8) = o; }
    for (int e = tid; e < 512 * 16; e += 512) { const int n = e >> 4, cg = e & 15, i = n >> 4, h = n & 15; float v[8];
#pragma unroll
        for (int q = 0; q < 8; ++q) { const int sidx = cg * 8 + q, p = sidx & 63; const float cr = crs[h * 64 + p], ci = cis[h * 64 + p], ar = apr[(i + 1) * 64 + p], ai = api[(i + 1) * 64 + p];
            v[q] = sidx < 64 ? (cr * ar - ci * ai) : -(cr * ai + ci * ar); }
        u32x4 o; o.x = pk2(v[0], v[1]); o.y = pk2(v[2], v[3]); o.z = pk2(v[4], v[5]); o.w = pk2(v[6], v[7]);
        *(u32x4*)(TH + (size_t)n * 640 + 512 + cg * 8) = o; }
    for (int e = tid; e < 256 * 80; e += 512) { const int n = e / 80, cg = e - n * 80; u32x4 o = {0u, 0u, 0u, 0u};
        if (n < 128 && cg < 64) { const int p = n & 63, im = n >> 6, j = cg >> 1, h0 = (cg & 1) * 8; const float ar = apr[(31 - j) * 64 + p], ai = api[(31 - j) * 64 + p]; float v[8];
#pragma unroll
            for (int q = 0; q < 8; ++q) { const float br = bbr[p * 16 + h0 + q], bi = bbi[p * 16 + h0 + q]; v[q] = im ? (ar * bi + ai * br) : (ar * br - ai * bi); }
            o.x = pk2(v[0], v[1]); o.y = pk2(v[2], v[3]); o.z = pk2(v[4], v[5]); o.w = pk2(v[6], v[7]); }
        *(u32x4*)(GM + (size_t)n * 640 + cg * 8) = o; }
    __syncthreads();
}
__device__ __forceinline__ void cvt_row1024(const float* src, bf16* dst, int lane) {
#pragma unroll
    for (int j = 0; j < 4; ++j) { const f32x4 v = *(const f32x4*)(src + (j * 64 + lane) * 4); u32x2 o; o.x = pk2(v[0], v[1]); o.y = pk2(v[2], v[3]); *(u32x2*)(dst + (j * 64 + lane) * 4) = o; }
}
__device__ __forceinline__ void p0_prologue(const Frame& F, KArgs A) {
    for (int g = blockIdx.x; g < 32; g += F.G) ssm_precompute(F, A, g);
    LAS float* scr = (LAS float*)(F.lds + F.wave * 16384);
    const int lane = F.lane;
    const float* x = (const float*)A->in[0]; const float* mem = (const float*)A->in[1]; const int* pos = (const int*)A->in[2];
    const float* w_in = (const float*)A->in[3]; const float* g_cq = (const float*)A->in[4]; const float* w_uq = (const float*)A->in[5]; const float* g_ckv = (const float*)A->in[6];
    const float* w_ukv = (const float*)A->in[7]; const float* w_glu = (const float*)A->in[16]; const float* g_mla = (const float*)A->in[18]; const float* g_ssm = (const float*)A->in[19];
    const float* w_out = (const float*)A->in[20]; const float* xq = (const float*)A->in[23]; const float* xk = (const float*)A->in[24]; const float* xv = (const float*)A->in[25];
    const float* xo = (const float*)A->in[26]; const float* w_query = (const float*)A->in[29]; const float* sk1 = (const float*)A->in[30]; const float* sk2 = (const float*)A->in[31];
    bf16* WINT = (bf16*)(F.ws + W_WINT); bf16* WUQT = (bf16*)(F.ws + W_WUQT); bf16* WUKVT = (bf16*)(F.ws + W_WUKVT); bf16* WGLUT = (bf16*)(F.ws + W_WGLUT); bf16* WOUTT = (bf16*)(F.ws + W_WOUTT);
    bf16* XKVT = (bf16*)(F.ws + W_XKVT); bf16* XQH = (bf16*)(F.ws + W_XQH); bf16* XOTH = (bf16*)(F.ws + W_XOTH); bf16* WQR = (bf16*)(F.ws + W_WQR); bf16* SKP = (bf16*)(F.ws + W_SKP);
    bf16* MEMB = (bf16*)(F.ws + W_MEMB); float2* ROPE = (float2*)(F.ws + W_ROPE); bf16* XB = (bf16*)(F.ob + O_XB); bf16* UP = (bf16*)(F.ws + A_UP);
    constexpr int I0 = 37 * 16, I1 = 24 * 6, I2 = 32 * 4, I3 = 16 * 8, I4 = 32 * 16, I5 = 32 * 16, I6 = 32 * 16, I7 = 4 * 32 * 4;
    constexpr int I8 = 16384, I9 = 512, I10 = 1024, I11 = 1024, I12 = 512, I13 = 4096, I14 = 4096, I15 = 96;
    constexpr int NIT = I0 + I1 + I2 + I3 + I4 + I5 + I6 + I7 + I8 + I9 + I10 + I11 + I12 + I13 + I14 + I15;
    for (int it = F.gw; it < NIT; it += F.ngw) {
        int r = it;
        if (r < I0) { const int nb = r >> 4, kb = r & 15; tr_item(w_in, 1184, kb * 64, nb * 32, WINT, 1024, nb * 32 + (nb >= 21 ? 96 : 0), nullptr, nb == 20, scr, lane); continue; } r -= I0;
        if (r < I1) { const int nb = r / 6, kb = r - nb * 6; tr_item(w_uq, 768, kb * 64, nb * 32, WUQT, 384, nb * 32, g_cq, (nb % 3) == 2, scr, lane); continue; } r -= I1;
        if (r < I2) { const int nb = r >> 2, kb = r & 3; tr_item(w_ukv, 1024, kb * 64, nb * 32, WUKVT, 256, nb * 32, g_ckv, false, scr, lane); continue; } r -= I2;
        if (r < I3) { const int nb = r >> 3, kb = r & 7; tr_item(w_glu, 512, kb * 64, nb * 32, WGLUT, 512, nb * 32, nullptr, false, scr, lane); continue; } r -= I3;
        if (r < I4) { const int nb = r >> 4, kb = r & 15; tr_item(w_out, 1024, kb * 64, nb * 32, WOUTT, 1024, nb * 32, kb < 8 ? g_mla : g_ssm - 512, false, scr, lane); continue; } r -= I4;
        if (r < I5) { const int nb = r >> 4, kb = r & 15; tr_item(xk, 1024, kb * 64, nb * 32, XKVT, 1024, nb * 32, nullptr, false, scr, lane); continue; } r -= I5;
        if (r < I6) { const int nb = r >> 4, kb = r & 15; tr_item(xv, 1024, kb * 64, nb * 32, XKVT, 1024, 1024 + nb * 32, nullptr, false, scr, lane); continue; } r -= I6;
        if (r < I7) { const int h = r >> 7, nb = (r >> 2) & 31, kb = r & 3; tr_item(xo + (size_t)h * 256 * 1024, 1024, kb * 64, nb * 32, XOTH + (size_t)h * 1024 * 256, 256, nb * 32, nullptr, false, scr, lane); continue; } r -= I7;
        if (r < I8) { cvt_row1024(x + (size_t)r * 1024, XB + (size_t)r * 1024, lane); continue; } r -= I8;
        if (r < I9) { cvt_row1024(mem + (size_t)r * 1024, MEMB + (size_t)r * 1024, lane); continue; } r -= I9;
        if (r < I10) {
#pragma unroll
            for (int j = 0; j < 4; ++j) { const int e = (j * 64 + lane) * 4, h = e >> 8, jj = e & 255; const f32x4 v = *(const f32x4*)(xq + (size_t)r * 1024 + e);
                u32x2 o; o.x = pk2(v[0], v[1]); o.y = pk2(v[2], v[3]); *(u32x2*)(XQH + ((size_t)h * 1024 + r) * 256 + jj) = o; }
            continue; } r -= I10;
        if (r < I11) {
#pragma unroll
            for (int j = 0; j < 8; ++j) { const int e = (j * 64 + lane) * 4, hh = e >> 7, d = e & 127; const f32x4 v = *(const f32x4*)(w_query + (size_t)r * 2048 + e);
                u32x2 o; o.x = pk2(v[0], v[1]); o.y = pk2(v[2], v[3]); bf16* dp = WQR + ((size_t)hh * 1024 + r) * 256 + d; *(u32x2*)dp = o; *(u32x2*)(dp + 128) = (u32x2){0u, 0u}; }
            continue; } r -= I11;
        if (r < I12) { const int half = r >> 8, key = r & 255, d = lane * 4; u32x2 o = {0u, 0u};
            if (key < 128 && d < 128) { const f32x4 v = *(const f32x4*)((half ? sk2 : sk1) + key * 128 + d); o.x = pk2(v[0], v[1]); o.y = pk2(v[2], v[3]); }
            *(u32x2*)(SKP + ((size_t)half * 256 + key) * 256 + d) = o; continue; } r -= I12;
        if (r < I13) { const int t = r * 4 + (lane >> 4), i = lane & 15; const float fq_ = exp2f(-(float)i * (13.287712379549449f / 16.0f));
            const float ang = (float)pos[t] * fq_; float sn, cs; sincosf(ang, &sn, &cs); ROPE[(size_t)t * 16 + i] = make_float2(cs, sn); continue; } r -= I13;
        if (r < I14) { const int row = r * 4 + (lane >> 4); *(u32x4*)(UP + (size_t)row * 640 + 512 + (lane & 15) * 8) = (u32x4){0u, 0u, 0u, 0u}; continue; } r -= I14;
        { const int row = 672 + r; *(u32x4*)(WINT + (size_t)row * 1024 + lane * 16) = (u32x4){0u, 0u, 0u, 0u}; *(u32x4*)(WINT + (size_t)row * 1024 + lane * 16 + 8) = (u32x4){0u, 0u, 0u, 0u}; }
    }
}
__device__ __forceinline__ void p3_scan(const Frame& F, KArgs A) {
    if (F.wave != 0) return;
    for (int task = blockIdx.x; task < 64; task += F.G) {
        const int g = task >> 1, b = task & 1, p = F.lane;
        const float lr = ((const float*)A->in[8])[g * 64 + p], li = ((const float*)A->in[9])[g * 64 + p], dt = expf(((const float*)A->in[10])[g]);
        const float mag = expf(lr * dt * 32.f); float sn, cs; sincosf(li * dt * 32.f, &sn, &cs); const float ar = mag * cs, ai = mag * sn;
        const float* LS = (const float*)(F.ws + A_LS) + (size_t)(g * 512 + b * 256) * 128; bf16* UP = (bf16*)(F.ws + A_UP) + (size_t)(g * 512 + b * 256) * 640 + 512;
        float sr = 0.f, si = 0.f;
#pragma unroll 8
        for (int c = 0; c < 256; ++c) {
            UP[(size_t)c * 640 + p] = (bf16)(cvtpk(sr, 0.f) & 0xffffu); UP[(size_t)c * 640 + 64 + p] = (bf16)(cvtpk(si, 0.f) & 0xffffu);
            const float l0 = LS[c * 128 + p], l1 = LS[c * 128 + 64 + p];
            const float nr = ar * sr - ai * si + l0, ni = ar * si + ai * sr + l1; sr = nr; si = ni;
        }
    }
}
__device__ __forceinline__ void p6_rmsnorm(const Frame& F) {
    const bf16* OA = (const bf16*)(F.ws + A_OA); const bf16* OS = (const bf16*)(F.ob + O_OS); bf16* MIXN = (bf16*)(F.ws + A_MIXN);
    for (int t = F.gw; t < NTOK; t += F.ngw) {
        f32x4 a0, a1, s0, s1; unpack8(*(const u32x4*)(OA + (size_t)t * 512 + F.lane * 8), a0, a1); unpack8(*(const u32x4*)(OS + (size_t)t * 512 + F.lane * 8), s0, s1);
        float qa = 0.f, qs = 0.f;
#pragma unroll
        for (int j = 0; j < 4; ++j) { qa += a0[j] * a0[j] + a1[j] * a1[j]; qs += s0[j] * s0[j] + s1[j] * s1[j]; }
        const float ra = rsqrtf(wave_sum(qa) * (1.f / 512.f) + RMS_EPS), rs = rsqrtf(wave_sum(qs) * (1.f / 512.f) + RMS_EPS);
        *(u32x4*)(MIXN + (size_t)t * 1024 + F.lane * 8) = pack8(a0 * ra, a1 * ra); *(u32x4*)(MIXN + (size_t)t * 1024 + 512 + F.lane * 8) = pack8(s0 * rs, s1 * rs);
    }
}
__device__ __forceinline__ void ln_rows(const Frame& F, const float* PRE, const float* gam, const float* bet, bf16* X) {
    for (int t = F.gw; t < NTOK; t += F.ngw) {
        f32x4 v[4]; float s = 0.f;
#pragma unroll
        for (int j = 0; j < 4; ++j) { v[j] = *(const f32x4*)(PRE + (size_t)t * 1024 + (j * 64 + F.lane) * 4); s += (v[j][0] + v[j][1]) + (v[j][2] + v[j][3]); }
        const float mean = wave_sum(s) * (1.f / 1024.f); float q = 0.f;
#pragma unroll
        for (int j = 0; j < 4; ++j) { v[j] = v[j] - mean; q += (v[j][0] * v[j][0] + v[j][1] * v[j][1]) + (v[j][2] * v[j][2] + v[j][3] * v[j][3]); }
        const float rstd = rsqrtf(wave_sum(q) * (1.f / 1024.f) + LN_EPS);
#pragma unroll
        for (int j = 0; j < 4; ++j) { const int c = (j * 64 + F.lane) * 4; const f32x4 gg = *(const f32x4*)(gam + c), bb = *(const f32x4*)(bet + c); const f32x4 o = v[j] * rstd * gg + bb;
            u32x2 w; w.x = pk2(o[0], o[1]); w.y = pk2(o[2], o[3]); *(u32x2*)(X + (size_t)t * 1024 + c) = w; }
    }
}
constexpr float USCALE = 32.0f;
__device__ __forceinline__ unsigned pk4_fp8(f32x4 v) { int w = __builtin_amdgcn_cvt_pk_fp8_f32(v[0], v[1], 0, false); w = __builtin_amdgcn_cvt_pk_fp8_f32(v[2], v[3], w, true); return (unsigned)w; }
__device__ __forceinline__ void cvt_row1024_fp8(const float* src, unsigned char* dst, int lane, float sc) {
    const f32x4 a = *(const f32x4*)(src + 16 * lane) * sc, b = *(const f32x4*)(src + 16 * lane + 4) * sc, c = *(const f32x4*)(src + 16 * lane + 8) * sc, d = *(const f32x4*)(src + 16 * lane + 12) * sc;
    u32x4 o; o.x = pk4_fp8(a); o.y = pk4_fp8(b); o.z = pk4_fp8(c); o.w = pk4_fp8(d); *(u32x4*)(dst + 16 * lane) = o;
}
__device__ const unsigned char PAIRTAB[64] = {0x00,0x01,0x02,0x03,0x04,0x05,0x06,0x07,0x08,0x09,0x0a,0x0b,0x0c,0x0d,0x0e,0x0f,0x10,0x11,0x12,0x13,0x14,0x15,0x16,0x17,0x20,0x21,0x22,0x23,0x24,0x30,0x31,0x32,
    0x33,0x40,0x41,0x42,0x50,0x51,0x60,0x61,0x70,0x71,0x80,0x90,0xa0,0xb0,0xc0,0xd0,0xe0,0xf0,0xff,0xff,0xff,0xff,0xff,0xff,0xff,0xff,0xff,0xff,0xff,0xff,0xff,0xff};
__device__ __forceinline__ unsigned f2sort(float f) { const unsigned u = __float_as_uint(f); return u ^ ((u >> 31) ? 0xffffffffu : 0x80000000u); }
__device__ __forceinline__ float sort2f(unsigned k) { return __uint_as_float((k & 0x80000000u) ? (k ^ 0x80000000u) : ~k); }
__device__ __forceinline__ unsigned umax_(unsigned a, unsigned b) { return a > b ? a : b; }
template <int CTRL> __device__ __forceinline__ unsigned dpp_u(unsigned v) { return (unsigned)__builtin_amdgcn_update_dpp(0, (int)v, CTRL, 0xf, 0xf, true); }
__device__ __forceinline__ unsigned gmax16(unsigned v) { v = umax_(v, dpp_u<0x128>(v)); v = umax_(v, dpp_u<0x124>(v)); v = umax_(v, dpp_u<0x122>(v)); v = umax_(v, dpp_u<0x121>(v)); return v; }
__device__ __forceinline__ float gmaxf16(float v) { v = fmaxf(v, __uint_as_float(dpp_u<0x128>(__float_as_uint(v)))); v = fmaxf(v, __uint_as_float(dpp_u<0x124>(__float_as_uint(v)))); v = fmaxf(v, __uint_as_float(dpp_u<0x122>(__float_as_uint(v)))); v = fmaxf(v, __uint_as_float(dpp_u<0x121>(__float_as_uint(v)))); return v; }
__device__ __forceinline__ float gsumf16(float v) { v += __uint_as_float(dpp_u<0x128>(__float_as_uint(v))); v += __uint_as_float(dpp_u<0x124>(__float_as_uint(v))); v += __uint_as_float(dpp_u<0x122>(__float_as_uint(v))); v += __uint_as_float(dpp_u<0x121>(__float_as_uint(v))); return v; }
__device__ __forceinline__ void p13_topk(const Frame& F, KArgs A) {
    const float* u_tab = (const float*)A->in[32]; const float* v_tab = (const float*)A->in[33]; unsigned char* UT = F.ws + A_UT; unsigned char* VT = F.ws + A_VT;
    const float* SCLO = (const float*)F.ob; const float* SCHI = (const float*)(F.ws + A_SCHI); int* IDS = (int*)(F.ws + A_IDS); float* GATES = (float*)(F.ws + A_GATES);
    const int lane = F.lane, l = lane & 15, gbase = lane & 48;
    for (int w = F.gw; w < NTOK * 2; w += F.ngw) {
        if (w < 16384) cvt_row1024_fp8(u_tab + (size_t)w * 1024, UT + (size_t)w * 1024, lane, USCALE); else cvt_row1024_fp8(v_tab + (size_t)(w - 16384) * 1024, VT + (size_t)(w - 16384) * 1024, lane, 1.0f);
        const int t = w >> 1, h = (w & 1) * 4 + (lane >> 4);
        const float* src = (h < 4 ? SCLO : SCHI) + (size_t)t * 1024 + (h & 3) * 256;
        const f32x4 a0 = *(const f32x4*)(src + 4 * l), a1 = *(const f32x4*)(src + 64 + 4 * l), b0 = *(const f32x4*)(src + 128 + 4 * l), b1 = *(const f32x4*)(src + 192 + 4 * l);
        unsigned k1[8], k2[8];
#pragma unroll
        for (int e = 0; e < 4; ++e) { k1[e] = (f2sort(a0[e]) & ~127u) | (unsigned)(4 * l + e); k1[4 + e] = (f2sort(a1[e]) & ~127u) | (unsigned)(64 + 4 * l + e);
                                      k2[e] = (f2sort(b0[e]) & ~127u) | (unsigned)(4 * l + e); k2[4 + e] = (f2sort(b1[e]) & ~127u) | (unsigned)(64 + 4 * l + e); }
        unsigned r1 = 0u, r2 = 0u;
        for (int k = 0; k < 16; ++k) {
            unsigned m1 = umax_(umax_(umax_(k1[0], k1[1]), umax_(k1[2], k1[3])), umax_(umax_(k1[4], k1[5]), umax_(k1[6], k1[7])));
            unsigned m2 = umax_(umax_(umax_(k2[0], k2[1]), umax_(k2[2], k2[3])), umax_(umax_(k2[4], k2[5]), umax_(k2[6], k2[7])));
            m1 = gmax16(m1); m2 = gmax16(m2);
            if (l == k) { r1 = m1; r2 = m2; }
#pragma unroll
            for (int e = 0; e < 8; ++e) { if (k1[e] == m1) k1[e] = 0u; if (k2[e] == m2) k2[e] = 0u; }
        }
        unsigned ck[4];
#pragma unroll
        for (int s = 0; s < 4; ++s) { const unsigned pr = PAIRTAB[s * 16 + l]; const bool valid = pr != 0xffu; const int i = valid ? (int)(pr >> 4) : 0, j = valid ? (int)(pr & 15u) : 0;
            const unsigned ki = (unsigned)__shfl((int)r1, gbase + i), kj = (unsigned)__shfl((int)r2, gbase + j);
            const float sum = sort2f(ki & ~127u) + sort2f(kj & ~127u);
            ck[s] = valid ? ((f2sort(sum) & ~255u) | pr) : 0u; }
        unsigned res = 0u;
        for (int k = 0; k < 16; ++k) {
            unsigned m = gmax16(umax_(umax_(ck[0], ck[1]), umax_(ck[2], ck[3])));
            if (l == k) res = m;
#pragma unroll
            for (int s = 0; s < 4; ++s) if (ck[s] == m) ck[s] = 0u;
        }
        const int i = (int)((res >> 4) & 15u), j = (int)(res & 15u);
        const unsigned ki = (unsigned)__shfl((int)r1, gbase + i), kj = (unsigned)__shfl((int)r2, gbase + j);
        const float val = sort2f(ki & ~127u) + sort2f(kj & ~127u); const int id = (int)(ki & 127u) * 128 + (int)(kj & 127u);
        const float mx = gmaxf16(val); const float ex = __expf(val - mx); const float sm = gsumf16(ex);
        IDS[(size_t)t * 128 + h * 16 + l] = id; GATES[(size_t)t * 128 + h * 16 + l] = ex / sm;
    }
}
__device__ __forceinline__ void unpack16_fp8(u32x4 w, f32x4& a, f32x4& b, f32x4& c, f32x4& d) {
    const f32x2 a0 = __builtin_amdgcn_cvt_pk_f32_fp8((int)w.x, false), a1 = __builtin_amdgcn_cvt_pk_f32_fp8((int)w.x, true), b0 = __builtin_amdgcn_cvt_pk_f32_fp8((int)w.y, false), b1 = __builtin_amdgcn_cvt_pk_f32_fp8((int)w.y, true);
    const f32x2 c0 = __builtin_amdgcn_cvt_pk_f32_fp8((int)w.z, false), c1 = __builtin_amdgcn_cvt_pk_f32_fp8((int)w.z, true), d0 = __builtin_amdgcn_cvt_pk_f32_fp8((int)w.w, false), d1 = __builtin_amdgcn_cvt_pk_f32_fp8((int)w.w, true);
    a = (f32x4){a0.x, a0.y, a1.x, a1.y}; b = (f32x4){b0.x, b0.y, b1.x, b1.y}; c = (f32x4){c0.x, c0.y, c1.x, c1.y}; d = (f32x4){d0.x, d0.y, d1.x, d1.y};
}
__device__ __forceinline__ float hsum4(f32x4 v) { return (v[0] + v[1]) + (v[2] + v[3]); }
__device__ __forceinline__ void p15_gather(const Frame& F, KArgs A) {
    const bf16* X2 = (const bf16*)(F.ws + A_X2); const int* IDS = (const int*)(F.ws + A_IDS); const float* GATES = (const float*)(F.ws + A_GATES);
    const unsigned char* UT = F.ws + A_UT; const unsigned char* VT = F.ws + A_VT; const float* g3 = (const float*)A->in[34]; const float* b3 = (const float*)A->in[35];
    float* out = (float*)F.ob; const int lane = F.lane; const bool b5 = lane & 32, b4 = lane & 16, b3_ = lane & 8;
    const int srcl = ((lane >> 2) & 1) * 32 + ((lane >> 1) & 1) * 16 + (lane & 1) * 8;
    for (int t = F.gw; t < NTOK; t += F.ngw) {
        f32x4 x0, x1, x2, x3; unpack8(*(const u32x4*)(X2 + (size_t)t * 1024 + 16 * lane), x0, x1); unpack8(*(const u32x4*)(X2 + (size_t)t * 1024 + 16 * lane + 8), x2, x3);
        const int id0 = IDS[(size_t)t * 128 + lane], id1 = IDS[(size_t)t * 128 + 64 + lane]; const float g0 = GATES[(size_t)t * 128 + lane], g1 = GATES[(size_t)t * 128 + 64 + lane];
        float c0 = 0.f, c1 = 0.f;
        for (int bi = 0; bi < 16; ++bi) {
            const int idv = bi < 8 ? id0 : id1; float p[8];
#pragma unroll
            for (int r = 0; r < 8; ++r) { const int id = __builtin_amdgcn_readlane(idv, (bi & 7) * 8 + r);
                f32x4 u0, u1, u2, u3; unpack16_fp8(*(const u32x4*)(UT + (size_t)id * 1024 + 16 * lane), u0, u1, u2, u3);
                p[r] = hsum4(x0 * u0 + x1 * u1 + x2 * u2 + x3 * u3); }
            float q[4], s2[2];
#pragma unroll
            for (int r = 0; r < 4; ++r) { const float keep = b5 ? p[r + 4] : p[r], send = b5 ? p[r] : p[r + 4]; q[r] = keep + __shfl_xor(send, 32); }
#pragma unroll
            for (int r = 0; r < 2; ++r) { const float keep = b4 ? q[r + 2] : q[r], send = b4 ? q[r] : q[r + 2]; s2[r] = keep + __shfl_xor(send, 16); }
            float v; { const float keep = b3_ ? s2[1] : s2[0], send = b3_ ? s2[0] : s2[1]; v = keep + __shfl_xor(send, 8); }
            v += __shfl_xor(v, 4); v += __shfl_xor(v, 2); v += __shfl_xor(v, 1);
            const float tv = __shfl(v, srcl);
            if ((lane >> 3) == (bi & 7)) { if (bi < 8) c0 = tv; else c1 = tv; }
        }
        c0 = g0 * gelu_tanh(c0 * (1.0f / USCALE)); c1 = g1 * gelu_tanh(c1 * (1.0f / USCALE));
        f32x4 acc[4] = {};
        for (int bi = 0; bi < 16; ++bi) {
            const int idv = bi < 8 ? id0 : id1; const float cv = bi < 8 ? c0 : c1;
#pragma unroll
            for (int r = 0; r < 8; ++r) { const int kk = (bi & 7) * 8 + r; const int id = __builtin_amdgcn_readlane(idv, kk);
                const float s = __uint_as_float(__builtin_amdgcn_readlane(__float_as_uint(cv), kk));
                f32x4 v0, v1, v2, v3; unpack16_fp8(*(const u32x4*)(VT + (size_t)id * 1024 + 16 * lane), v0, v1, v2, v3);
                acc[0] += v0 * s; acc[1] += v1 * s; acc[2] += v2 * s; acc[3] += v3 * s; }
        }
        acc[0] += x0 * ALPHA; acc[1] += x1 * ALPHA; acc[2] += x2 * ALPHA; acc[3] += x3 * ALPHA;
        float s = 0.f;
#pragma unroll
        for (int j = 0; j < 4; ++j) s += hsum4(acc[j]);
        const float mean = wave_sum(s) * (1.f / 1024.f); float qv = 0.f;
#pragma unroll
        for (int j = 0; j < 4; ++j) { acc[j] = acc[j] - mean; qv += hsum4(acc[j] * acc[j]); }
        const float rstd = rsqrtf(wave_sum(qv) * (1.f / 1024.f) + LN_EPS);
#pragma unroll
        for (int j = 0; j < 4; ++j) { const int c = 16 * lane + 4 * j; const f32x4 gg = *(const f32x4*)(g3 + c), bb = *(const f32x4*)(b3 + c);
            *(f32x4*)(out + (size_t)t * 1024 + c) = acc[j] * rstd * gg + bb; }
    }
}

__global__ void __launch_bounds__(NWAVES * 64, 2) mk_fwd(Args args) {
    extern __shared__ __attribute__((aligned(16))) unsigned char lds[];
    Frame F;
    F.lds = (LAS unsigned char*)lds; F.ws = args.ws; F.ob = (unsigned char*)args.out; F.ctl = (unsigned*)(args.ws + WS_CTL);
    F.tid = threadIdx.x; F.lane = F.tid & 63; F.wave = __builtin_amdgcn_readfirstlane(F.tid >> 6);
    F.G = gridDim.x; { const int bx = blockIdx.x; F.vcu = (F.G % 8 == 0) ? (bx % 8) * (F.G / 8) + bx / 8 : bx; }
    F.gw = F.vcu * NWAVES + F.wave; F.ngw = F.G * NWAVES;
    volatile LAS unsigned* MISC = (volatile LAS unsigned*)(F.lds + MISC_OFF);
    if (F.tid < 32) MISC[F.tid] = 0u;
    __syncthreads();
    const int lo = args.ph_lo, hi = args.ph_hi;
    XcdBarrier bar; bar.bar = F.ctl + CW_BAR; bar.x = 0; bar.st = nullptr;
    if (hi - lo > 1) bar = xcd_barrier_post(F.ctl + CW_BAR, MISC + 8);
#define IN(k) (lo <= (k) && (k) < hi)
#define SEAM(k) do { if (IN(k) && IN((k) + 1)) xcd_barrier(bar); } while (0)
    const int bx = (int)blockIdx.x;

    if (IN(0)) { for (int rep = 0; rep < 1 + ((MK_REP >> 0) & 1); ++rep) { F.refresh(); p0_prologue(F, kargs()); } SEAM(0); }

    if (IN(1)) {
        { pg8::Gemm g{(const bf16*)(F.ob + O_XB), (const bf16*)(F.ws + W_WINT), NTOK, NINP, DM}; BigSched S; S.so.init(NTOK, NINP, F.G, bx); S.bt = 0;
          EpiWin E{(bf16*)(F.ws + A_CQ), (bf16*)(F.ws + A_CKV), (bf16*)(F.ws + A_KH), (bf16*)(F.ws + A_UP), (const float2*)(F.ws + W_ROPE), (float*)(F.ws + W_SSQ)};
          pg8::gemm_phase<EpiWin, BigSched, true, true>(F.lds, g, S, E); }
        { pg8::Gemm g{(const bf16*)(F.ws + W_MEMB), (const bf16*)(F.ws + W_XKVT), 512, 2048, DM}; ListSched<DecKV2> S{16, F.G, (bx + F.G - 64) % F.G, DecKV2{}};
          EpiK2V2 E{(bf16*)(F.ws + W_K2V2)};
          pg8::gemm_phase<EpiK2V2, ListSched<DecKV2>, true, true>(F.lds, g, S, E); }
        SEAM(1);
    }
    if (IN(2)) {
        { pg8::Gemm g{(const bf16*)(F.ws + A_CQ), (const bf16*)(F.ws + W_WUQT), NTOK, 768, QL}; BigSched S; S.so.init(NTOK, 768, F.G, bx); S.bt = 0;
          EpiQ E{(bf16*)(F.ws + A_QH), (const float2*)(F.ws + W_ROPE), (const float*)(F.ws + W_SSQ)};
          pg8::gemm_phase<EpiQ, BigSched, true, true>(F.lds, g, S, E); }
        { pg8::Gemm g{(const bf16*)(F.ws + A_UP), (const bf16*)(F.ws + W_GM), 16384, 8192, 640}; ListSched<DecLS> S{64, F.G, (bx + F.G - 192) % F.G, DecLS{}};
          EpiLS E{(float*)(F.ws + A_LS)};
          pg8::gemm_phase<EpiLS, ListSched<DecLS>, true, true>(F.lds, g, S, E); }
        { pg8::Gemm g{(const bf16*)(F.ws + A_CKV), (const bf16*)(F.ws + W_WUKVT), NTOK, 1024, KVL}; BigSched S; S.so.init(NTOK, 1024, F.G, bx); S.bt = 0;
          EpiKV E{(bf16*)(F.ws + A_KH), (bf16*)(F.ws + A_VH), (const float*)(F.ws + W_SSQ)};
          pg8::gemm_phase<EpiKV, BigSched, true, true>(F.lds, g, S, E); }
        { pg8::Gemm g{(const bf16*)(F.ws + W_K2V2), (const bf16*)(F.ws + W_XQH), 2048, 4096, 256}; ListSched<DecMb> S{32, F.G, bx, DecMb{}};
          EpiMb E{(bf16*)(F.ws + W_MB)};
          pg8::gemm_phase<EpiMb, ListSched<DecMb>, true, true>(F.lds, g, S, E); }
        { pg8::Gemm g{(const bf16*)(F.ws + W_XOTH), (const bf16*)(F.ws + W_K2V2) + (size_t)2 * 4 * 256 * 256, 4096, 2048, 256}; ListSched<DecVOT> S{32, F.G, (bx + F.G - 32) % F.G, DecVOT{}};
          EpiVOT E{(bf16*)(F.ws + W_VOT)};
          pg8::gemm_phase<EpiVOT, ListSched<DecVOT>, true, true>(F.lds, g, S, E); }
        { pg8::Gemm g{(const bf16*)(F.ws + W_SKP), (const bf16*)(F.ws + W_WQR), 512, 16384, 256}; ListSched<DecWsc> S{64, F.G, (bx + F.G - 64) % F.G, DecWsc{}};
          EpiWsc E{(bf16*)(F.ws + W_WSC)};
          pg8::gemm_phase<EpiWsc, ListSched<DecWsc>, true, true>(F.lds, g, S, E); }
        SEAM(2);
    }
    if (IN(3)) { F.refresh(); p3_scan(F, kargs()); SEAM(3); }
    if (IN(4)) {
        for (int rep = 0; rep < 1 + ((MK_REP >> 4) & 1); ++rep)
        for (int L = F.vcu; L < 256; L += F.G) {
            const int bh = L >> 4, xq_ = L & 15, q0 = xq_, q1 = 31 - xq_, b = bh >> 3, h = bh & 7;
            const att::bf16* Qb = (const att::bf16*)(F.ws + A_QH) + (size_t)bh * SEQ * 96; const att::bf16* Kb = (const att::bf16*)(F.ws + A_KH) + (size_t)bh * SEQ * 96;
            const att::bf16* Vb = (const att::bf16*)(F.ws + A_VH) + (size_t)bh * SEQ * 64; att::bf16* Ob = (att::bf16*)(F.ws + A_OA) + (size_t)b * SEQ * 512 + h * 64;
            const att::BlockRef r0{Qb + (size_t)q0 * 256 * 96, Kb, Vb, Ob + (size_t)q0 * 256 * 512, q0 * 256};
            const att::BlockRef r1{Qb + (size_t)q1 * 256 * 96, Kb, Vb, Ob + (size_t)q1 * 256 * 512, q1 * 256};
            att::Seam S;
            att::attn_prime(r0, (char*)lds, S);
            att::attn_block(r0, r1, (char*)lds, S);
            att::attn_block(r1, r1, (char*)lds, S);
        }
        { pg8::Gemm g{(const bf16*)(F.ws + A_UP), (const bf16*)(F.ws + W_TH), 16384, 16384, 640}; ListSched<DecY> S{128, F.G, bx, DecY{}};
          EpiY E{(bf16*)(F.ob + O_YS)};
          pg8::gemm_phase<EpiY, ListSched<DecY>, true, true>(F.lds, g, S, E); }
        SEAM(4);
    }
    if (IN(5)) {
        pg8::Gemm g{(const bf16*)(F.ob + O_YS), (const bf16*)(F.ws + W_WGLUT), NTOK, 512, 512}; BigSched S; S.so.init(NTOK, 512, F.G, bx); S.bt = 0;
        EpiGlu E{(const bf16*)(F.ob + O_YS), (bf16*)(F.ob + O_OS), (const float*)kargs()->in[17]};
        pg8::gemm_phase<EpiGlu, BigSched, true, true>(F.lds, g, S, E);
        SEAM(5);
    }
    if (IN(6)) { F.refresh(); p6_rmsnorm(F); SEAM(6); }
    if (IN(7)) {
        pg8::Gemm g{(const bf16*)(F.ws + A_MIXN), (const bf16*)(F.ws + W_WOUTT), NTOK, DM, DM}; BigSched S; S.so.init(NTOK, DM, F.G, bx); S.bt = 0;
        EpiPre<0> E{(const float*)kargs()->in[0], nullptr, (float*)F.ob};
        pg8::gemm_phase<EpiPre<0>, BigSched, true, true>(F.lds, g, S, E);
        SEAM(7);
    }
    if (IN(8)) { F.refresh(); ln_rows(F, (const float*)F.ob, (const float*)kargs()->in[21], (const float*)kargs()->in[22], (bf16*)(F.ws + A_X1)); SEAM(8); }
    if (IN(9)) {
        pg8::Gemm g{(const bf16*)(F.ws + A_X1), (const bf16*)(F.ws + W_MB), NTOK, DM, DM}; BigSched S; S.so.init(NTOK, DM, F.G, bx); S.bt = 4;
        EpiXS E{(bf16*)(F.ws + A_P), F.lds};
        pg8::gemm_phase<EpiXS, BigSched, true, true>(F.lds, g, S, E);
        SEAM(9);
    }
    if (IN(10)) {
        pg8::Gemm g{(const bf16*)(F.ws + A_P), (const bf16*)(F.ws + W_VOT), NTOK, DM, DM}; BigSched S; S.so.init(NTOK, DM, F.G, bx); S.bt = 4;
        EpiPre<1> E{nullptr, (const bf16*)(F.ws + A_X1), (float*)F.ob};
        pg8::gemm_phase<EpiPre<1>, BigSched, true, true>(F.lds, g, S, E);
        SEAM(10);
    }
    if (IN(11)) { F.refresh(); ln_rows(F, (const float*)F.ob, (const float*)kargs()->in[27], (const float*)kargs()->in[28], (bf16*)(F.ws + A_X2)); SEAM(11); }
    if (IN(12)) {
        pg8::Gemm g{(const bf16*)(F.ws + A_X2), (const bf16*)(F.ws + W_WSC), NTOK, 2048, DM}; BigSched S; S.so.init(NTOK, 2048, F.G, bx); S.bt = 0;
        EpiSC E{(float*)F.ob, (float*)(F.ws + A_SCHI)};
        pg8::gemm_phase<EpiSC, BigSched, true, true>(F.lds, g, S, E);
        SEAM(12);
    }
    if (IN(13)) { for (int rep = 0; rep < 1 + ((MK_REP >> 13) & 1); ++rep) { F.refresh(); p13_topk(F, kargs()); } if (IN(13) && IN(15)) xcd_barrier(bar); }
    if (IN(15)) { for (int rep = 0; rep < 1 + ((MK_REP >> 15) & 1); ++rep) { F.refresh(); p15_gather(F, kargs()); } }
#undef IN
#undef SEAM
}

#if MK_DBG
struct DArgs { const void* in[36]; float* out; unsigned char* ws; };
__device__ __forceinline__ unsigned hsh(unsigned x) { x ^= x >> 16; x *= 0x7feb352du; x ^= x >> 15; x *= 0x846ca68bu; x ^= x >> 16; return x; }
__device__ __forceinline__ float bf2f(bf16 v) { return __uint_as_float((unsigned)v << 16); }
__device__ __forceinline__ void dbg_report(unsigned char* ws, int code, bool bad) { if (bad) atomicMax((unsigned*)(ws + WS_CTL) + CW_DBG, (unsigned)(32 - code)); }
__device__ __forceinline__ bool far(float got, float ref, float scale) { return !(fabsf(got - ref) <= 0.03f * scale + 0.03f * fabsf(ref)); }
__device__ __forceinline__ int ropepos(int i, int second) { return (i >> 2) * 8 + (i & 3) + 4 * second; }

__global__ void chk1(DArgs a) {
    const int i = blockIdx.x * blockDim.x + threadIdx.x; const unsigned h0 = hsh(i * 2 + 1), h1 = hsh(i * 2 + 2);
    const int t = h0 % NTOK; int col = h1 % 1184; const float* x = (const float*)a.in[0]; const float* w = (const float*)a.in[3]; const int* pos = (const int*)a.in[2];
    const int b = t >> 13, tl = t & 8191;
    if (col >= 640 && col < 672) { const int ii = (col - 640) & 15; float x1 = 0.f, x2 = 0.f;
        for (int k = 0; k < 1024; ++k) { x1 += x[(size_t)t * 1024 + k] * w[(size_t)k * 1184 + 640 + ii]; x2 += x[(size_t)t * 1024 + k] * w[(size_t)k * 1184 + 656 + ii]; }
        const float ang = (float)pos[t] * powf(10000.f, -(float)ii / 16.f); const float c = cosf(ang), s = sinf(ang); const int hh = h1 % 8;
        const bf16* kr = (const bf16*)(a.ws + A_KH) + ((size_t)(b * 8 + hh) * SEQ + tl) * 96 + 64;
        dbg_report(a.ws, 1, far(bf2f(kr[ropepos(ii, 0)]), x1 * c - x2 * s, 1.f) || far(bf2f(kr[ropepos(ii, 1)]), x2 * c + x1 * s, 1.f)); return; }
    float r = 0.f; for (int k = 0; k < 1024; ++k) r += x[(size_t)t * 1024 + k] * w[(size_t)k * 1184 + col];
    float got;
    if (col < 384) got = bf2f(((const bf16*)(a.ws + A_CQ))[(size_t)t * 384 + col]);
    else if (col < 640) got = bf2f(((const bf16*)(a.ws + A_CKV))[(size_t)t * 256 + col - 384]);
    else { const int ch = col - 672, g = ch >> 4, hp = ch & 15; got = bf2f(((const bf16*)(a.ws + A_UP))[((size_t)(g * 512 + b * 256 + (tl >> 5)) * 640) + (tl & 31) * 16 + hp]); }
    dbg_report(a.ws, 1, far(got, r, 1.f));
}
__global__ void chk2(DArgs a) {
    const int i = blockIdx.x * blockDim.x + threadIdx.x; const unsigned h0 = hsh(i * 3 + 11), h1 = hsh(i * 3 + 12), h2 = hsh(i * 3 + 13);
    const int t = h0 % NTOK, h = h1 % 8, b = t >> 13, tl = t & 8191; const int* pos = (const int*)a.in[2];
    if (h2 & 1) {
        const bf16* cq = (const bf16*)(a.ws + A_CQ) + (size_t)t * 384; const float* g = (const float*)a.in[4]; const float* w = (const float*)a.in[5];
        float ss = 0.f; for (int k = 0; k < 384; ++k) ss += bf2f(cq[k]) * bf2f(cq[k]);
        const float rr = rsqrtf(ss / 384.f + 1e-6f); const int d = (h2 >> 1) % 96; const bf16* q = (const bf16*)(a.ws + A_QH) + ((size_t)(b * 8 + h) * SEQ + tl) * 96;
        if (d < 64) { float r = 0.f; for (int k = 0; k < 384; ++k) r += bf2f(cq[k]) * g[k] * w[(size_t)k * 768 + h * 96 + d]; dbg_report(a.ws, 2, far(bf2f(q[d]), r * rr * C2Q, 0.15f)); }
        else { const int ii = (d - 64) & 15; float x1 = 0.f, x2 = 0.f;
            for (int k = 0; k < 384; ++k) { const float v = bf2f(cq[k]) * g[k]; x1 += v * w[(size_t)k * 768 + h * 96 + 64 + ii]; x2 += v * w[(size_t)k * 768 + h * 96 + 80 + ii]; }
            x1 *= rr * C2Q; x2 *= rr * C2Q; const float ang = (float)pos[t] * powf(10000.f, -(float)ii / 16.f); const float c = cosf(ang), s = sinf(ang);
            dbg_report(a.ws, 2, far(bf2f(q[64 + ropepos(ii, 0)]), x1 * c - x2 * s, 0.15f) || far(bf2f(q[64 + ropepos(ii, 1)]), x2 * c + x1 * s, 0.15f)); }
    } else {
        const bf16* ck = (const bf16*)(a.ws + A_CKV) + (size_t)t * 256; const float* g = (const float*)a.in[6]; const float* w = (const float*)a.in[7];
        float ss = 0.f; for (int k = 0; k < 256; ++k) ss += bf2f(ck[k]) * bf2f(ck[k]);
        const float rr = rsqrtf(ss / 256.f + 1e-6f); const int j = (h2 >> 1) % 128; float r = 0.f;
        for (int k = 0; k < 256; ++k) r += bf2f(ck[k]) * g[k] * w[(size_t)k * 1024 + h * 128 + j];
        const float got = j < 64 ? bf2f(((const bf16*)(a.ws + A_KH))[((size_t)(b * 8 + h) * SEQ + tl) * 96 + j]) : bf2f(((const bf16*)(a.ws + A_VH))[((size_t)(b * 8 + h) * SEQ + tl) * 64 + j - 64]);
        dbg_report(a.ws, 2, far(got, r * rr, 1.f));
    }
}
__global__ void chk3(DArgs a) {
    const int i = blockIdx.x * (blockDim.x >> 6) + (threadIdx.x >> 6), lane = threadIdx.x & 63; const unsigned h0 = hsh(i * 3 + 21), h1 = hsh(i * 3 + 22), h2 = hsh(i * 3 + 23);
    int t = h0 % NTOK; if ((i & 3) == 0) t = (t & ~8191) + (h0 >> 16) % 300; const int h = h1 % 8, d = h2 % 64, b = t >> 13, tl = t & 8191;
    const bf16* q = (const bf16*)(a.ws + A_QH) + ((size_t)(b * 8 + h) * SEQ + tl) * 96; const bf16* K = (const bf16*)(a.ws + A_KH) + (size_t)(b * 8 + h) * SEQ * 96; const bf16* V = (const bf16*)(a.ws + A_VH) + (size_t)(b * 8 + h) * SEQ * 64;
    float mx = -1e30f;
    for (int k = lane; k <= tl; k += 64) { float s = 0.f; for (int e = 0; e < 96; ++e) s += bf2f(q[e]) * bf2f(K[(size_t)k * 96 + e]); mx = fmaxf(mx, s); }
    for (int o = 1; o < 64; o <<= 1) mx = fmaxf(mx, __shfl_xor(mx, o));
    float l = 0.f, acc = 0.f;
    for (int k = lane; k <= tl; k += 64) { float s = 0.f; for (int e = 0; e < 96; ++e) s += bf2f(q[e]) * bf2f(K[(size_t)k * 96 + e]); const float p = exp2f(s - mx); l += p; acc += p * bf2f(V[(size_t)k * 64 + d]); }
    l = wave_sum(l); acc = wave_sum(acc);
    const float got = bf2f(((const bf16*)(a.ws + A_OA))[(size_t)t * 512 + h * 64 + d]);
    if (lane == 0) dbg_report(a.ws, 3, far(got, acc / l, 0.05f));
}
__global__ void chk4(DArgs a) {
    const int i = blockIdx.x * (blockDim.x >> 6) + (threadIdx.x >> 6), p = threadIdx.x & 63; const unsigned h0 = hsh(i * 3 + 31), h1 = hsh(i * 3 + 32);
    const int b = h0 & 1, tl = (h0 >> 1) % 420, ch = h1 % 512, g = ch >> 4, h = ch & 15;
    const float lr = ((const float*)a.in[8])[g * 64 + p], li = ((const float*)a.in[9])[g * 64 + p], dt = expf(((const float*)a.in[10])[g]);
    const float mag = expf(lr * dt), ar = mag * cosf(li * dt), ai = mag * sinf(li * dt), den = lr * lr + li * li, nr = ar - 1.f, ni = ai;
    const float fr_ = (nr * lr + ni * li) / den, fi_ = (ni * lr - nr * li) / den;
    const float* bre = (const float*)a.in[11] + g * 1024 + p * 16; const float* bim = (const float*)a.in[12] + g * 1024 + p * 16;
    const bf16* UP = (const bf16*)(a.ws + A_UP);
    float sr = 0.f, si = 0.f, ulast = 0.f;
    for (int tau = 0; tau <= tl; ++tau) { const bf16* ur = UP + ((size_t)(g * 512 + b * 256 + (tau >> 5)) * 640) + (tau & 31) * 16; float br = 0.f, bi = 0.f;
        for (int hp = 0; hp < 16; ++hp) { const float uu = bf2f(ur[hp]); const float bbr = fr_ * bre[hp] - fi_ * bim[hp], bbi = fr_ * bim[hp] + fi_ * bre[hp]; br += bbr * uu; bi += bbi * uu; }
        const float n0 = ar * sr - ai * si + br, n1 = ar * si + ai * sr + bi; sr = n0; si = n1; ulast = bf2f(ur[h]); }
    const float cr = ((const float*)a.in[13])[g * 1024 + h * 64 + p], ci = ((const float*)a.in[14])[g * 1024 + h * 64 + p];
    float y = wave_sum(cr * sr - ci * si) + ((const float*)a.in[15])[g * 16 + h] * ulast;
    const float k0 = 0.7978845608f; y = 0.5f * y * (1.f + tanhf(k0 * (y + 0.044715f * y * y * y)));
    const float got = bf2f(((const bf16*)((unsigned char*)a.out + O_YS))[(size_t)(b * SEQ + tl) * 512 + ch]);
    if (p == 0) dbg_report(a.ws, 4, far(got, y, 0.3f));
}
__global__ void chk5(DArgs a) {
    const int i = blockIdx.x * blockDim.x + threadIdx.x; const unsigned h0 = hsh(i * 2 + 41), h1 = hsh(i * 2 + 42); const int t = h0 % NTOK, c = h1 % 512;
    const bf16* y = (const bf16*)((unsigned char*)a.out + O_YS) + (size_t)t * 512; const float* w = (const float*)a.in[16]; float z = ((const float*)a.in[17])[c];
    for (int k = 0; k < 512; ++k) z += bf2f(y[k]) * w[(size_t)k * 512 + c];
    const float r = bf2f(y[c]) / (1.f + expf(-z)); dbg_report(a.ws, 5, far(bf2f(((const bf16*)((unsigned char*)a.out + O_OS))[(size_t)t * 512 + c]), r, 0.3f));
}
__global__ void chk7(DArgs a) {
    const int i = blockIdx.x * blockDim.x + threadIdx.x; const unsigned h0 = hsh(i * 2 + 51), h1 = hsh(i * 2 + 52); const int t = h0 % NTOK, c = h1 % 1024;
    const bf16* oa = (const bf16*)(a.ws + A_OA) + (size_t)t * 512; const bf16* os = (const bf16*)((unsigned char*)a.out + O_OS) + (size_t)t * 512;
    const bf16* mx = (const bf16*)(a.ws + A_MIXN) + (size_t)t * 1024; const float* w = (const float*)a.in[20]; const float* ga = (const float*)a.in[18]; const float* gs = (const float*)a.in[19];
    float ss = 0.f; for (int k = 0; k < 512; ++k) ss += bf2f(oa[k]) * bf2f(oa[k]);
    const float ra = rsqrtf(ss / 512.f + 1e-6f); const int kk = h1 % 512; const bool badn = far(bf2f(mx[kk]), bf2f(oa[kk]) * ra, 1.f); (void)os;
    float r = 0.f; for (int k = 0; k < 1024; ++k) r += bf2f(mx[k]) * (k < 512 ? ga[k] : gs[k - 512]) * w[(size_t)k * 1024 + c];
    r += ALPHA * ((const float*)a.in[0])[(size_t)t * 1024 + c];
    dbg_report(a.ws, 6, badn || far(a.out[(size_t)t * 1024 + c], r, 1.f));
}
__global__ void chk8(DArgs a, int which) {
    const int i = blockIdx.x * blockDim.x + threadIdx.x; const unsigned h0 = hsh(i * 2 + 61), h1 = hsh(i * 2 + 62); const int t = h0 % NTOK, c = h1 % 1024; const float* pre = a.out + (size_t)t * 1024;
    float m = 0.f; for (int k = 0; k < 1024; ++k) m += pre[k]; m /= 1024.f; float v = 0.f; for (int k = 0; k < 1024; ++k) v += (pre[k] - m) * (pre[k] - m); v /= 1024.f;
    const float* g = (const float*)a.in[which ? 27 : 21]; const float* bb = (const float*)a.in[which ? 28 : 22]; const float r = (pre[c] - m) * rsqrtf(v + 1e-5f) * g[c] + bb[c];
    dbg_report(a.ws, 7, far(bf2f(((const bf16*)(a.ws + (which ? A_X2 : A_X1)))[(size_t)t * 1024 + c]), r, 1.f));
}
__global__ void chk_k2(DArgs a) {
    const int i = blockIdx.x * blockDim.x + threadIdx.x; const unsigned h0 = hsh(i * 2 + 71), h1 = hsh(i * 2 + 72); const int bm = h0 % 512, n = h1 % 1024, kv = (h1 >> 12) & 1;
    const float* mem = (const float*)a.in[1] + (size_t)bm * 1024; const float* w = (const float*)a.in[kv ? 25 : 24]; float r = 0.f; for (int k = 0; k < 1024; ++k) r += mem[k] * w[(size_t)k * 1024 + n];
    const int b = bm >> 8, m = bm & 255, h = n >> 8, j = n & 255;
    dbg_report(a.ws, 8, far(bf2f(((const bf16*)(a.ws + W_K2V2))[((size_t)(((kv * 2 + b) * 4 + h) * 256 + m)) * 256 + j]), r, 1.f));
}
__global__ void chk10(DArgs a) {
    __shared__ float q[1024], s[1024], o[1024]; __shared__ float red[4];
    const int i = blockIdx.x, tid = threadIdx.x; const unsigned h0 = hsh(i * 2 + 81), h1 = hsh(i * 2 + 82); const int t = h0 % NTOK, c = h1 % 1024, b = t >> 13;
    const bf16* x1 = (const bf16*)(a.ws + A_X1) + (size_t)t * 1024; const float* xq = (const float*)a.in[23]; const float* xo = (const float*)a.in[26];
    const bf16* K2 = (const bf16*)(a.ws + W_K2V2) + (size_t)(0 * 2 + b) * 4 * 256 * 256; const bf16* V2 = (const bf16*)(a.ws + W_K2V2) + (size_t)(1 * 2 + b) * 4 * 256 * 256;
    for (int n = tid; n < 1024; n += 256) { float r = 0.f; for (int k = 0; k < 1024; ++k) r += bf2f(x1[k]) * xq[(size_t)k * 1024 + n]; q[n] = r; }
    __syncthreads();
    for (int n = tid; n < 1024; n += 256) { const int h = n >> 8, m = n & 255; float r = 0.f; for (int j = 0; j < 256; ++j) r += q[h * 256 + j] * bf2f(K2[((size_t)h * 256 + m) * 256 + j]); s[n] = r * 0.0625f; }
    __syncthreads();
    if (tid < 4) { float mx = -1e30f; for (int m = 0; m < 256; ++m) mx = fmaxf(mx, s[tid * 256 + m]); float l = 0.f; for (int m = 0; m < 256; ++m) l += expf(s[tid * 256 + m] - mx); red[tid] = mx; __threadfence_block();
        for (int m = 0; m < 256; ++m) s[tid * 256 + m] = expf(s[tid * 256 + m] - mx) / l; }
    __syncthreads();
    for (int n = tid; n < 1024; n += 256) { const int h = n >> 8, j = n & 255; float r = 0.f; for (int m = 0; m < 256; ++m) r += s[h * 256 + m] * bf2f(V2[((size_t)h * 256 + m) * 256 + j]); o[n] = r; }
    __syncthreads();
    if (tid == 0) { float r = 0.f; for (int n = 0; n < 1024; ++n) r += o[n] * xo[(size_t)n * 1024 + c]; const float res = ALPHA * bf2f(x1[c]);
        dbg_report(a.ws, 9, far(a.out[(size_t)t * 1024 + c] - res, r, 0.06f)); }
}
__global__ void chk12(DArgs a) {
    const int i = blockIdx.x * blockDim.x + threadIdx.x; const unsigned h0 = hsh(i * 2 + 91), h1 = hsh(i * 2 + 92); const int t = h0 % NTOK, hh = h1 % 16, key = (h1 >> 8) % 128;
    const bf16* x2 = (const bf16*)(a.ws + A_X2) + (size_t)t * 1024; const float* wq = (const float*)a.in[29]; const float* sk = (const float*)a.in[(hh & 1) ? 31 : 30] + key * 128; float r = 0.f;
    for (int d = 0; d < 128; ++d) { float qd = 0.f; for (int k = 0; k < 1024; ++k) qd += bf2f(x2[k]) * wq[(size_t)k * 2048 + hh * 128 + d]; r += qd * sk[d]; }
    const int h = hh >> 1; const float* sc = (h < 4 ? a.out : (const float*)(a.ws + A_SCHI)) + (size_t)t * 1024 + (h & 3) * 256 + (hh & 1) * 128 + key;
    dbg_report(a.ws, 10, far(*sc, r, 1.f));
}
__global__ void chk13(DArgs a) {
    __shared__ float s1[128], s2[128]; __shared__ int cnt;
    const int i = blockIdx.x, tid = threadIdx.x; const unsigned h0 = hsh(i * 2 + 101), h1 = hsh(i * 2 + 102); const int t = h0 % NTOK, h = h1 % 8;
    const float* sc = (h < 4 ? a.out : (const float*)(a.ws + A_SCHI)) + (size_t)t * 1024 + (h & 3) * 256;
    s1[tid] = sc[tid]; s1[tid + 64] = sc[tid + 64]; s2[tid] = sc[128 + tid]; s2[tid + 64] = sc[192 + tid]; if (tid == 0) cnt = 0; __syncthreads();
    const int* ids = (const int*)(a.ws + A_IDS) + (size_t)t * 128 + h * 16; const float* gt = (const float*)(a.ws + A_GATES) + (size_t)t * 128 + h * 16;
    float smin = 1e30f, smax = -1e30f; bool bad = false;
    for (int k = 0; k < 16; ++k) { const int id = ids[k]; if (id < 0 || id >= 16384) { bad = true; continue; } const float v = s1[id >> 7] + s2[id & 127]; smin = fminf(smin, v); smax = fmaxf(smax, v); for (int k2 = 0; k2 < k; ++k2) if (ids[k2] == id) bad = true; }
    float l = 0.f; for (int k = 0; k < 16; ++k) { const int id = ids[k] & 16383; l += expf(s1[id >> 7] + s2[id & 127] - smax); }
    for (int k = 0; k < 16; ++k) { const int id = ids[k] & 16383; if (far(gt[k], expf(s1[id >> 7] + s2[id & 127] - smax) / l, 0.02f)) bad = true; }
    int c = 0; for (int e = tid; e < 16384; e += 64) if (s1[e >> 7] + s2[e & 127] > smin + 2e-3f) ++c;
    atomicAdd(&cnt, c); __syncthreads();
    if (tid == 0) dbg_report(a.ws, 11, bad || cnt > 15);
}
__global__ void chk15(DArgs a) {
    __shared__ float hc[128], row[1024], red[256];
    const int i = blockIdx.x, tid = threadIdx.x; const int t = hsh(i * 2 + 111) % NTOK; const bf16* x2 = (const bf16*)(a.ws + A_X2) + (size_t)t * 1024;
    const int* ids = (const int*)(a.ws + A_IDS) + (size_t)t * 128; const float* gt = (const float*)(a.ws + A_GATES) + (size_t)t * 128; const float* ut = (const float*)a.in[32]; const float* vt = (const float*)a.in[33];
    if (tid < 128) { const float* u = ut + (size_t)(ids[tid] & 16383) * 1024; float d = 0.f; for (int k = 0; k < 1024; ++k) d += bf2f(x2[k]) * u[k];
        hc[tid] = gt[tid] * 0.5f * d * (1.f + tanhf(0.7978845608f * (d + 0.044715f * d * d * d))); }
    __syncthreads();
    for (int c = tid; c < 1024; c += 256) { float r = ALPHA * bf2f(x2[c]); for (int k = 0; k < 128; ++k) r += hc[k] * vt[(size_t)(ids[k] & 16383) * 1024 + c]; row[c] = r; }
    __syncthreads();
    float m = 0.f; for (int c = tid; c < 1024; c += 256) m += row[c]; red[tid] = m; __syncthreads(); if (tid == 0) { float s = 0.f; for (int k = 0; k < 256; ++k) s += red[k]; red[0] = s / 1024.f; } __syncthreads(); m = red[0]; __syncthreads();
    float v = 0.f; for (int c = tid; c < 1024; c += 256) v += (row[c] - m) * (row[c] - m); red[tid] = v; __syncthreads(); if (tid == 0) { float s = 0.f; for (int k = 0; k < 256; ++k) s += red[k]; red[0] = s / 1024.f; } __syncthreads(); v = red[0];
    __syncthreads(); float se = 0.f, sr = 0.f;
    for (int c = tid; c < 1024; c += 256) { const float r = (row[c] - m) * rsqrtf(v + 1e-5f) * ((const float*)a.in[34])[c] + ((const float*)a.in[35])[c]; const float g = a.out[(size_t)t * 1024 + c]; se += (g - r) * (g - r); sr += r * r; }
    red[tid] = se; __syncthreads(); if (tid == 0) { float s = 0.f; for (int k = 0; k < 256; ++k) s += red[k]; hc[0] = s; } __syncthreads();
    red[tid] = sr; __syncthreads(); if (tid == 0) { float s = 0.f; for (int k = 0; k < 256; ++k) s += red[k]; dbg_report(a.ws, 12, !(hc[0] <= 0.003f * s)); }
}
__global__ void dbg_poison(DArgs a) {
    const unsigned f = ((const unsigned*)(a.ws + WS_CTL))[CW_DBG]; if (!f) return; const int code = 32 - (int)f; float sc = 1.f; for (int k = 0; k < code; ++k) sc *= 10.f;
    for (size_t e = (size_t)blockIdx.x * blockDim.x + threadIdx.x; e < (size_t)NTOK * DM; e += (size_t)gridDim.x * blockDim.x) a.out[e] *= sc;
}
#endif

extern "C" void kernel_launch(void* const* d_in, const int* in_sizes, int n_in, void* d_out, int out_size, void* d_ws, size_t ws_size, hipStream_t stream) {
    static int grid = 0;
    if (grid == 0) {
        if (n_in != 36 || in_sizes[0] != NTOK * DM || out_size != NTOK * DM || ws_size < WS_NEED) {
            fprintf(stderr, "kernel_launch: unexpected shapes (n_in %d, in0 %d, out %d, ws %zu); nothing launched\n", n_in, n_in > 0 ? in_sizes[0] : -1, out_size, ws_size); grid = -1; return; }
        int dev = 0, cus = 0, per_cu = 0;
        if (hipGetDevice(&dev) != hipSuccess || hipDeviceGetAttribute(&cus, hipDeviceAttributeMultiprocessorCount, dev) != hipSuccess) { grid = -1; return; }
        if (hipFuncSetAttribute((const void*)mk_fwd, hipFuncAttributeMaxDynamicSharedMemorySize, LDS_BYTES) != hipSuccess) { fprintf(stderr, "kernel_launch: hipFuncSetAttribute failed\n"); grid = -1; return; }
        if (hipOccupancyMaxActiveBlocksPerMultiprocessor(&per_cu, (const void*)mk_fwd, NWAVES * 64, LDS_BYTES) != hipSuccess || per_cu < 1)
            fprintf(stderr, "kernel_launch: note: occupancy query reports %d workgroups per CU\n", per_cu);
        (void)hipGetLastError();
        grid = cus;
    }
    if (grid < 0) return;
    if (hipMemsetAsync((char*)d_ws + WS_CTL, 0, CTL_ZERO_BYTES, stream) != hipSuccess) return;
    Args a{};
    for (int i = 0; i < 36; ++i) a.in[i] = d_in[i];
    a.out = (float*)d_out; a.ws = (unsigned char*)d_ws;
#if MK_DBG
    DArgs da{}; for (int i = 0; i < 36; ++i) da.in[i] = d_in[i]; da.out = (float*)d_out; da.ws = (unsigned char*)d_ws;
    for (int p = 0; p < NPH; ++p) { a.ph_lo = p; a.ph_hi = p + 1; hipLaunchKernelGGL(mk_fwd, dim3(grid), dim3(NWAVES * 64), LDS_BYTES, stream, a);
        if (p == 1) { hipLaunchKernelGGL(chk1, dim3(8), dim3(256), 0, stream, da); hipLaunchKernelGGL(chk_k2, dim3(8), dim3(256), 0, stream, da); }
        if (p == 2) hipLaunchKernelGGL(chk2, dim3(8), dim3(256), 0, stream, da);
        if (p == 4) { hipLaunchKernelGGL(chk3, dim3(64), dim3(256), 0, stream, da); hipLaunchKernelGGL(chk4, dim3(64), dim3(256), 0, stream, da); }
        if (p == 5) hipLaunchKernelGGL(chk5, dim3(8), dim3(256), 0, stream, da);
        if (p == 7) hipLaunchKernelGGL(chk7, dim3(8), dim3(256), 0, stream, da);
        if (p == 8) hipLaunchKernelGGL(chk8, dim3(8), dim3(256), 0, stream, da, 0);
        if (p == 10) hipLaunchKernelGGL(chk10, dim3(64), dim3(256), 0, stream, da);
        if (p == 11) hipLaunchKernelGGL(chk8, dim3(8), dim3(256), 0, stream, da, 1);
        if (p == 12) hipLaunchKernelGGL(chk12, dim3(8), dim3(256), 0, stream, da);
        if (p == 13) hipLaunchKernelGGL(chk13, dim3(512), dim3(64), 0, stream, da);
        if (p == 15) { hipLaunchKernelGGL(chk15, dim3(64), dim3(256), 0, stream, da); hipLaunchKernelGGL(dbg_poison, dim3(1024), dim3(256), 0, stream, da); } }
#elif MK_PER_PHASE
    for (int p = 0; p < NPH; ++p) { a.ph_lo = p; a.ph_hi = p + 1; hipLaunchKernelGGL(mk_fwd, dim3(grid), dim3(NWAVES * 64), LDS_BYTES, stream, a); }
#else
    a.ph_lo = 0; a.ph_hi = NPH; hipLaunchKernelGGL(mk_fwd, dim3(grid), dim3(NWAVES * 64), LDS_BYTES, stream, a);
#endif
}
```

```cpp
#include <hip/hip_runtime.h>
#include <hip/hip_bf16.h>
#include <cstdio>
#include <cstdint>
#include <cmath>

#ifndef MK_PER_PHASE
#define MK_PER_PHASE 0
#endif
#ifndef MK_DBG
#define MK_DBG 0
#endif
#ifndef MK_REP
#define MK_REP 0
#endif
namespace pg8 {
#define PG8_LAS __attribute__((address_space(3)))
typedef unsigned short bf16_t;
typedef short bf16x8 __attribute__((ext_vector_type(8)));
typedef float f32x4 __attribute__((ext_vector_type(4)));
typedef unsigned u32x4 __attribute__((ext_vector_type(4)));
constexpr int BM = 256, BK = 64, HALF = 128, HTB = HALF * BK * 2  , STAGE_BYTES = 8 * HTB, NXCD = 8, WGM = 8;

__host__ __device__ __forceinline__ int lds_byte(int r, int c) { const int st = (r >> 4) * 2 + (c >> 5), rr = r & 15, cc = c & 31, ob = rr * 64 + cc * 2; return st * 1024 + (ob ^ (((ob >> 9) & 1) << 5)); }
__host__ __device__ __forceinline__ void stage_rc(int b, int& R, int& C) { const int st = b / 1024, sb = b % 1024, swz = sb ^ (((sb >> 9) & 1) << 5); R = (st >> 1) * 16 + swz / 64; C = (st & 1) * 32 + (swz % 64) / 2; }
__host__ __device__ __forceinline__ int perm32(int rho) { const int n = rho >> 4, i = rho & 15; return 8 * (i >> 2) + 4 * n + (i & 3); }

struct Unit { int pm, pn; };
struct Gemm { const bf16_t* A; const bf16_t* Bt; int M, N, K; };

struct StaticOrder {
    int nM, nN, nwg, G, c;
    __host__ __device__ void init(int M, int N, int G_, int c_) { nM = M / BM; nN = N / BM; nwg = nM * nN; G = G_; c = c_; }
    __host__ __device__ bool next(int i, Unit& u) const {
        const long L = (long)i * G + c; if (L >= nwg) return false;
        int wgid = (int)L; { const int q = nwg / NXCD, r = nwg % NXCD, xcd = wgid % NXCD, off = wgid / NXCD; wgid = (xcd < r ? xcd * (q + 1) : r * (q + 1) + (xcd - r) * q) + off; }
        const int nig = WGM * nN, gid = wgid / nig, fm = gid * WGM, gsz = (nM - fm) < WGM ? (nM - fm) : WGM;
        u.pm = fm + ((wgid % nig) % gsz); u.pn = (wgid % nig) / gsz; return true;
    }
    __device__ __forceinline__ void a_ready(const Unit&) const {}
    __device__ __forceinline__ void done(const Unit&) const {}
};

__device__ __forceinline__ unsigned cvt_pk_bf16(float lo, float hi) { unsigned r; asm volatile("v_cvt_pk_bf16_f32 %0, %1, %2" : "=v"(r) : "v"(lo), "v"(hi)); return r; }
typedef float f32x2 __attribute__((ext_vector_type(2)));
__device__ __forceinline__ f32x2 gelu_pk(f32x2 v) {
    const f32x2 av = __builtin_elementwise_abs(v), d = av * 0.2316418882f + 1.0f;
    f32x2 t; t.x = __builtin_amdgcn_rcpf(d.x); t.y = __builtin_amdgcn_rcpf(d.y);
    f32x2 q = t * 0.5307027145f + (-0.7265760135f); q = q * t + 0.7107068705f; q = q * t + (-0.142248368f); q = q * t + 0.127414796f; q = q * t;
    const f32x2 s = (v * v) * (-0.72134752044f);
    f32x2 e; e.x = __builtin_amdgcn_exp2f(s.x); e.y = __builtin_amdgcn_exp2f(s.y);
    const f32x2 m = v * (q * e), r = v - m;
    f32x2 o; o.x = v.x < 0.f ? m.x : r.x; o.y = v.y < 0.f ? m.y : r.y; return o;
}

template <int ACT  > struct EpiBf16 {
    static constexpr bool PERM = true, AFTER_DRAIN = false; static_assert(ACT == 0 || ACT == 1, "EpiBf16: ACT is 0 (none) or 1 (gelu_pk)");
    bf16_t* O; int ldc; const float* bias; int split_cols; size_t split_stride; float scale0;
    __device__ __forceinline__ void operator()(const f32x4 (&acc)[2][2][4][2], const Unit& u, int wr, int wc, int fr, int fq) const {
        const int row0 = u.pm * BM + wr * 64 + fr; int colt = u.pn * BM; bf16_t* base = O;
        float sc = 1.f; if (split_cols) { const int t = colt / split_cols; base += (size_t)t * split_stride; colt -= t * split_cols; if (t == 0) sc = scale0; }
        const int col0 = colt + wc * 32 + 8 * fq, bcol0 = u.pn * BM + wc * 32 + 8 * fq;
        f32x4 bv[2][2];
#pragma unroll
        for (int bj = 0; bj < 2; ++bj)
#pragma unroll
            for (int n = 0; n < 2; ++n) bv[bj][n] = bias ? *(const f32x4*)(bias + bcol0 + bj * HALF + 4 * n) : (f32x4){0.f, 0.f, 0.f, 0.f};
#pragma unroll
        for (int ai = 0; ai < 2; ++ai)
#pragma unroll
            for (int m = 0; m < 4; ++m) { bf16_t* rowp = base + (size_t)(row0 + ai * HALF + m * 16) * ldc + col0;
#pragma unroll
                for (int bj = 0; bj < 2; ++bj) { f32x4 v0 = acc[ai][bj][m][0] + bv[bj][0], v1 = acc[ai][bj][m][1] + bv[bj][1];
                    if (ACT == 1) { f32x2 a = gelu_pk((f32x2){v0[0], v0[1]}), b = gelu_pk((f32x2){v0[2], v0[3]}), c = gelu_pk((f32x2){v1[0], v1[1]}), d = gelu_pk((f32x2){v1[2], v1[3]});
                        v0 = (f32x4){a.x, a.y, b.x, b.y}; v1 = (f32x4){c.x, c.y, d.x, d.y}; }
                    v0 = v0 * sc; v1 = v1 * sc; u32x4 w; w.x = cvt_pk_bf16(v0[0], v0[1]); w.y = cvt_pk_bf16(v0[2], v0[3]); w.z = cvt_pk_bf16(v1[0], v1[1]); w.w = cvt_pk_bf16(v1[2], v1[3]);
                    *(u32x4*)(rowp + bj * HALF) = w; } }
    }
};

struct PanelStats {
    unsigned* xbuf;
    unsigned* cnt;
    unsigned* tmo;
    int ntn; float eps;
    unsigned code;
    __device__ __forceinline__ bool run(const f32x4 (&v)[2][2][4][2], const Unit& u, int wr, int wc, int fr, int fq, PG8_LAS unsigned char* lds, int wid, int lane) const {
        typedef float f32x2v __attribute__((ext_vector_type(2)));
        PG8_LAS f32x2v* P = (PG8_LAS f32x2v*)lds;
        PG8_LAS f32x2v* S = (PG8_LAS f32x2v*)(lds + 8192);
        PG8_LAS unsigned* flag = (PG8_LAS unsigned*)(lds + 8192 + 2048);
#pragma unroll
        for (int ai = 0; ai < 2; ++ai)
#pragma unroll
            for (int m = 0; m < 4; ++m) {
                float s = 0.f;
#pragma unroll
                for (int bj = 0; bj < 2; ++bj)
#pragma unroll
                    for (int n = 0; n < 2; ++n) { const f32x4 x = v[ai][bj][m][n]; s += (x[0] + x[1]) + (x[2] + x[3]); }
                s += __shfl_xor(s, 16); s += __shfl_xor(s, 32);
                const float mw = s * (1.0f / 64.0f); float q = 0.f;
#pragma unroll
                for (int bj = 0; bj < 2; ++bj)
#pragma unroll
                    for (int n = 0; n < 2; ++n) { const f32x4 d = v[ai][bj][m][n] - mw; q += (d[0] * d[0] + d[1] * d[1]) + (d[2] * d[2] + d[3] * d[3]); }
                q += __shfl_xor(q, 16); q += __shfl_xor(q, 32);
                if (fq == 0) P[(ai * HALF + wr * 64 + m * 16 + fr) * 4 + wc] = (f32x2v){mw, q};
            }
        asm volatile("s_waitcnt lgkmcnt(0)" ::: "memory"); __builtin_amdgcn_s_barrier(); asm volatile("" ::: "memory");
#if defined(BROKEN_EXCHANGE_NO_WAIT)
#warning BROKEN CONTROL BUILD: the row-statistics exchange does not wait; results are wrong by design
        if (blockIdx.x >= 64) { const long long t0_ = clock64(); while (clock64() - t0_ < 60000) __builtin_amdgcn_s_sleep(8); }
#endif
        const int row = wid * 32 + (lane & 31);
        if (lane < 32) {
            const f32x2v a = P[row * 4 + 0], b = P[row * 4 + 1], c = P[row * 4 + 2], d = P[row * 4 + 3];
            const float mt = (a.x + b.x + c.x + d.x) * 0.25f;
            const float da = a.x - mt, db = b.x - mt, dc = c.x - mt, dd = d.x - mt;
            const float m2 = (a.y + b.y) + (c.y + d.y) + 64.0f * ((da * da + db * db) + (dc * dc + dd * dd));
            unsigned long long* slot = (unsigned long long*)xbuf + ((size_t)(u.pm * BM + row) * 4 + u.pn);
            __hip_atomic_store(slot, ((unsigned long long)__float_as_uint(m2) << 32) | __float_as_uint(mt), __ATOMIC_RELAXED, __HIP_MEMORY_SCOPE_AGENT);
        }
        asm volatile("s_waitcnt vmcnt(0)" ::: "memory");
        if (lane == 0) __hip_atomic_fetch_add(cnt + 64 * u.pm, 1u, __ATOMIC_RELAXED, __HIP_MEMORY_SCOPE_AGENT);
        if (wid == 0) {
            bool dead = false; const unsigned long long t0 = __builtin_amdgcn_s_memrealtime(); const unsigned want = 8u * (unsigned)ntn;
            for (;;) {
#if defined(BROKEN_EXCHANGE_NO_WAIT)
                break;
#endif
                if ((unsigned)__builtin_amdgcn_readfirstlane(__hip_atomic_load(cnt + 64 * u.pm, __ATOMIC_RELAXED, __HIP_MEMORY_SCOPE_AGENT)) >= want) break;
                if (__builtin_amdgcn_s_memrealtime() - t0 > 2000000ull) {
                    if (lane == 0) { unsigned expect = 0u; __hip_atomic_compare_exchange_strong(tmo + 1, &expect, code | (unsigned)(u.pm & 0xff), __ATOMIC_RELAXED, __ATOMIC_RELAXED, __HIP_MEMORY_SCOPE_AGENT);
                                     __hip_atomic_store(tmo, 1u, __ATOMIC_RELAXED, __HIP_MEMORY_SCOPE_AGENT); }
                    dead = true; break; }
                __builtin_amdgcn_s_sleep(2);
            }
            __builtin_amdgcn_fence(__ATOMIC_ACQUIRE, "agent");
            if (lane == 0) flag[0] = dead ? 1u : 0u;
        }
        asm volatile("s_waitcnt vmcnt(0) lgkmcnt(0)" ::: "memory"); __builtin_amdgcn_s_barrier(); asm volatile("" ::: "memory");
        const bool bad = flag[0] != 0u;
        if (lane < 32) {
            const unsigned long long* slot = (const unsigned long long*)xbuf + (size_t)(u.pm * BM + row) * 4; float mt[4], m2[4]; float ms = 0.f;
#pragma unroll
            for (int t = 0; t < 4; ++t) { if (t < ntn) { const unsigned long long w = __hip_atomic_load(slot + t, __ATOMIC_RELAXED, __HIP_MEMORY_SCOPE_AGENT); mt[t] = __uint_as_float((unsigned)w); m2[t] = __uint_as_float((unsigned)(w >> 32)); } else { mt[t] = 0.f; m2[t] = 0.f; } ms += mt[t]; }
            const float mean = ms / (float)ntn; float q = 0.f;
#pragma unroll
            for (int t = 0; t < 4; ++t) if (t < ntn) { const float dm = mt[t] - mean; q += m2[t] + 256.0f * dm * dm; }
            S[row] = (f32x2v){mean, 1.0f / sqrtf(q / (256.0f * (float)ntn) + eps)};
        }
        asm volatile("s_waitcnt lgkmcnt(0)" ::: "memory"); __builtin_amdgcn_s_barrier(); asm volatile("" ::: "memory");
        return bad;
    }
};
struct EpiLnRes {
    static constexpr bool PERM = false, AFTER_DRAIN = true;
    const float* base; float* out; int ldc; const float* bias; PanelStats st; unsigned poison;
    __device__ __forceinline__ void fused(f32x4 (&acc)[2][2][4][2], const Unit& u, int wr, int wc, int fr, int fq, PG8_LAS unsigned char* lds, int wid, int lane) const {
        typedef float f32x2v __attribute__((ext_vector_type(2)));
        const PG8_LAS f32x2v* S = (const PG8_LAS f32x2v*)(lds + 8192);
        const int col0 = u.pn * BM + wc * 32 + 4 * fq;
#pragma unroll
        for (int bj = 0; bj < 2; ++bj)
#pragma unroll
            for (int n = 0; n < 2; ++n) { const f32x4 bv = bias ? *(const f32x4*)(bias + col0 + bj * HALF + n * 16) : (f32x4){0.f, 0.f, 0.f, 0.f};
#pragma unroll
                for (int ai = 0; ai < 2; ++ai)
#pragma unroll
                    for (int m = 0; m < 4; ++m) acc[ai][bj][m][n] += bv; }
        f32x4 pre[4][2][2];
#pragma unroll
        for (int m = 0; m < 4; ++m) { const size_t off = (size_t)(u.pm * BM + wr * 64 + m * 16 + fr) * ldc + col0;
#pragma unroll
            for (int bj = 0; bj < 2; ++bj)
#pragma unroll
                for (int n = 0; n < 2; ++n) pre[m][bj][n] = *(const f32x4*)(base + off + bj * HALF + n * 16); }
        const bool bad = st.run(acc, u, wr, wc, fr, fq, lds, wid, lane) || poison != 0u;
        const float qnan = __builtin_nanf("");
#pragma unroll
        for (int ai = 0; ai < 2; ++ai)
#pragma unroll
            for (int m = 0; m < 4; ++m) { const int r = ai * HALF + wr * 64 + m * 16 + fr; const f32x2v sr = S[r]; const size_t off = (size_t)(u.pm * BM + r) * ldc + col0;
#pragma unroll
                for (int bj = 0; bj < 2; ++bj)
#pragma unroll
                    for (int n = 0; n < 2; ++n) { const f32x4 bs = ai == 0 ? pre[m][bj][n] : *(const f32x4*)(base + off + bj * HALF + n * 16); f32x4 o = bs + (acc[ai][bj][m][n] - sr.x) * sr.y;
                        if (bad) o = (f32x4){qnan, qnan, qnan, qnan}; *(f32x4*)(out + off + bj * HALF + n * 16) = o; }
                if (m & 1) asm volatile("" ::: "memory"); }
    }
};
struct EpiLnResLn {
    static constexpr bool PERM = false, AFTER_DRAIN = true;
    const float* base; float* out; bf16_t* xn; int ldc; const float* bias; PanelStats st1, st2; unsigned poison;
    __device__ __forceinline__ void fused(f32x4 (&acc)[2][2][4][2], const Unit& u, int wr, int wc, int fr, int fq, PG8_LAS unsigned char* lds, int wid, int lane) const {
        typedef float f32x2v __attribute__((ext_vector_type(2))); typedef unsigned u32x2v __attribute__((ext_vector_type(2)));
        const PG8_LAS f32x2v* S = (const PG8_LAS f32x2v*)(lds + 8192);
        const int col0 = u.pn * BM + wc * 32 + 4 * fq;
#pragma unroll
        for (int bj = 0; bj < 2; ++bj)
#pragma unroll
            for (int n = 0; n < 2; ++n) { const f32x4 bv = bias ? *(const f32x4*)(bias + col0 + bj * HALF + n * 16) : (f32x4){0.f, 0.f, 0.f, 0.f};
#pragma unroll
                for (int ai = 0; ai < 2; ++ai)
#pragma unroll
                    for (int m = 0; m < 4; ++m) acc[ai][bj][m][n] += bv; }
        bool bad = st1.run(acc, u, wr, wc, fr, fq, lds, wid, lane) || poison != 0u;
        const float qnan = __builtin_nanf("");
#pragma unroll
        for (int ai = 0; ai < 2; ++ai)
#pragma unroll
            for (int m = 0; m < 4; ++m) { const int r = ai * HALF + wr * 64 + m * 16 + fr; const f32x2v sr = S[r]; const size_t off = (size_t)(u.pm * BM + r) * ldc + col0;
#pragma unroll
                for (int bj = 0; bj < 2; ++bj)
#pragma unroll
                    for (int n = 0; n < 2; ++n) { const f32x4 bs = *(const f32x4*)(base + off + bj * HALF + n * 16); acc[ai][bj][m][n] = bs + (acc[ai][bj][m][n] - sr.x) * sr.y; }
                asm volatile("" : "+v"(acc[ai][0][m][0]), "+v"(acc[ai][0][m][1]), "+v"(acc[ai][1][m][0]), "+v"(acc[ai][1][m][1]));
                if (m & 1) asm volatile("" ::: "memory"); }
        const bool bad1 = bad;
        bad = st2.run(acc, u, wr, wc, fr, fq, lds, wid, lane) || bad;
#pragma unroll
        for (int ai = 0; ai < 2; ++ai)
#pragma unroll
            for (int m = 0; m < 4; ++m) { const int r = ai * HALF + wr * 64 + m * 16 + fr; const f32x2v sr = S[r]; const size_t off = (size_t)(u.pm * BM + r) * ldc + col0;
#pragma unroll
                for (int bj = 0; bj < 2; ++bj)
#pragma unroll
                    for (int n = 0; n < 2; ++n) { const f32x4 x1 = acc[ai][bj][m][n]; *(f32x4*)(out + off + bj * HALF + n * 16) = bad1 ? (f32x4){qnan, qnan, qnan, qnan} : x1;
                        const f32x4 o = (x1 - sr.x) * sr.y; u32x2v w; w.x = cvt_pk_bf16(o[0], o[1]); w.y = cvt_pk_bf16(o[2], o[3]);
                        if (bad) { w.x = 0x7fc07fc0u; w.y = 0x7fc07fc0u; } *(u32x2v*)(xn + off + bj * HALF + n * 16) = w; }
                asm volatile("" ::: "memory"); }
    }
};

template <class Epi, class Sched, bool ALIGN_EPI = false, bool SP2 = false>
__device__ __forceinline__ void gemm_phase(PG8_LAS unsigned char* lds, const Gemm g, const Sched& S, const Epi& E) {
    int tid_ = threadIdx.x; asm volatile("" : "+v"(tid_));
    const int tid = tid_, wid = __builtin_amdgcn_readfirstlane(tid >> 6), lane = tid & 63, wr = wid >> 2, wc = wid & 3, fr = lane & 15, fq = lane >> 4;
    const int K = g.K, nt = K / BK;
    unsigned voffA[2], voffB[2];
#pragma unroll
    for (int i = 0; i < 2; ++i) { int R, C; stage_rc(tid * 16 + i * 8192, R, C); const int Rb = Epi::PERM ? ((R & ~31) + perm32(R & 31)) : R;
        voffA[i] = (unsigned)(R * K + C) * 2u; voffB[i] = (unsigned)(Rb * K + C) * 2u; }
    const size_t kstep = (size_t)(BK * 2);
    const size_t hstep = (size_t)HALF * K * 2;
    const size_t tstep = 2 * hstep;
    const unsigned ldsw = (unsigned)wid * 1024u;
    const int aoff = lds_byte(wr * 64 + fr, fq * 8), boff = lds_byte(wc * 32 + fr, fq * 8);
#define PG8_SA(b, h) (((b) * 2 + (h)) * HTB)
#define PG8_SB(b, h) ((4 + (b) * 2 + (h)) * HTB)
#define PG8_STAGE(bufoff, gbase, voff) do { _Pragma("unroll") for (int _i = 0; _i < 2; ++_i) \
        __builtin_amdgcn_global_load_lds((const unsigned*)((const char*)(gbase) + (voff)[_i]), (PG8_LAS unsigned*)(lds + (bufoff) + ldsw + _i * 8192), 16, 0, 0); } while (0)
#define PG8_LDA(dst, b, h) do { _Pragma("unroll") for (int m = 0; m < 4; ++m) _Pragma("unroll") for (int k = 0; k < 2; ++k) dst[m][k] = *(const PG8_LAS bf16x8*)(lds + PG8_SA(b, h) + aoff + m * 2048 + k * 1024); } while (0)
#define PG8_LDB(dst, b, h) do { _Pragma("unroll") for (int n = 0; n < 2; ++n) _Pragma("unroll") for (int k = 0; k < 2; ++k) dst[n][k] = *(const PG8_LAS bf16x8*)(lds + PG8_SB(b, h) + boff + n * 2048 + k * 1024); } while (0)
#define PG8_MMA(ai, bj, At, Bt) do { __builtin_amdgcn_s_setprio(1); _Pragma("unroll") for (int m = 0; m < 4; ++m) _Pragma("unroll") for (int n = 0; n < 2; ++n) _Pragma("unroll") for (int k = 0; k < 2; ++k) \
        acc[ai][bj][m][n] = __builtin_amdgcn_mfma_f32_16x16x32_bf16(Bt[n][k], At[m][k], acc[ai][bj][m][n], 0, 0, 0); __builtin_amdgcn_s_setprio(0); } while (0)
#define PG8_WAIT_V(n) asm volatile("s_waitcnt vmcnt(" #n ")" ::: "memory")
#define PG8_WAIT_L(n) asm volatile("s_waitcnt lgkmcnt(" #n ")" ::: "memory")
#define PG8_BAR __builtin_amdgcn_s_barrier()
#define PG8_SCHED __builtin_amdgcn_sched_barrier(0)
    Unit cur, nxt; int ui = 0;
    if (!S.next(0, cur)) return;
    f32x4 acc[2][2][4][2];
#pragma unroll
    for (int a = 0; a < 2; ++a)
#pragma unroll
        for (int b = 0; b < 2; ++b)
#pragma unroll
            for (int m = 0; m < 4; ++m)
#pragma unroll
                for (int n = 0; n < 2; ++n) acc[a][b][m][n] = (f32x4){0.f, 0.f, 0.f, 0.f};
    bf16x8 At[4][2], B0[2][2], B1[2][2];
    const char* cA = (const char*)g.A + (size_t)cur.pm * tstep; const char* cB = (const char*)g.Bt + (size_t)cur.pn * tstep;
    S.a_ready(cur);
    if constexpr (SP2) {
        PG8_STAGE(PG8_SB(0, 0), cB, voffB); PG8_STAGE(PG8_SB(0, 1), cB + hstep, voffB); PG8_STAGE(PG8_SA(0, 0), cA, voffA); PG8_STAGE(PG8_SA(0, 1), cA + hstep, voffA);
        if (wr == 1) PG8_BAR;
        PG8_WAIT_V(2); PG8_BAR;
        PG8_STAGE(PG8_SB(1, 0), cB + kstep, voffB); PG8_STAGE(PG8_SA(1, 0), cA + kstep, voffA); PG8_STAGE(PG8_SB(1, 1), cB + hstep + kstep, voffB);
        PG8_WAIT_V(6); PG8_BAR;
    } else {
        PG8_STAGE(PG8_SB(0, 0), cB, voffB); PG8_STAGE(PG8_SA(0, 0), cA, voffA); PG8_STAGE(PG8_SB(0, 1), cB + hstep, voffB); PG8_STAGE(PG8_SA(0, 1), cA + hstep, voffA);
        if (wr == 1) PG8_BAR;
        PG8_WAIT_V(4); PG8_BAR;
        PG8_STAGE(PG8_SB(1, 0), cB + kstep, voffB); PG8_STAGE(PG8_SA(1, 0), cA + kstep, voffA); PG8_STAGE(PG8_SB(1, 1), cB + hstep + kstep, voffB);
        PG8_WAIT_V(6); PG8_BAR;
    }
    for (;;) {
        const bool has_next = S.next(ui + 1, nxt);
        const char* nA = has_next ? (const char*)g.A + (size_t)nxt.pm * tstep : cA; const char* nB = has_next ? (const char*)g.Bt + (size_t)nxt.pn * tstep : cB;
#pragma unroll 1
        for (int t = 0; t < nt; t += 2) {
            const bool last = (t == nt - 2);
            const char* a1 = cA + (size_t)(t + 1) * kstep;
            const char* a2 = last ? nA : cA + (size_t)(t + 2) * kstep; const char* b2 = last ? nB : cB + (size_t)(t + 2) * kstep;
            const char* a3 = a2 + kstep; const char* b3 = b2 + kstep;
            if (last && has_next) S.a_ready(nxt);
            if constexpr (SP2) {
            PG8_LDB(B0, 0, 0); PG8_LDB(B1, 0, 1); PG8_SCHED; PG8_LDA(At, 0, 0); PG8_STAGE(PG8_SA(1, 1), a1 + hstep, voffA);
            PG8_WAIT_V(8); PG8_WAIT_L(0); PG8_BAR; PG8_MMA(0, 0, At, B0); PG8_MMA(0, 1, At, B1); PG8_BAR; PG8_SCHED;
            PG8_LDA(At, 0, 1); PG8_STAGE(PG8_SB(0, 0), b2, voffB); PG8_STAGE(PG8_SB(0, 1), b2 + hstep, voffB); PG8_STAGE(PG8_SA(0, 0), a2, voffA);
            PG8_WAIT_V(8); PG8_WAIT_L(0); PG8_BAR; PG8_MMA(1, 0, At, B0); PG8_MMA(1, 1, At, B1); PG8_BAR; PG8_SCHED;
            PG8_LDB(B0, 1, 0); PG8_LDB(B1, 1, 1); PG8_SCHED; PG8_LDA(At, 1, 0); PG8_STAGE(PG8_SA(0, 1), a2 + hstep, voffA);
            PG8_WAIT_V(8); PG8_WAIT_L(0); PG8_BAR; PG8_MMA(0, 0, At, B0); PG8_MMA(0, 1, At, B1); PG8_BAR; PG8_SCHED;
            PG8_LDA(At, 1, 1); PG8_STAGE(PG8_SB(1, 0), b3, voffB); PG8_STAGE(PG8_SB(1, 1), b3 + hstep, voffB); PG8_STAGE(PG8_SA(1, 0), a3, voffA);
            PG8_WAIT_V(8); PG8_WAIT_L(0); PG8_BAR; PG8_MMA(1, 0, At, B0); PG8_MMA(1, 1, At, B1); PG8_BAR; PG8_SCHED;
            } else {
            PG8_LDB(B0, 0, 0); PG8_SCHED; PG8_LDA(At, 0, 0); PG8_STAGE(PG8_SA(1, 1), a1 + hstep, voffA);
            PG8_WAIT_L(8); PG8_BAR; PG8_WAIT_L(0); PG8_MMA(0, 0, At, B0); PG8_BAR; PG8_SCHED;
            PG8_LDB(B1, 0, 1); PG8_STAGE(PG8_SB(0, 0), b2, voffB);
            PG8_BAR; PG8_WAIT_L(0); PG8_MMA(0, 1, At, B1); PG8_BAR;
            PG8_LDA(At, 0, 1); PG8_STAGE(PG8_SA(0, 0), a2, voffA);
            PG8_BAR; PG8_WAIT_L(0); PG8_MMA(1, 0, At, B0); PG8_BAR; PG8_SCHED;
            PG8_STAGE(PG8_SB(0, 1), b2 + hstep, voffB);
            PG8_WAIT_V(6); PG8_BAR; PG8_MMA(1, 1, At, B1); PG8_BAR;
            PG8_LDB(B0, 1, 0); PG8_SCHED; PG8_LDA(At, 1, 0); PG8_STAGE(PG8_SA(0, 1), a2 + hstep, voffA);
            PG8_WAIT_L(8); PG8_BAR; PG8_WAIT_L(0); PG8_MMA(0, 0, At, B0); PG8_BAR; PG8_SCHED;
            PG8_LDB(B1, 1, 1); PG8_STAGE(PG8_SB(1, 0), b3, voffB);
            PG8_BAR; PG8_WAIT_L(0); PG8_MMA(0, 1, At, B1); PG8_BAR;
            PG8_LDA(At, 1, 1); PG8_STAGE(PG8_SA(1, 0), a3, voffA);
            PG8_BAR; PG8_WAIT_L(0); PG8_MMA(1, 0, At, B0); PG8_BAR; PG8_SCHED;
            PG8_STAGE(PG8_SB(1, 1), b3 + hstep, voffB);
            PG8_WAIT_V(6); PG8_BAR; PG8_MMA(1, 1, At, B1); PG8_BAR;
            }
        }
        if constexpr (ALIGN_EPI) { if (wr == 0) PG8_BAR; }
        if constexpr (!Epi::AFTER_DRAIN) { E(acc, cur, wr, wc, fr, fq); S.done(cur); }
        if (!has_next) break;
#pragma unroll
        for (int a = 0; a < 2; ++a)
#pragma unroll
            for (int b = 0; b < 2; ++b)
#pragma unroll
                for (int m = 0; m < 4; ++m)
#pragma unroll
                    for (int n = 0; n < 2; ++n) acc[a][b][m][n] = (f32x4){0.f, 0.f, 0.f, 0.f};
        cur = nxt; cA = nA; cB = nB; ++ui;
        if constexpr (ALIGN_EPI) { if (wr == 1) PG8_BAR; }
    }
    PG8_WAIT_V(0);
    if constexpr (!ALIGN_EPI) { if (wr == 0) PG8_BAR; }
    PG8_BAR;
    if constexpr (Epi::AFTER_DRAIN) { E.fused(acc, cur, wr, wc, fr, fq, lds, wid, lane); S.done(cur); }
#undef PG8_SA
#undef PG8_SB
#undef PG8_STAGE
#undef PG8_LDA
#undef PG8_LDB
#undef PG8_MMA
#undef PG8_WAIT_V
#undef PG8_WAIT_L
#undef PG8_BAR
#undef PG8_SCHED
}
}

namespace mk {
typedef unsigned short bf16;
typedef float f32x4 __attribute__((ext_vector_type(4)));
typedef float f32x2 __attribute__((ext_vector_type(2)));
typedef unsigned u32x4 __attribute__((ext_vector_type(4)));
typedef unsigned u32x2 __attribute__((ext_vector_type(2)));
typedef short bf16x8 __attribute__((ext_vector_type(8)));
#define LAS __attribute__((address_space(3)))

constexpr int NTOK = 16384, DM = 1024, SEQ = 8192, NBATCH = 2;
constexpr int QL = 384, KVL = 256, NINP = 1280;
constexpr float ALPHA = 1.18920711500272f;
constexpr float C2Q = 0.10206207261596575f * 1.4426950408889634f;
constexpr float XSC = 0.0625f * 1.4426950408889634f;
constexpr float LN_EPS = 1e-5f, RMS_EPS = 1e-6f;

constexpr size_t MiB = 1u << 20;
constexpr size_t WS_CTL = 0, CTL_ZERO_BYTES = 1 * MiB;
constexpr size_t W_WINT = 1 * MiB;
constexpr size_t W_WUQT = W_WINT + (size_t)1280 * 1024 * 2;
constexpr size_t W_WUKVT = W_WUQT + (size_t)768 * 384 * 2;
constexpr size_t W_WGLUT = W_WUKVT + (size_t)1024 * 256 * 2;
constexpr size_t W_WOUTT = W_WGLUT + (size_t)512 * 512 * 2;
constexpr size_t W_XKVT = W_WOUTT + (size_t)1024 * 1024 * 2;
constexpr size_t W_XQH = W_XKVT + (size_t)2048 * 1024 * 2;
constexpr size_t W_XOTH = W_XQH + (size_t)4 * 1024 * 256 * 2;
constexpr size_t W_MB = W_XOTH + (size_t)4 * 1024 * 256 * 2;
constexpr size_t W_VOT = W_MB + (size_t)2 * 1024 * 1024 * 2;
constexpr size_t W_K2V2 = W_VOT + (size_t)2 * 1024 * 1024 * 2;
constexpr size_t W_WQR = W_K2V2 + (size_t)2 * 2 * 4 * 256 * 256 * 2;
constexpr size_t W_SKP = W_WQR + (size_t)16 * 1024 * 256 * 2;
constexpr size_t W_WSC = W_SKP + (size_t)2 * 256 * 256 * 2;
constexpr size_t W_TH = W_WSC + (size_t)2048 * 1024 * 2;
constexpr size_t W_GM = W_TH + (size_t)32 * 512 * 640 * 2;
constexpr size_t W_MEMB = W_GM + (size_t)32 * 256 * 640 * 2;
constexpr size_t W_ROPE = W_MEMB + (size_t)512 * 1024 * 2;
constexpr size_t W_SSQ = W_ROPE + (size_t)16384 * 16 * 8;
constexpr size_t W_END = W_SSQ + (size_t)16384 * 20 * 4;
static_assert(W_END <= 80 * MiB, "weights region");
constexpr size_t A_UT = 80 * MiB, A_VT = 96 * MiB;
constexpr size_t A_SCHI = 112 * MiB;
constexpr size_t A_CQ = 144 * MiB, A_CKV = 156 * MiB, A_UP = 164 * MiB, A_QH = 184 * MiB, A_KH = 208 * MiB, A_VH = 232 * MiB, A_LS = 248 * MiB;
constexpr size_t A_OA = 144 * MiB, A_MIXN = 184 * MiB, A_X1 = 216 * MiB, A_P = 144 * MiB, A_X2 = 176 * MiB, A_IDS = 208 * MiB, A_GATES = 216 * MiB;
constexpr size_t WS_NEED = 256 * MiB;
constexpr size_t O_XB = 0, O_YS = 0, O_OS = 16 * MiB;
constexpr int CW_TMO = 0, CW_BAR = 4096, CW_SSQQ = 16384, CW_SSQKV = 32768, CW_DBG = 65536;
constexpr int RING_BYTES = 131072, EXCH_OFF = 131072, MISC_OFF = EXCH_OFF + 8192, LDS_BYTES = 147456;

__device__ __forceinline__ unsigned cvtpk(float lo, float hi) { unsigned r; asm volatile("v_cvt_pk_bf16_f32 %0, %1, %2" : "=v"(r) : "v"(lo), "v"(hi)); return r; }
__device__ __forceinline__ u32x4 pack8(f32x4 a, f32x4 b) { u32x4 w; w.x = cvtpk(a[0], a[1]); w.y = cvtpk(a[2], a[3]); w.z = cvtpk(b[0], b[1]); w.w = cvtpk(b[2], b[3]); return w; }
__device__ __forceinline__ float bflo(unsigned w) { return __uint_as_float(w << 16); }
__device__ __forceinline__ float bfhi(unsigned w) { return __uint_as_float(w & 0xffff0000u); }
__device__ __forceinline__ void unpack8(u32x4 w, f32x4& a, f32x4& b) { a = (f32x4){bflo(w.x), bfhi(w.x), bflo(w.y), bfhi(w.y)}; b = (f32x4){bflo(w.z), bfhi(w.z), bflo(w.w), bfhi(w.w)}; }
__device__ __forceinline__ float gelu_tanh(float v) {
    const float z = v * (1.0f + 0.044715f * v * v) * (-2.0f * 0.7978845608028654f * 1.4426950408889634f);
    return v * __builtin_amdgcn_rcpf(1.0f + __builtin_amdgcn_exp2f(z));
}
__device__ __forceinline__ float sigmoidf_(float z) { return __builtin_amdgcn_rcpf(1.0f + __builtin_amdgcn_exp2f(-1.4426950408889634f * z)); }

template <class Dec> struct ListSched {
    int n, G, c; Dec dec;
    __device__ __forceinline__ bool next(int i, pg8::Unit& u) const { const long L = (long)i * G + c; if (L >= n) return false; dec((int)L, u); return true; }
    __device__ __forceinline__ void a_ready(const pg8::Unit&) const {}
    __device__ __forceinline__ void done(const pg8::Unit&) const {}
};
struct BigSched {
    pg8::StaticOrder so; int bt;
    __device__ __forceinline__ bool next(int i, pg8::Unit& u) const { if (!so.next(i, u)) return false; u.pn += (u.pm >> 5) * bt; return true; }
    __device__ __forceinline__ void a_ready(const pg8::Unit&) const {}
    __device__ __forceinline__ void done(const pg8::Unit&) const {}
};
struct DecLS  { __device__ __forceinline__ void operator()(int L, pg8::Unit& u) const { const int g = L >> 1, b = L & 1; u.pm = 2 * g + b; u.pn = g; } };
struct DecY   { __device__ __forceinline__ void operator()(int L, pg8::Unit& u) const { const int g = L >> 2, b = (L >> 1) & 1, n = L & 1; u.pm = 2 * g + b; u.pn = 2 * g + n; } };
struct DecKV2 { __device__ __forceinline__ void operator()(int L, pg8::Unit& u) const { u.pm = L >> 3; u.pn = L & 7; } };
struct DecMb  { __device__ __forceinline__ void operator()(int L, pg8::Unit& u) const { const int bh = L >> 2, kt = L & 3; u.pm = bh; u.pn = (bh & 3) * 4 + kt; } };
struct DecVOT { __device__ __forceinline__ void operator()(int L, pg8::Unit& u) const { const int bh = L >> 2, ct = L & 3; u.pm = (bh & 3) * 4 + ct; u.pn = bh; } };
struct DecWsc { __device__ __forceinline__ void operator()(int L, pg8::Unit& u) const { const int hh = L >> 2, kt = L & 3; u.pm = hh & 1; u.pn = hh * 4 + kt; } };

typedef f32x4 AccT[2][2][4][2];
#define EPI_ROWS_BEGIN _Pragma("unroll") for (int ai = 0; ai < 2; ++ai) _Pragma("unroll") for (int m = 0; m < 4; ++m) { const int rt = ai * 128 + wr * 64 + m * 16 + fr;
#define EPI_ROWS_END asm volatile("" ::: "memory"); }

__device__ __forceinline__ void rope8(f32x4& v0, f32x4& v1, const float2* cs) {
#pragma unroll
    for (int j = 0; j < 4; ++j) { const float2 c = cs[j]; const float a = v0[j], b = v1[j]; v0[j] = a * c.x - b * c.y; v1[j] = b * c.x + a * c.y; }
}

struct EpiWin {
    static constexpr bool PERM = true, AFTER_DRAIN = false;
    bf16* CQ; bf16* CKV; bf16* KH; bf16* UP; const float2* rope; float* ssqp;
    __device__ __forceinline__ void operator()(AccT& acc, const pg8::Unit& u, int wr, int wc, int fr, int fq) const { asm volatile("" : "+v"(fr), "+v"(fq));
#pragma unroll
        for (int bj = 0; bj < 2; ++bj) {
            const int s = 8 * u.pn + 4 * bj + wc;
            if (s >= 21 && s < 24) continue;
            const int c0 = 32 * s + 8 * fq;
            EPI_ROWS_BEGIN {
                const int t = u.pm * 256 + rt; f32x4 v0 = acc[ai][bj][m][0], v1 = acc[ai][bj][m][1];
                if (s < 20) {
                    float q = (v0[0] * v0[0] + v0[1] * v0[1]) + (v0[2] * v0[2] + v0[3] * v0[3]) + (v1[0] * v1[0] + v1[1] * v1[1]) + (v1[2] * v1[2] + v1[3] * v1[3]);
                    q += __shfl_xor(q, 16); q += __shfl_xor(q, 32);
                    if (fq == 0) ssqp[(size_t)t * 20 + s] = q;
                    if (s < 12) *(u32x4*)(CQ + (size_t)t * QL + c0) = pack8(v0, v1);
                    else *(u32x4*)(CKV + (size_t)t * KVL + (c0 - 384)) = pack8(v0, v1);
                } else if (s == 20) {
                    rope8(v0, v1, rope + (size_t)t * 16 + 4 * fq);
                    const u32x4 w = pack8(v0, v1); const int b = t >> 13, tl = t & 8191;
#pragma unroll
                    for (int h = 0; h < 8; ++h) *(u32x4*)(KH + ((size_t)(b * 8 + h) * SEQ + tl) * 96 + 64 + 8 * fq) = w;
                } else {
                    const int ch = c0 - 768, g = ch >> 4, h8 = ch & 15, b = t >> 13, tl = t & 8191, chunk = b * 256 + (tl >> 5), j = tl & 31;
                    *(u32x4*)(UP + ((size_t)(g * 512 + chunk) * 640) + j * 16 + h8) = pack8(v0, v1);
                }
            } EPI_ROWS_END
        }
    }
};
struct EpiQ {
    static constexpr bool PERM = true, AFTER_DRAIN = false;
    bf16* QH; const float2* rope; const float* ssqp;
    __device__ __forceinline__ void operator()(AccT& acc, const pg8::Unit& u, int wr, int wc, int fr, int fq) const { asm volatile("" : "+v"(fr), "+v"(fq));
#pragma unroll
        for (int bj = 0; bj < 2; ++bj) {
            const int s = 8 * u.pn + 4 * bj + wc, h = s / 3, sl = s - 3 * h, d0 = sl * 32 + 8 * fq;
            EPI_ROWS_BEGIN {
                const int t = u.pm * 256 + rt; const f32x4 qa = *(const f32x4*)(ssqp + (size_t)t * 20), qb = *(const f32x4*)(ssqp + (size_t)t * 20 + 4), qc = *(const f32x4*)(ssqp + (size_t)t * 20 + 8);
                const float sq = ((qa[0] + qa[1]) + (qa[2] + qa[3])) + ((qb[0] + qb[1]) + (qb[2] + qb[3])) + ((qc[0] + qc[1]) + (qc[2] + qc[3]));
                const float rq = rsqrtf(sq * (1.0f / QL) + RMS_EPS) * C2Q;
                f32x4 v0 = acc[ai][bj][m][0] * rq, v1 = acc[ai][bj][m][1] * rq;
                if (sl == 2) rope8(v0, v1, rope + (size_t)t * 16 + 4 * fq);
                const int b = t >> 13, tl = t & 8191;
                *(u32x4*)(QH + ((size_t)(b * 8 + h) * SEQ + tl) * 96 + d0) = pack8(v0, v1);
            } EPI_ROWS_END
        }
    }
};
struct EpiKV {
    static constexpr bool PERM = true, AFTER_DRAIN = false;
    bf16* KH; bf16* VH; const float* ssqp;
    __device__ __forceinline__ void operator()(AccT& acc, const pg8::Unit& u, int wr, int wc, int fr, int fq) const { asm volatile("" : "+v"(fr), "+v"(fq));
#pragma unroll
        for (int bj = 0; bj < 2; ++bj) {
            const int s = 8 * u.pn + 4 * bj + wc, h = s >> 2, sl = s & 3, j0 = sl * 32 + 8 * fq;
            EPI_ROWS_BEGIN {
                const int t = u.pm * 256 + rt; const f32x4 qa = *(const f32x4*)(ssqp + (size_t)t * 20 + 12), qb = *(const f32x4*)(ssqp + (size_t)t * 20 + 16);
                const float rk = rsqrtf((((qa[0] + qa[1]) + (qa[2] + qa[3])) + ((qb[0] + qb[1]) + (qb[2] + qb[3]))) * (1.0f / KVL) + RMS_EPS);
                const f32x4 v0 = acc[ai][bj][m][0] * rk, v1 = acc[ai][bj][m][1] * rk; const int b = t >> 13, tl = t & 8191;
                if (sl < 2) *(u32x4*)(KH + ((size_t)(b * 8 + h) * SEQ + tl) * 96 + j0) = pack8(v0, v1);
                else *(u32x4*)(VH + ((size_t)(b * 8 + h) * SEQ + tl) * 64 + (j0 - 64)) = pack8(v0, v1);
            } EPI_ROWS_END
        }
    }
};
struct EpiLS {
    static constexpr bool PERM = false, AFTER_DRAIN = false;
    float* LS;
    __device__ __forceinline__ void operator()(AccT& acc, const pg8::Unit& u, int wr, int wc, int fr, int fq) const { asm volatile("" : "+v"(fr), "+v"(fq));
        const int g = u.pn, b = u.pm & 1;
        EPI_ROWS_BEGIN {
            float* rowp = LS + ((size_t)(g * 512 + b * 256 + rt)) * 128 + wc * 32 + 4 * fq;
            *(f32x4*)(rowp) = acc[ai][0][m][0]; *(f32x4*)(rowp + 16) = acc[ai][0][m][1];
        } EPI_ROWS_END
    }
};
struct EpiY {
    static constexpr bool PERM = true, AFTER_DRAIN = false;
    bf16* YS;
    __device__ __forceinline__ void operator()(AccT& acc, const pg8::Unit& u, int wr, int wc, int fr, int fq) const { asm volatile("" : "+v"(fr), "+v"(fq));
        const int g = u.pm >> 1, b = u.pm & 1, nt = u.pn & 1;
#pragma unroll
        for (int bj = 0; bj < 2; ++bj) {
            const int n0 = nt * 256 + bj * 128 + wc * 32 + 8 * fq, i = n0 >> 4, h8 = n0 & 15;
            EPI_ROWS_BEGIN {
                const int t = b * SEQ + rt * 32 + i; f32x4 v0 = acc[ai][bj][m][0], v1 = acc[ai][bj][m][1];
#pragma unroll
                for (int j = 0; j < 4; ++j) { v0[j] = gelu_tanh(v0[j]); v1[j] = gelu_tanh(v1[j]); }
                *(u32x4*)(YS + (size_t)t * 512 + g * 16 + h8) = pack8(v0, v1);
            } EPI_ROWS_END
        }
    }
};
struct EpiGlu {
    static constexpr bool PERM = true, AFTER_DRAIN = false;
    const bf16* YS; bf16* OS; const float* bglu;
    __device__ __forceinline__ void operator()(AccT& acc, const pg8::Unit& u, int wr, int wc, int fr, int fq) const { asm volatile("" : "+v"(fr), "+v"(fq));
#pragma unroll
        for (int bj = 0; bj < 2; ++bj) {
            const int c0 = u.pn * 256 + bj * 128 + wc * 32 + 8 * fq;
            const f32x4 b0 = *(const f32x4*)(bglu + c0), b1 = *(const f32x4*)(bglu + c0 + 4);
            EPI_ROWS_BEGIN {
                const int t = u.pm * 256 + rt; f32x4 y0, y1; unpack8(*(const u32x4*)(YS + (size_t)t * 512 + c0), y0, y1);
                f32x4 z0 = acc[ai][bj][m][0] + b0, z1 = acc[ai][bj][m][1] + b1;
#pragma unroll
                for (int j = 0; j < 4; ++j) { z0[j] = y0[j] * sigmoidf_(z0[j]); z1[j] = y1[j] * sigmoidf_(z1[j]); }
                *(u32x4*)(OS + (size_t)t * 512 + c0) = pack8(z0, z1);
            } EPI_ROWS_END
        }
    }
};
template <int MODE  > struct EpiPre {
    static constexpr bool PERM = false, AFTER_DRAIN = false;
    const float* resf; const bf16* resb; float* PRE;
    __device__ __forceinline__ void operator()(AccT& acc, const pg8::Unit& u, int wr, int wc, int fr, int fq) const { asm volatile("" : "+v"(fr), "+v"(fq));
        const int cb = (u.pn & 3) * 256 + wc * 32 + 4 * fq;
        EPI_ROWS_BEGIN {
            const size_t ro = (size_t)(u.pm * 256 + rt) * DM + cb;
#pragma unroll
            for (int bj = 0; bj < 2; ++bj)
#pragma unroll
                for (int n = 0; n < 2; ++n) { const size_t o = ro + bj * 128 + n * 16; f32x4 r;
                    if (MODE == 0) r = *(const f32x4*)(resf + o);
                    else { const u32x2 w = *(const u32x2*)(resb + o); r = (f32x4){bflo(w.x), bfhi(w.x), bflo(w.y), bfhi(w.y)}; }
                    *(f32x4*)(PRE + o) = r * ALPHA + acc[ai][bj][m][n]; }
        } EPI_ROWS_END
    }
};
struct EpiXS {
    static constexpr bool PERM = true, AFTER_DRAIN = false;
    bf16* P; LAS unsigned char* lds;
    __device__ __forceinline__ void operator()(AccT& acc, const pg8::Unit& u, int wr, int wc, int fr, int fq) const { asm volatile("" : "+v"(fr), "+v"(fq));
        LAS float* exm = (LAS float*)(lds + EXCH_OFF); LAS float* exs = exm + 1024;
        EPI_ROWS_BEGIN {
            float mx = -3.0e38f;
#pragma unroll
            for (int bj = 0; bj < 2; ++bj)
#pragma unroll
                for (int n = 0; n < 2; ++n) { const f32x4 x = acc[ai][bj][m][n]; mx = fmaxf(mx, fmaxf(fmaxf(x[0], x[1]), fmaxf(x[2], x[3]))); }
            mx = fmaxf(mx, __shfl_xor(mx, 16)); mx = fmaxf(mx, __shfl_xor(mx, 32));
            if (fq == 0) exm[rt * 4 + wc] = mx;
        } EPI_ROWS_END
        asm volatile("s_waitcnt lgkmcnt(0)" ::: "memory"); __builtin_amdgcn_s_barrier(); asm volatile("" ::: "memory");
        EPI_ROWS_BEGIN {
            const f32x4 mm = *(const LAS f32x4*)(exm + rt * 4); const float M = fmaxf(fmaxf(mm[0], mm[1]), fmaxf(mm[2], mm[3])); float s = 0.f;
#pragma unroll
            for (int bj = 0; bj < 2; ++bj)
#pragma unroll
                for (int n = 0; n < 2; ++n) { f32x4 x = acc[ai][bj][m][n];
#pragma unroll
                    for (int j = 0; j < 4; ++j) { x[j] = __builtin_amdgcn_exp2f(x[j] - M); s += x[j]; }
                    acc[ai][bj][m][n] = x; }
            s += __shfl_xor(s, 16); s += __shfl_xor(s, 32);
            if (fq == 0) exs[rt * 4 + wc] = s;
        } EPI_ROWS_END
        asm volatile("s_waitcnt lgkmcnt(0)" ::: "memory"); __builtin_amdgcn_s_barrier(); asm volatile("" ::: "memory");
        const int cb = (u.pn & 3) * 256 + wc * 32 + 8 * fq;
        EPI_ROWS_BEGIN {
            const f32x4 ss = *(const LAS f32x4*)(exs + rt * 4); const float inv = __builtin_amdgcn_rcpf((ss[0] + ss[1]) + (ss[2] + ss[3]));
            bf16* rowp = P + (size_t)(u.pm * 256 + rt) * DM + cb;
#pragma unroll
            for (int bj = 0; bj < 2; ++bj) *(u32x4*)(rowp + bj * 128) = pack8(acc[ai][bj][m][0] * inv, acc[ai][bj][m][1] * inv);
        } EPI_ROWS_END
    }
};
struct EpiSC {
    static constexpr bool PERM = false, AFTER_DRAIN = false;
    float* SCLO; float* SCHI;
    __device__ __forceinline__ void operator()(AccT& acc, const pg8::Unit& u, int wr, int wc, int fr, int fq) const { asm volatile("" : "+v"(fr), "+v"(fq));
        float* base = (u.pn < 4 ? SCLO : SCHI) + (u.pn & 3) * 256 + wc * 32 + 4 * fq;
        EPI_ROWS_BEGIN {
            float* rowp = base + (size_t)(u.pm * 256 + rt) * 1024;
#pragma unroll
            for (int bj = 0; bj < 2; ++bj)
#pragma unroll
                for (int n = 0; n < 2; ++n) *(f32x4*)(rowp + bj * 128 + n * 16) = acc[ai][bj][m][n];
        } EPI_ROWS_END
    }
};
struct EpiK2V2 {
    static constexpr bool PERM = true, AFTER_DRAIN = false;
    bf16* O;
    __device__ __forceinline__ void operator()(AccT& acc, const pg8::Unit& u, int wr, int wc, int fr, int fq) const { asm volatile("" : "+v"(fr), "+v"(fq));
        const int b = u.pm, kv = u.pn >> 2, h = u.pn & 3;
        EPI_ROWS_BEGIN {
            bf16* rowp = O + ((size_t)(((kv * 2 + b) * 4 + h) * 256 + rt)) * 256 + wc * 32 + 8 * fq;
#pragma unroll
            for (int bj = 0; bj < 2; ++bj) *(u32x4*)(rowp + bj * 128) = pack8(acc[ai][bj][m][0], acc[ai][bj][m][1]);
        } EPI_ROWS_END
    }
};
struct EpiMb {
    static constexpr bool PERM = true, AFTER_DRAIN = false;
    bf16* O;
    __device__ __forceinline__ void operator()(AccT& acc, const pg8::Unit& u, int wr, int wc, int fr, int fq) const { asm volatile("" : "+v"(fr), "+v"(fq));
        const int b = u.pm >> 2, h = u.pm & 3, kt = u.pn & 3;
        EPI_ROWS_BEGIN {
            bf16* rowp = O + ((size_t)(b * 1024 + h * 256 + rt)) * 1024 + kt * 256 + wc * 32 + 8 * fq;
#pragma unroll
            for (int bj = 0; bj < 2; ++bj) *(u32x4*)(rowp + bj * 128) = pack8(acc[ai][bj][m][0] * XSC, acc[ai][bj][m][1] * XSC);
        } EPI_ROWS_END
    }
};
struct EpiVOT {
    static constexpr bool PERM = true, AFTER_DRAIN = false;
    bf16* O;
    __device__ __forceinline__ void operator()(AccT& acc, const pg8::Unit& u, int wr, int wc, int fr, int fq) const { asm volatile("" : "+v"(fr), "+v"(fq));
        const int h = u.pm >> 2, ct = u.pm & 3, b = u.pn >> 2;
        EPI_ROWS_BEGIN {
            bf16* rowp = O + ((size_t)(b * 1024 + ct * 256 + rt)) * 1024 + h * 256 + wc * 32 + 8 * fq;
#pragma unroll
            for (int bj = 0; bj < 2; ++bj) *(u32x4*)(rowp + bj * 128) = pack8(acc[ai][bj][m][0], acc[ai][bj][m][1]);
        } EPI_ROWS_END
    }
};
struct EpiWsc {
    static constexpr bool PERM = true, AFTER_DRAIN = false;
    bf16* O;
    __device__ __forceinline__ void operator()(AccT& acc, const pg8::Unit& u, int wr, int wc, int fr, int fq) const { asm volatile("" : "+v"(fr), "+v"(fq));
        const int hh = u.pn >> 2, kt = u.pn & 3;
#pragma unroll
        for (int m = 0; m < 4; ++m) { const int key = wr * 64 + m * 16 + fr;
            bf16* rowp = O + ((size_t)(hh * 128 + key)) * 1024 + kt * 256 + wc * 32 + 8 * fq;
#pragma unroll
            for (int bj = 0; bj < 2; ++bj) *(u32x4*)(rowp + bj * 128) = pack8(acc[0][bj][m][0], acc[0][bj][m][1]); }
    }
};
}
namespace att {
typedef unsigned short bf16;
typedef short bf16x8 __attribute__((ext_vector_type(8)));
typedef short s16x4 __attribute__((ext_vector_type(4)));
typedef float f32x16 __attribute__((ext_vector_type(16)));
typedef float f32x4 __attribute__((ext_vector_type(4)));
typedef unsigned u32x4 __attribute__((ext_vector_type(4)));
constexpr int DQ = 96, DV = 64, NW = 8, QBLK = 32, KVBLK = 64, QB = NW * QBLK, SEQ = 8192, OPITCH = 512;
constexpr int SHM_V = 16384, SHM_K = 16384;
constexpr int LDS_BYTES = 2 * SHM_V + 2 * SHM_K + NW * 64 * 4;
constexpr float THR = 8.f;
constexpr unsigned WBIG = 0x7fffffffu;

#define KSWZ(row, colB) ((row) * 256 + ((colB) ^ (((row) & 7) << 4)))
#define SBAR() __builtin_amdgcn_sched_barrier(0)
__device__ __forceinline__ int v_st(int k, int c) { const int kk = (k & ~0xC) | ((k & 4) << 1) | ((k & 8) >> 1); return ((kk >> 3) * 4 + (c >> 5)) * 512 + ((kk & 7) * 32 + (c & 31)) * 2; }
__device__ __forceinline__ int v_rd_base(int lane) { return ((lane & 3) << 3) | (((lane >> 2) & 3) << 6) | (((lane >> 4) & 1) << 5) | (((lane >> 5) & 1) << 8); }
constexpr int v_rd_off(int d0, int ks, int half) { return d0 * 512 + ks * 4096 + half * 2048; }
__device__ __forceinline__ int crow(int r, int hi) { return (r & 3) + 8 * (r >> 2) + 4 * hi; }
__device__ __forceinline__ unsigned cvtpk(float lo, float hi) { unsigned r; asm volatile("v_cvt_pk_bf16_f32 %0, %1, %2" : "=v"(r) : "v"(lo), "v"(hi)); return r; }

__device__ __forceinline__ void mask_tile(f32x16& p0, f32x16& p1, int dq, unsigned W) {
    const float NEG = -__builtin_inff();
#pragma unroll
    for (int r = 0; r < 16; ++r) {
        const int c = (r & 3) + 8 * (r >> 2);
        if ((unsigned)(dq - c) >= W) p0[r] = NEG;
        if ((unsigned)(dq - c - 32) >= W) p1[r] = NEG;
    }
}
__device__ __forceinline__ void partialSM(f32x16& p0, f32x16& p1, float& m_reg, float& mn, float& alpha) {
    float pmax = p0[0];
#pragma unroll
    for (int r = 1; r < 16; ++r) pmax = fmaxf(pmax, p0[r]);
#pragma unroll
    for (int r = 0; r < 16; ++r) pmax = fmaxf(pmax, p1[r]);
    { auto rr = __builtin_amdgcn_permlane32_swap(__float_as_uint(pmax), __float_as_uint(pmax), false, false);
      pmax = fmaxf(__uint_as_float(rr[0]), __uint_as_float(rr[1])); }
    if (__builtin_expect(__all((pmax - m_reg) <= THR), 1)) { mn = m_reg; alpha = 1.f; }
    else { mn = fmaxf(m_reg, pmax); alpha = __builtin_amdgcn_exp2f(m_reg - mn); m_reg = mn; }
#pragma unroll
    for (int r = 0; r < 16; ++r) p0[r] = p0[r] - mn;
#pragma unroll
    for (int r = 0; r < 16; ++r) p1[r] = p1[r] - mn;
#pragma unroll
    for (int r = 0; r < 16; ++r) p0[r] = __builtin_amdgcn_exp2f(p0[r]);
}
__device__ __forceinline__ void finishSM(f32x16& p0, f32x16& p1, float alpha, float& l_reg, bf16x8& pa0, bf16x8& pa1, bf16x8& pa2, bf16x8& pa3) {
#pragma unroll
    for (int r = 0; r < 16; ++r) p1[r] = __builtin_amdgcn_exp2f(p1[r]);
    float ps = 0;
#pragma unroll
    for (int r = 0; r < 16; ++r) ps += p0[r];
#pragma unroll
    for (int r = 0; r < 16; ++r) ps += p1[r];
    { auto rr = __builtin_amdgcn_permlane32_swap(__float_as_uint(ps), __float_as_uint(ps), false, false);
      ps = __uint_as_float(rr[0]) + __uint_as_float(rr[1]); }
    l_reg = l_reg * alpha + ps;
#define PK4(P, B_, OUT) do { unsigned a0 = cvtpk(P[B_+0], P[B_+1]), a1 = cvtpk(P[B_+2], P[B_+3]);                          \
        unsigned b0 = cvtpk(P[B_+4], P[B_+5]), b1 = cvtpk(P[B_+6], P[B_+7]);                                             \
        auto r0 = __builtin_amdgcn_permlane32_swap(a0, b0, false, false); auto r1 = __builtin_amdgcn_permlane32_swap(a1, b1, false, false); \
        u32x4 w = {r0[0], r1[0], r0[1], r1[1]}; OUT = *reinterpret_cast<bf16x8*>(&w); } while (0)
    PK4(p0, 0, pa0); PK4(p0, 8, pa1); PK4(p1, 0, pa2); PK4(p1, 8, pa3);
#undef PK4
}
template <int KB>
__device__ __forceinline__ void qkt(f32x16& p0, f32x16& p1, const char* K_lds, int r32, int hi, const bf16x8* qr) {
    p0 = f32x16{}; p1 = f32x16{};
    const char* kb[4];
#pragma unroll
    for (int dd = 0; dd < 4; ++dd) kb[dd] = K_lds + KB * SHM_K + KSWZ(r32, (dd * 16 + hi * 8) * 2);
#pragma unroll
    for (int d0 = 0; d0 < 6; ++d0) { const char* a = kb[d0 & 3] + (d0 >> 2) * 128;
        bf16x8 b0 = *reinterpret_cast<const bf16x8*>(a);
        bf16x8 b1 = *reinterpret_cast<const bf16x8*>(a + 32 * 256);
        p0 = __builtin_amdgcn_mfma_f32_32x32x16_bf16(b0, qr[d0], p0, 0, 0, 0);
        p1 = __builtin_amdgcn_mfma_f32_32x32x16_bf16(b1, qr[d0], p1, 0, 0, 0); }
}
template <int VB>
__device__ __forceinline__ void pv_tile(f32x16* o, int vb0, bf16x8 pa0, bf16x8 pa1, bf16x8 pa2, bf16x8 pa3) {
#define TRRD(dst, off) asm volatile("ds_read_b64_tr_b16 %0, %1 offset:%2" : "=&v"(dst) : "v"(vb0), "i"(off) : "memory")
#define PV_D0(d0) do { s16x4 l0, l1, l2, l3, h0, h1, h2, h3; constexpr int b_ = VB * SHM_V + v_rd_off(d0, 0, 0); \
        TRRD(l0, b_); TRRD(h0, b_ + 2048); TRRD(l1, b_ + 4096); TRRD(h1, b_ + 6144); TRRD(l2, b_ + 8192); TRRD(h2, b_ + 10240); TRRD(l3, b_ + 12288); TRRD(h3, b_ + 14336); \
        asm volatile("s_waitcnt lgkmcnt(0)" ::: "memory"); SBAR(); \
        o[d0] = __builtin_amdgcn_mfma_f32_32x32x16_bf16(pa0, (bf16x8){l0[0], l0[1], l0[2], l0[3], h0[0], h0[1], h0[2], h0[3]}, o[d0], 0, 0, 0);   \
        o[d0] = __builtin_amdgcn_mfma_f32_32x32x16_bf16(pa1, (bf16x8){l1[0], l1[1], l1[2], l1[3], h1[0], h1[1], h1[2], h1[3]}, o[d0], 0, 0, 0);   \
        o[d0] = __builtin_amdgcn_mfma_f32_32x32x16_bf16(pa2, (bf16x8){l2[0], l2[1], l2[2], l2[3], h2[0], h2[1], h2[2], h2[3]}, o[d0], 0, 0, 0);   \
        o[d0] = __builtin_amdgcn_mfma_f32_32x32x16_bf16(pa3, (bf16x8){l3[0], l3[1], l3[2], l3[3], h3[0], h3[1], h3[2], h3[3]}, o[d0], 0, 0, 0); } while (0)
    PV_D0(0); PV_D0(1);
#undef PV_D0
#undef TRRD
}

struct BlockRef { const bf16* Q; const bf16* K; const bf16* V; bf16* O; int P0; };
struct Seam { bf16x8 qr[6]; bf16x8 st_v0, st_k0, st_k1; };
#define KROW(p, k0, rr) ((p) + (size_t)((k0) + (rr)) * DQ + scl)
#define VROW(p, k0) ((p) + (size_t)((k0) + vr) * DV + vc)
#define VMW() asm volatile("s_waitcnt vmcnt(0)" ::: "memory")
#define VMWN(n) asm volatile("s_waitcnt vmcnt(%0)" :: "i"(n) : "memory")
#define SLOAD_H(Kp, Vp, k0) do { S.st_v0 = *reinterpret_cast<const bf16x8*>(VROW(Vp, k0)); \
                         S.st_k0 = *reinterpret_cast<const bf16x8*>(KROW(Kp, k0, sr)); S.st_k1 = *reinterpret_cast<const bf16x8*>(KROW(Kp, k0, 32 + sr)); } while (0)
#define SWRITE_HK(bf) do { *(bf16x8*)(K_lds + (bf) * SHM_K + kws) = S.st_k0; *(bf16x8*)(K_lds + (bf) * SHM_K + kws + 32 * 256) = S.st_k1; } while (0)
#define SWRITE_HV(bf) do { *(bf16x8*)(V_lds + (bf) * SHM_V + vst0) = S.st_v0; } while (0)
#define SWRITE_H(bf) do { SWRITE_HV(bf); SWRITE_HK(bf); } while (0)
__device__ __forceinline__ void attn_prime(const BlockRef& cur, char* lds, Seam& S) {
    int tid_ = threadIdx.x; asm volatile("" : "+v"(tid_)); const int tid = tid_, wid = __builtin_amdgcn_readfirstlane(tid >> 6), lane = tid & 63, r32 = lane & 31, hi = lane >> 5;
    const int sr = tid >> 4, sc = (tid & 15) * 8, scl = sc < DQ ? sc : DQ - 8, kws = KSWZ(sr, sc * 2), vr = tid >> 3, vc = (tid & 7) * 8; char* K_lds = lds + 2 * SHM_V;
#pragma unroll
    for (int d0 = 0; d0 < 6; ++d0) S.qr[d0] = *reinterpret_cast<const bf16x8*>(cur.Q + (size_t)(wid * QBLK + r32) * DQ + d0 * 16 + hi * 8);
    SLOAD_H(cur.K, cur.V, 0); VMW(); SWRITE_HK(0);
    __syncthreads();
}
__device__ __forceinline__ void attn_block(const BlockRef& cur, const BlockRef& nxt, char* lds, Seam& S) {
    int tid_ = threadIdx.x; asm volatile("" : "+v"(tid_)); const int tid = tid_, wid = __builtin_amdgcn_readfirstlane(tid >> 6), lane = tid & 63, r32 = lane & 31, hi = lane >> 5;
    const int NT = (cur.P0 + QB - 1) / KVBLK + 1;
    const int qlo = cur.P0 + wid * QBLK, qm = qlo + r32 - 4 * hi;
    char* V_lds = lds; char* K_lds = lds + 2 * SHM_V;
    float* ws = (float*)(lds + 2 * SHM_V + 2 * SHM_K) + wid * 64; float* li_l = ws, * al_l = ws + 32;
    float m_reg = -1e30f, l_reg = 0; f32x16 o[2] = {};
    const int sr = tid >> 4, sc = (tid & 15) * 8, scl = sc < DQ ? sc : DQ - 8, kws = KSWZ(sr, sc * 2), vr = tid >> 3, vc = (tid & 7) * 8, vst0 = v_st(vr, vc);
    const int vb0 = (int)(uintptr_t)V_lds + v_rd_base(lane);
    const bf16* Kh = cur.K; const bf16* Vh = cur.V;
#define RESC(a) do { if (__any((a) < 1.f)) { if (hi == 0) al_l[r32] = (a); asm volatile("s_waitcnt lgkmcnt(0)" ::: "memory");              \
                     _Pragma("unroll") for (int d_ = 0; d_ < 2; ++d_) _Pragma("unroll") for (int r = 0; r < 16; ++r) o[d_][r] *= al_l[crow(r, hi)]; } } while (0)
#define KBASE(t) ((t) * KVBLK)
#define MASKT(P0_, P1_, t) do { const int kb_ = KBASE(t); if (kb_ + KVBLK - 1 > qlo) mask_tile(P0_, P1_, qm - kb_, WBIG); } while (0)
    constexpr int NQL = 6;
#define SEAM_K0() do { VMWN(NQL); SWRITE_HK(0); SBAR(); } while (0)
    f32x16 pA0, pA1, pB0, pB1; float mnA, mnB, alA, alB; bf16x8 pa0, pa1, pa2, pa3;
    SWRITE_HV(0); SBAR();
    SLOAD_H(Kh, Vh, KBASE(1));
    SBAR(); qkt<0>(pA0, pA1, K_lds, r32, hi, S.qr);
    MASKT(pA0, pA1, 0); partialSM(pA0, pA1, m_reg, mnA, alA);
    VMW(); SWRITE_H(1);
    __syncthreads();
#define HALF_STEP(PX0, PX1, mnX, alX, PY0, PY1, alY, t, KB, VB, SB) do {                                                      \
        SBAR(); qkt<KB>(PX0, PX1, K_lds, r32, hi, S.qr);                                                                      \
        finishSM(PY0, PY1, alY, l_reg, pa0, pa1, pa2, pa3); SBAR();                                                           \
        if ((t) + 1 < NT) { SLOAD_H(Kh, Vh, KBASE((t) + 1)); SBAR(); }                                                        \
        pv_tile<VB>(o, vb0, pa0, pa1, pa2, pa3); MASKT(PX0, PX1, (t)); partialSM(PX0, PX1, m_reg, mnX, alX);                  \
        __syncthreads();                                                                                                      \
        if ((t) + 1 < NT) { VMW(); SWRITE_H(SB); }                                                                            \
        RESC(alX); __syncthreads(); } while (0)
    for (int t = 1; t + 1 < NT; t += 2) {
        HALF_STEP(pB0, pB1, mnB, alB, pA0, pA1, alA, t, 1, 0, 0);
        HALF_STEP(pA0, pA1, mnA, alA, pB0, pB1, alB, t + 1, 0, 1, 1);
    }
    SBAR(); qkt<1>(pB0, pB1, K_lds, r32, hi, S.qr); SBAR();
    SLOAD_H(nxt.K, nxt.V, 0); SBAR();
#pragma unroll
    for (int d0 = 0; d0 < 6; ++d0) S.qr[d0] = *reinterpret_cast<const bf16x8*>(nxt.Q + (size_t)(wid * QBLK + r32) * DQ + d0 * 16 + hi * 8);
    SBAR();
    finishSM(pA0, pA1, alA, l_reg, pa0, pa1, pa2, pa3); SBAR();
    pv_tile<0>(o, vb0, pa0, pa1, pa2, pa3);
    MASKT(pB0, pB1, NT - 1); partialSM(pB0, pB1, m_reg, mnB, alB); __syncthreads(); RESC(alB);
    finishSM(pB0, pB1, alB, l_reg, pa0, pa1, pa2, pa3); SBAR(); pv_tile<1>(o, vb0, pa0, pa1, pa2, pa3);
    SBAR(); SEAM_K0();
    if (hi == 0) li_l[r32] = l_reg; asm volatile("s_waitcnt lgkmcnt(0)" ::: "memory");
    float rli[16];
#pragma unroll
    for (int r = 0; r < 16; ++r) rli[r] = __builtin_amdgcn_rcpf(li_l[crow(r, hi)]);
    bf16* Ow = cur.O + (size_t)(wid * QBLK) * OPITCH;
#pragma unroll
    for (int r = 0; r < 16; ++r) { const int orow = crow(r, hi);
#pragma unroll
        for (int d0 = 0; d0 < 2; ++d0) { const float v = o[d0][r] * rli[r]; const float vn = __shfl_xor(v, 1);
            if ((r32 & 1) == 0) *(unsigned*)(Ow + (size_t)orow * OPITCH + d0 * 32 + r32) = cvtpk(v, vn); } }
    __syncthreads();
#undef RESC
#undef KBASE
#undef MASKT
#undef SEAM_K0
#undef HALF_STEP
}
#undef KROW
#undef VROW
#undef VMW
#undef VMWN
#undef SLOAD_H
#undef SWRITE_HK
#undef SWRITE_HV
#undef SWRITE_H
#undef KSWZ
#undef SBAR
}
using namespace mk;
typedef __attribute__((address_space(1))) unsigned gu32;
#define RLX_AGENT __ATOMIC_RELAXED, __HIP_MEMORY_SCOPE_AGENT
#define LDS_WAIT() asm volatile("s_waitcnt lgkmcnt(0)" ::: "memory")
#define VM_WAIT() asm volatile("s_waitcnt vmcnt(0)" ::: "memory")
constexpr int NWAVES = 8, NPH = 16;

#define XB_TMO      128
#define XB_XCNT(j)  (256  + 64 * (j))
#define XB_XSUB(j)  (1280 + 64 * (j))
#define XB_XGEN(j)  (2304 + 64 * (j))
#define XB_TOP      3328
#define XB_TOPGEN   3392
#define XCD_BAR_WORDS 3456
#define XB_SPIN_CAP (1u << 18)

__device__ __forceinline__ unsigned xb_ld(unsigned* p)              { return __hip_atomic_load(p, __ATOMIC_RELAXED, __HIP_MEMORY_SCOPE_AGENT); }
__device__ __forceinline__ unsigned xb_add(unsigned* p, unsigned v) { return __hip_atomic_fetch_add(p, v, __ATOMIC_RELAXED, __HIP_MEMORY_SCOPE_AGENT); }
__device__ __forceinline__ unsigned xb_xcc_id() { return (unsigned)__builtin_amdgcn_s_getreg((3 << 11) | 20) & 0xFu; }
#define XB_SPIN(cond, bar) do { unsigned _sp = 0; while (cond) { __builtin_amdgcn_s_sleep(1); \
    if ((++_sp & 255u) == 0u) { if (xb_ld(&(bar)[XB_TMO])) break; if (_sp > XB_SPIN_CAP) { atomicAdd(&(bar)[XB_TMO], 1u); break; } } } } while (0)

struct XcdBarrier {
    unsigned* bar; unsigned x;
    volatile LAS unsigned* st;
};

__device__ __forceinline__ XcdBarrier xcd_barrier_post(unsigned* bar, volatile LAS unsigned* st) {
    XcdBarrier b; b.bar = bar; b.x = xb_xcc_id(); b.st = st;
    if (threadIdx.x == 0) (void)xb_add(&bar[XB_XCNT(b.x)], 1u);
    return b;
}
__device__ __forceinline__ void xcd_barrier_complete(unsigned* bar, unsigned x, unsigned& nloc, unsigned& nx) {
    const unsigned G = gridDim.x * gridDim.y * gridDim.z;
    unsigned sum, cnt, mine, sp = 0u;
    for (;;) {
        sum = 0u; cnt = 0u; mine = 0u;
#pragma unroll
        for (unsigned j = 0; j < 16; ++j) { const unsigned c = xb_ld(&bar[XB_XCNT(j)]); sum += c; cnt += (c > 0u) ? 1u : 0u; mine = (j == x) ? c : mine; }
        if (sum == G) break;
        __builtin_amdgcn_s_sleep(1);
        if ((++sp & 255u) == 0u) { if (xb_ld(&bar[XB_TMO])) break; if (sp > XB_SPIN_CAP) { atomicAdd(&bar[XB_TMO], 1u); break; } }
    }
    nloc = mine > 0u ? mine : 1u; nx = cnt > 0u ? cnt : 1u;
}

__device__ __forceinline__ void xcd_barrier(const XcdBarrier& b) {
    asm volatile("s_waitcnt vmcnt(0)" ::: "memory");
    __syncthreads();
    if (threadIdx.x == 0) {
        unsigned* bar = b.bar;
        __builtin_amdgcn_s_waitcnt(0);
        unsigned nloc = b.st[0], nx = b.st[1];
        if (nloc == 0u) { xcd_barrier_complete(bar, b.x, nloc, nx); b.st[0] = nloc; b.st[1] = nx; }
        const unsigned old = xb_add(&bar[XB_XSUB(b.x)], 1u);
        const unsigned gen = old / nloc;
        if (old + 1u == (gen + 1u) * nloc) {
            __builtin_amdgcn_fence(__ATOMIC_RELEASE, "agent");
            asm volatile("s_waitcnt vmcnt(0)" ::: "memory");
            const unsigned og = xb_add(&bar[XB_TOP], 1u);
            const unsigned tg = og / nx;
            if (og + 1u == (tg + 1u) * nx) xb_add(&bar[XB_TOPGEN], 1u);
            else XB_SPIN(xb_ld(&bar[XB_TOPGEN]) == tg, bar);
            __builtin_amdgcn_fence(__ATOMIC_ACQUIRE, "agent");
            xb_add(&bar[XB_XGEN(b.x)], 1u);
            asm volatile("s_waitcnt vmcnt(0)" ::: "memory");
        } else {
            XB_SPIN(xb_ld(&bar[XB_XGEN(b.x)]) == gen, bar);
            __builtin_amdgcn_fence(__ATOMIC_ACQUIRE, "agent");
            asm volatile("s_waitcnt vmcnt(0)" ::: "memory");
        }
    }
    __syncthreads();
}


struct Args { const void* in[36]; float* out; unsigned char* ws; int ph_lo, ph_hi; };
typedef const __attribute__((address_space(4))) Args* KArgs;
__device__ __forceinline__ KArgs kargs() { KArgs p = (KArgs)__builtin_amdgcn_kernarg_segment_ptr(); asm volatile("" : "+s"(p)); return p; }
struct Frame {
    LAS unsigned char* lds; unsigned char* ws; unsigned char* ob;
    unsigned* ctl; int tid, lane, wave, vcu, G, gw, ngw;
    __device__ __forceinline__ void refresh() { int t = threadIdx.x; asm volatile("" : "+v"(t)); tid = t; lane = t & 63; wave = __builtin_amdgcn_readfirstlane(t >> 6); gw = vcu * 8 + wave; }
};

__device__ __forceinline__ float wave_sum(float v) {
#pragma unroll
    for (int o = 1; o < 64; o <<= 1) v += __shfl_xor(v, o);
    return v;
}
__device__ __forceinline__ unsigned pk2(float lo, float hi) { return cvtpk(lo, hi); }

__device__ __forceinline__ int ropeperm(int n) { const int b = n >> 3, j = n & 7; return j < 4 ? 4 * b + j : 16 + 4 * b + (j - 4); }
__device__ __forceinline__ void tr_item(const float* W, int ldw, int k0, int scol0, bf16* WT, int ldt, int drow0, const float* kscale, bool perm, LAS float* scr, int lane) {
#pragma unroll 8
    for (int i = 0; i < 32; ++i) { const int kk = 2 * i + (lane >> 5); const float sc = kscale ? kscale[k0 + kk] : 1.0f;
        scr[kk * 33 + (lane & 31)] = W[(size_t)(k0 + kk) * ldw + scol0 + (lane & 31)] * sc; }
    LDS_WAIT(); asm volatile("" ::: "memory");
    const int c = lane & 7;
#pragma unroll
    for (int j = 0; j < 4; ++j) { const int n = (lane >> 3) + 8 * j, ns = perm ? ropeperm(n) : n; const LAS float* s = scr + (8 * c) * 33 + ns;
        u32x4 o; o.x = pk2(s[0 * 33], s[1 * 33]); o.y = pk2(s[2 * 33], s[3 * 33]); o.z = pk2(s[4 * 33], s[5 * 33]); o.w = pk2(s[6 * 33], s[7 * 33]);
        *(u32x4*)(WT + (size_t)(drow0 + n) * ldt + k0 + 8 * c) = o; }
    LDS_WAIT(); asm volatile("" ::: "memory");
}
__device__ __forceinline__ void ssm_precompute(const Frame& F, KArgs A, int g) {
    const float* lam_re = (const float*)A->in[8] + g * 64; const float* lam_im = (const float*)A->in[9] + g * 64; const float dt = expf(((const float*)A->in[10])[g]);
    const float* b_re = (const float*)A->in[11] + g * 1024; const float* b_im = (const float*)A->in[12] + g * 1024;
    const float* c_re = (const float*)A->in[13] + g * 1024; const float* c_im = (const float*)A->in[14] + g * 1024;
    const float* dsk = (const float*)A->in[15] + g * 16;
    LAS float* apr = (LAS float*)F.lds; LAS float* api = apr + 33 * 64; LAS float* bbr = api + 33 * 64; LAS float* bbi = bbr + 1024;
    LAS float* crs = bbi + 1024; LAS float* cis = crs + 1024; LAS float* Kt = cis + 1024;
    const int tid = F.tid;
    for (int e = tid; e < 33 * 64; e += 512) { const int m = e >> 6, p = e & 63; const float lr = lam_re[p], li = lam_im[p];
        const float mag = expf(lr * dt * (float)m); float sn, cs; sincosf(li * dt * (float)m, &sn, &cs); apr[e] = mag * cs; api[e] = mag * sn; }
    for (int e = tid; e < 1024; e += 512) { crs[e] = c_re[e]; cis[e] = c_im[e]; }
    __syncthreads();
    for (int e = tid; e < 1024; e += 512) { const int p = e >> 4; const float lr = lam_re[p], li = lam_im[p], den = lr * lr + li * li;
        const float nr = apr[64 + p] - 1.0f, ni = api[64 + p]; const float fr_ = (nr * lr + ni * li) / den, fi_ = (ni * lr - nr * li) / den;
        const float br = b_re[e], bi = b_im[e]; bbr[e] = fr_ * br - fi_ * bi; bbi[e] = fr_ * bi + fi_ * br; }
    __syncthreads();
    { const int m = tid >> 4, h = tid & 15;
      f32x4 s0 = {0.f, 0.f, 0.f, 0.f}, s1 = s0, s2 = s0, s3 = s0;
      for (int p = 0; p < 64; ++p) { const float cr = crs[h * 64 + p], ci = cis[h * 64 + p], ar = apr[m * 64 + p], ai = api[m * 64 + p];
          const float er = cr * ar - ci * ai, ei = cr * ai + ci * ar;
          const LAS f32x4* br4 = (const LAS f32x4*)(bbr + p * 16); const LAS f32x4* bi4 = (const LAS f32x4*)(bbi + p * 16);
          s0 += br4[0] * er - bi4[0] * ei; s1 += br4[1] * er - bi4[1] * ei; s2 += br4[2] * er - bi4[2] * ei; s3 += br4[3] * er - bi4[3] * ei; }
      if (m == 0) { const float dv = dsk[h]; if (h < 4) s0[h] += dv; else if (h < 8) s1[h - 4] += dv; else if (h < 12) s2[h - 8] += dv; else s3[h - 12] += dv; }
      LAS f32x4* ko = (LAS f32x4*)(Kt + m * 256 + h * 16); ko[0] = s0; ko[1] = s1; ko[2] = s2; ko[3] = s3; }
    __syncthreads();
    bf16* TH = (bf16*)(F.ws + W_TH) + (size_t)g * 512 * 640; bf16* GM = (bf16*)(F.ws + W_GM) + (size_t)g * 256 * 640;
    for (int e = tid; e < 512 * 64; e += 512) { const int n = e >> 6, cg = e & 63, i = n >> 4, h = n & 15, j = cg >> 1, h0 = (cg & 1) * 8; u32x4 o = {0u, 0u, 0u, 0u};
        if (j <= i) { const LAS float* k = Kt + (i - j) * 256 + h * 16 + h0; o.x = pk2(k[0], k[1]); o.y = pk2(k[2], k[3]); o.z = pk2(k[4], k[5]); o.w = pk2(k[6], k[7]); }
        *(u32x4*)(TH + (size_t)n * 640 + cg * 8) = o; }
    for (int e = tid; e < 512 * 16; e += 512) { const int n = e >> 4, cg = e & 15, i = n >> 4, h = n & 15; float v[8];
#pragma unroll
        for (int q = 0; q < 8; ++q) { const int sidx = cg * 8 + q, p = sidx & 63; const float cr = crs[h * 64 + p], ci = cis[h * 64 + p], ar = apr[(i + 1) * 64 + p], ai = api[(i + 1) * 64 + p];
            v[q] = sidx < 64 ? (cr * ar - ci * ai) : -(cr * ai + ci * ar); }
        u32x4 o; o.x = pk2(v[0], v[1]); o.y = pk2(v[2], v[3]); o.z = pk2(v[4], v[5]); o.w = pk2(v[6], v[7]);
        *(u32x4*)(TH + (size_t)n * 640 + 512 + cg * 8) = o; }
    for (int e = tid; e < 256 * 80; e += 512) { const int n = e / 80, cg = e - n * 80; u32x4 o = {0u, 0u, 0u, 0u};
        if (n < 128 && cg < 64) { const int p = n & 63, im = n >> 6, j = cg >> 1, h0 = (cg & 1) * 8; const float ar = apr[(31 - j) * 64 + p], ai = api[(31 - j) * 64 + p]; float v[8];
#pragma unroll
            for (int q = 0; q < 8; ++q) { const float br = bbr[p * 16 + h0 + q], bi = bbi[p * 16 + h0 + q]; v[q] = im ? (ar * bi + ai * br) : (ar * br - ai * bi); }
            o.x = pk2(v[0], v[1]); o.y = pk2(v[2], v[3]); o.z = pk2(v[4], v[5]); o.w = pk2(v[6], v[7]); }
        *(u32x4*)(GM + (size_t)n * 640 + cg * 8) = o; }
    __syncthreads();
}
__device__ __forceinline__ void cvt_row1024(const float* src, bf16* dst, int lane) {
#pragma unroll
    for (int j = 0; j < 4; ++j) { const f32x4 v = *(const f32x4*)(src + (j * 64 + lane) * 4); u32x2 o; o.x = pk2(v[0], v[1]); o.y = pk2(v[2], v[3]); *(u32x2*)(dst + (j * 64 + lane) * 4) = o; }
}
__device__ __forceinline__ void p0_prologue(const Frame& F, KArgs A) {
    const bool split = F.G >= 64; const int bx0 = (int)blockIdx.x;
    if (!split || bx0 < 32) for (int g = bx0; g < 32; g += F.G) ssm_precompute(F, A, g);
    if (split && bx0 < 32) return;
    const int igw = split ? (bx0 - 32) * NWAVES + F.wave : F.gw, ingw = split ? (F.G - 32) * NWAVES : F.ngw;
    LAS float* scr = (LAS float*)(F.lds + F.wave * 16384);
    const int lane = F.lane;
    const float* x = (const float*)A->in[0]; const float* mem = (const float*)A->in[1]; const int* pos = (const int*)A->in[2];
    const float* w_in = (const float*)A->in[3]; const float* g_cq = (const float*)A->in[4]; const float* w_uq = (const float*)A->in[5]; const float* g_ckv = (const float*)A->in[6];
    const float* w_ukv = (const float*)A->in[7]; const float* w_glu = (const float*)A->in[16]; const float* g_mla = (const float*)A->in[18]; const float* g_ssm = (const float*)A->in[19];
    const float* w_out = (const float*)A->in[20]; const float* xq = (const float*)A->in[23]; const float* xk = (const float*)A->in[24]; const float* xv = (const float*)A->in[25];
    const float* xo = (const float*)A->in[26]; const float* w_query = (const float*)A->in[29]; const float* sk1 = (const float*)A->in[30]; const float* sk2 = (const float*)A->in[31];
    bf16* WINT = (bf16*)(F.ws + W_WINT); bf16* WUQT = (bf16*)(F.ws + W_WUQT); bf16* WUKVT = (bf16*)(F.ws + W_WUKVT); bf16* WGLUT = (bf16*)(F.ws + W_WGLUT); bf16* WOUTT = (bf16*)(F.ws + W_WOUTT);
    bf16* XKVT = (bf16*)(F.ws + W_XKVT); bf16* XQH = (bf16*)(F.ws + W_XQH); bf16* XOTH = (bf16*)(F.ws + W_XOTH); bf16* WQR = (bf16*)(F.ws + W_WQR); bf16* SKP = (bf16*)(F.ws + W_SKP);
    bf16* MEMB = (bf16*)(F.ws + W_MEMB); float2* ROPE = (float2*)(F.ws + W_ROPE); bf16* XB = (bf16*)(F.ob + O_XB); bf16* UP = (bf16*)(F.ws + A_UP);
    constexpr int I0 = 37 * 16, I1 = 24 * 6, I2 = 32 * 4, I3 = 16 * 8, I4 = 32 * 16, I5 = 32 * 16, I6 = 32 * 16, I7 = 4 * 32 * 4;
    constexpr int I8 = 16384, I9 = 512, I10 = 1024, I11 = 1024, I12 = 512, I13 = 4096, I14 = 4096, I15 = 96;
    constexpr int NIT = I0 + I1 + I2 + I3 + I4 + I5 + I6 + I7 + I8 + I9 + I10 + I11 + I12 + I13 + I14 + I15;
    for (int it = igw; it < NIT; it += ingw) {
        int r = it;
        if (r < I0) { const int nb = r >> 4, kb = r & 15; tr_item(w_in, 1184, kb * 64, nb * 32, WINT, 1024, nb * 32 + (nb >= 21 ? 96 : 0), nullptr, nb == 20, scr, lane); continue; } r -= I0;
        if (r < I1) { const int nb = r / 6, kb = r - nb * 6; tr_item(w_uq, 768, kb * 64, nb * 32, WUQT, 384, nb * 32, g_cq, (nb % 3) == 2, scr, lane); continue; } r -= I1;
        if (r < I2) { const int nb = r >> 2, kb = r & 3; tr_item(w_ukv, 1024, kb * 64, nb * 32, WUKVT, 256, nb * 32, g_ckv, false, scr, lane); continue; } r -= I2;
        if (r < I3) { const int nb = r >> 3, kb = r & 7; tr_item(w_glu, 512, kb * 64, nb * 32, WGLUT, 512, nb * 32, nullptr, false, scr, lane); continue; } r -= I3;
        if (r < I4) { const int nb = r >> 4, kb = r & 15; tr_item(w_out, 1024, kb * 64, nb * 32, WOUTT, 1024, nb * 32, kb < 8 ? g_mla : g_ssm - 512, false, scr, lane); continue; } r -= I4;
        if (r < I5) { const int nb = r >> 4, kb = r & 15; tr_item(xk, 1024, kb * 64, nb * 32, XKVT, 1024, nb * 32, nullptr, false, scr, lane); continue; } r -= I5;
        if (r < I6) { const int nb = r >> 4, kb = r & 15; tr_item(xv, 1024, kb * 64, nb * 32, XKVT, 1024, 1024 + nb * 32, nullptr, false, scr, lane); continue; } r -= I6;
        if (r < I7) { const int h = r >> 7, nb = (r >> 2) & 31, kb = r & 3; tr_item(xo + (size_t)h * 256 * 1024, 1024, kb * 64, nb * 32, XOTH + (size_t)h * 1024 * 256, 256, nb * 32, nullptr, false, scr, lane); continue; } r -= I7;
        if (r < I8) { cvt_row1024(x + (size_t)r * 1024, XB + (size_t)r * 1024, lane); continue; } r -= I8;
        if (r < I9) { cvt_row1024(mem + (size_t)r * 1024, MEMB + (size_t)r * 1024, lane); continue; } r -= I9;
        if (r < I10) {
#pragma unroll
            for (int j = 0; j < 4; ++j) { const int e = (j * 64 + lane) * 4, h = e >> 8, jj = e & 255; const f32x4 v = *(const f32x4*)(xq + (size_t)r * 1024 + e);
                u32x2 o; o.x = pk2(v[0], v[1]); o.y = pk2(v[2], v[3]); *(u32x2*)(XQH + ((size_t)h * 1024 + r) * 256 + jj) = o; }
            continue; } r -= I10;
        if (r < I11) {
#pragma unroll
            for (int j = 0; j < 8; ++j) { const int e = (j * 64 + lane) * 4, hh = e >> 7, d = e & 127; const f32x4 v = *(const f32x4*)(w_query + (size_t)r * 2048 + e);
                u32x2 o; o.x = pk2(v[0], v[1]); o.y = pk2(v[2], v[3]); bf16* dp = WQR + ((size_t)hh * 1024 + r) * 256 + d; *(u32x2*)dp = o; *(u32x2*)(dp + 128) = (u32x2){0u, 0u}; }
            continue; } r -= I11;
        if (r < I12) { const int half = r >> 8, key = r & 255, d = lane * 4; u32x2 o = {0u, 0u};
            if (key < 128 && d < 128) { const f32x4 v = *(const f32x4*)((half ? sk2 : sk1) + key * 128 + d); o.x = pk2(v[0], v[1]); o.y = pk2(v[2], v[3]); }
            *(u32x2*)(SKP + ((size_t)half * 256 + key) * 256 + d) = o; continue; } r -= I12;
        if (r < I13) { const int t = r * 4 + (lane >> 4), i = lane & 15; const float fq_ = exp2f(-(float)i * (13.287712379549449f / 16.0f));
            const float ang = (float)pos[t] * fq_; float sn, cs; sincosf(ang, &sn, &cs); ROPE[(size_t)t * 16 + i] = make_float2(cs, sn); continue; } r -= I13;
        if (r < I14) { const int row = r * 4 + (lane >> 4); *(u32x4*)(UP + (size_t)row * 640 + 512 + (lane & 15) * 8) = (u32x4){0u, 0u, 0u, 0u}; continue; } r -= I14;
        { const int row = 672 + r; *(u32x4*)(WINT + (size_t)row * 1024 + lane * 16) = (u32x4){0u, 0u, 0u, 0u}; *(u32x4*)(WINT + (size_t)row * 1024 + lane * 16 + 8) = (u32x4){0u, 0u, 0u, 0u}; }
    }
}
__device__ __forceinline__ void p3_scan(const Frame& F, KArgs A) {
    LAS float* sl = (LAS float*)F.lds;
    for (int task = blockIdx.x; task < 64; task += F.G) {
        const int g = task >> 1, b = task & 1;
        const float* LS = (const float*)(F.ws + A_LS) + (size_t)(g * 512 + b * 256) * 128;
        for (int e = F.tid; e < 256 * 32; e += 512) *(LAS f32x4*)(sl + e * 4) = *(const f32x4*)(LS + e * 4);
        __syncthreads();
        if (F.wave == 0) {
            const int p = F.lane;
            const float lr = ((const float*)A->in[8])[g * 64 + p], li = ((const float*)A->in[9])[g * 64 + p], dt = expf(((const float*)A->in[10])[g]);
            const float mag = expf(lr * dt * 32.f); float sn, cs; sincosf(li * dt * 32.f, &sn, &cs); const float ar = mag * cs, ai = mag * sn;
            bf16* UP = (bf16*)(F.ws + A_UP) + (size_t)(g * 512 + b * 256) * 640 + 512;
            float sr = 0.f, si = 0.f;
#pragma unroll 8
            for (int c = 0; c < 256; ++c) {
                UP[(size_t)c * 640 + p] = (bf16)(cvtpk(sr, 0.f) & 0xffffu); UP[(size_t)c * 640 + 64 + p] = (bf16)(cvtpk(si, 0.f) & 0xffffu);
                const float l0 = sl[c * 128 + p], l1 = sl[c * 128 + 64 + p];
                const float nr = ar * sr - ai * si + l0, ni = ar * si + ai * sr + l1; sr = nr; si = ni;
            }
        }
        __syncthreads();
    }
}
__device__ __forceinline__ void p6_rmsnorm(const Frame& F) {
    const bf16* OA = (const bf16*)(F.ws + A_OA); const bf16* OS = (const bf16*)(F.ob + O_OS); bf16* MIXN = (bf16*)(F.ws + A_MIXN);
    for (int t = F.gw; t < NTOK; t += F.ngw) {
        f32x4 a0, a1, s0, s1; unpack8(*(const u32x4*)(OA + (size_t)t * 512 + F.lane * 8), a0, a1); unpack8(*(const u32x4*)(OS + (size_t)t * 512 + F.lane * 8), s0, s1);
        float qa = 0.f, qs = 0.f;
#pragma unroll
        for (int j = 0; j < 4; ++j) { qa += a0[j] * a0[j] + a1[j] * a1[j]; qs += s0[j] * s0[j] + s1[j] * s1[j]; }
        const float ra = rsqrtf(wave_sum(qa) * (1.f / 512.f) + RMS_EPS), rs = rsqrtf(wave_sum(qs) * (1.f / 512.f) + RMS_EPS);
        *(u32x4*)(MIXN + (size_t)t * 1024 + F.lane * 8) = pack8(a0 * ra, a1 * ra); *(u32x4*)(MIXN + (size_t)t * 1024 + 512 + F.lane * 8) = pack8(s0 * rs, s1 * rs);
    }
}
__device__ __forceinline__ void ln_rows(const Frame& F, const float* PRE, const float* gam, const float* bet, bf16* X) {
    for (int t = F.gw; t < NTOK; t += F.ngw) {
        f32x4 v[4]; float s = 0.f;
#pragma unroll
        for (int j = 0; j < 4; ++j) { v[j] = *(const f32x4*)(PRE + (size_t)t * 1024 + (j * 64 + F.lane) * 4); s += (v[j][0] + v[j][1]) + (v[j][2] + v[j][3]); }
        const float mean = wave_sum(s) * (1.f / 1024.f); float q = 0.f;
#pragma unroll
        for (int j = 0; j < 4; ++j) { v[j] = v[j] - mean; q += (v[j][0] * v[j][0] + v[j][1] * v[j][1]) + (v[j][2] * v[j][2] + v[j][3] * v[j][3]); }
        const float rstd = rsqrtf(wave_sum(q) * (1.f / 1024.f) + LN_EPS);
#pragma unroll
        for (int j = 0; j < 4; ++j) { const int c = (j * 64 + F.lane) * 4; const f32x4 gg = *(const f32x4*)(gam + c), bb = *(const f32x4*)(bet + c); const f32x4 o = v[j] * rstd * gg + bb;
            u32x2 w; w.x = pk2(o[0], o[1]); w.y = pk2(o[2], o[3]); *(u32x2*)(X + (size_t)t * 1024 + c) = w; }
    }
}
constexpr float USCALE = 32.0f;
__device__ __forceinline__ unsigned pk4_fp8(f32x4 v) { int w = __builtin_amdgcn_cvt_pk_fp8_f32(v[0], v[1], 0, false); w = __builtin_amdgcn_cvt_pk_fp8_f32(v[2], v[3], w, true); return (unsigned)w; }
__device__ __forceinline__ void cvt_row1024_fp8(const float* src, unsigned char* dst, int lane, float sc) {
    const f32x4 a = *(const f32x4*)(src + 16 * lane) * sc, b = *(const f32x4*)(src + 16 * lane + 4) * sc, c = *(const f32x4*)(src + 16 * lane + 8) * sc, d = *(const f32x4*)(src + 16 * lane + 12) * sc;
    u32x4 o; o.x = pk4_fp8(a); o.y = pk4_fp8(b); o.z = pk4_fp8(c); o.w = pk4_fp8(d); *(u32x4*)(dst + 16 * lane) = o;
}
__device__ const unsigned char PAIRTAB[64] = {0x00,0x01,0x02,0x03,0x04,0x05,0x06,0x07,0x08,0x09,0x0a,0x0b,0x0c,0x0d,0x0e,0x0f,0x10,0x11,0x12,0x13,0x14,0x15,0x16,0x17,0x20,0x21,0x22,0x23,0x24,0x30,0x31,0x32,
    0x33,0x40,0x41,0x42,0x50,0x51,0x60,0x61,0x70,0x71,0x80,0x90,0xa0,0xb0,0xc0,0xd0,0xe0,0xf0,0xff,0xff,0xff,0xff,0xff,0xff,0xff,0xff,0xff,0xff,0xff,0xff,0xff,0xff};
__device__ __forceinline__ unsigned f2sort(float f) { const unsigned u = __float_as_uint(f); return u ^ ((u >> 31) ? 0xffffffffu : 0x80000000u); }
__device__ __forceinline__ float sort2f(unsigned k) { return __uint_as_float((k & 0x80000000u) ? (k ^ 0x80000000u) : ~k); }
__device__ __forceinline__ unsigned umax_(unsigned a, unsigned b) { return a > b ? a : b; }
template <int CTRL> __device__ __forceinline__ unsigned dpp_u(unsigned v) { return (unsigned)__builtin_amdgcn_update_dpp(0, (int)v, CTRL, 0xf, 0xf, true); }
__device__ __forceinline__ unsigned gmax16(unsigned v) { v = umax_(v, dpp_u<0x128>(v)); v = umax_(v, dpp_u<0x124>(v)); v = umax_(v, dpp_u<0x122>(v)); v = umax_(v, dpp_u<0x121>(v)); return v; }
__device__ __forceinline__ float gmaxf16(float v) { v = fmaxf(v, __uint_as_float(dpp_u<0x128>(__float_as_uint(v)))); v = fmaxf(v, __uint_as_float(dpp_u<0x124>(__float_as_uint(v)))); v = fmaxf(v, __uint_as_float(dpp_u<0x122>(__float_as_uint(v)))); v = fmaxf(v, __uint_as_float(dpp_u<0x121>(__float_as_uint(v)))); return v; }
__device__ __forceinline__ float gsumf16(float v) { v += __uint_as_float(dpp_u<0x128>(__float_as_uint(v))); v += __uint_as_float(dpp_u<0x124>(__float_as_uint(v))); v += __uint_as_float(dpp_u<0x122>(__float_as_uint(v))); v += __uint_as_float(dpp_u<0x121>(__float_as_uint(v))); return v; }
__device__ __forceinline__ void p13_topk(const Frame& F, KArgs A) {
    const float* u_tab = (const float*)A->in[32]; const float* v_tab = (const float*)A->in[33]; unsigned char* UT = F.ws + A_UT; unsigned char* VT = F.ws + A_VT;
    const float* SCLO = (const float*)F.ob; const float* SCHI = (const float*)(F.ws + A_SCHI); int* IDS = (int*)(F.ws + A_IDS); float* GATES = (float*)(F.ws + A_GATES);
    const int lane = F.lane, l = lane & 15, gbase = lane & 48;
    for (int w = F.gw; w < NTOK * 2; w += F.ngw) {
        if (w < 16384) cvt_row1024_fp8(u_tab + (size_t)w * 1024, UT + (size_t)w * 1024, lane, USCALE); else cvt_row1024_fp8(v_tab + (size_t)(w - 16384) * 1024, VT + (size_t)(w - 16384) * 1024, lane, 1.0f);
        const int t = w >> 1, h = (w & 1) * 4 + (lane >> 4);
        const float* src = (h < 4 ? SCLO : SCHI) + (size_t)t * 1024 + (h & 3) * 256;
        const f32x4 a0 = *(const f32x4*)(src + 4 * l), a1 = *(const f32x4*)(src + 64 + 4 * l), b0 = *(const f32x4*)(src + 128 + 4 * l), b1 = *(const f32x4*)(src + 192 + 4 * l);
        unsigned k1[8], k2[8];
#pragma unroll
        for (int e = 0; e < 4; ++e) { k1[e] = (f2sort(a0[e]) & ~127u) | (unsigned)(4 * l + e); k1[4 + e] = (f2sort(a1[e]) & ~127u) | (unsigned)(64 + 4 * l + e);
                                      k2[e] = (f2sort(b0[e]) & ~127u) | (unsigned)(4 * l + e); k2[4 + e] = (f2sort(b1[e]) & ~127u) | (unsigned)(64 + 4 * l + e); }
        unsigned r1 = 0u, r2 = 0u;
        for (int k = 0; k < 16; ++k) {
            unsigned m1 = umax_(umax_(umax_(k1[0], k1[1]), umax_(k1[2], k1[3])), umax_(umax_(k1[4], k1[5]), umax_(k1[6], k1[7])));
            unsigned m2 = umax_(umax_(umax_(k2[0], k2[1]), umax_(k2[2], k2[3])), umax_(umax_(k2[4], k2[5]), umax_(k2[6], k2[7])));
            m1 = gmax16(m1); m2 = gmax16(m2);
            if (l == k) { r1 = m1; r2 = m2; }
#pragma unroll
            for (int e = 0; e < 8; ++e) { if (k1[e] == m1) k1[e] = 0u; if (k2[e] == m2) k2[e] = 0u; }
        }
        unsigned ck[4];
#pragma unroll
        for (int s = 0; s < 4; ++s) { const unsigned pr = PAIRTAB[s * 16 + l]; const bool valid = pr != 0xffu; const int i = valid ? (int)(pr >> 4) : 0, j = valid ? (int)(pr & 15u) : 0;
            const unsigned ki = (unsigned)__shfl((int)r1, gbase + i), kj = (unsigned)__shfl((int)r2, gbase + j);
            const float sum = sort2f(ki & ~127u) + sort2f(kj & ~127u);
            ck[s] = valid ? ((f2sort(sum) & ~255u) | pr) : 0u; }
        unsigned res = 0u;
        for (int k = 0; k < 16; ++k) {
            unsigned m = gmax16(umax_(umax_(ck[0], ck[1]), umax_(ck[2], ck[3])));
            if (l == k) res = m;
#pragma unroll
            for (int s = 0; s < 4; ++s) if (ck[s] == m) ck[s] = 0u;
        }
        const int i = (int)((res >> 4) & 15u), j = (int)(res & 15u);
        const unsigned ki = (unsigned)__shfl((int)r1, gbase + i), kj = (unsigned)__shfl((int)r2, gbase + j);
        const float val = sort2f(ki & ~127u) + sort2f(kj & ~127u); const int id = (int)(ki & 127u) * 128 + (int)(kj & 127u);
        const float mx = gmaxf16(val); const float ex = __expf(val - mx); const float sm = gsumf16(ex);
        IDS[(size_t)t * 128 + h * 16 + l] = id; GATES[(size_t)t * 128 + h * 16 + l] = ex / sm;
    }
}
__device__ __forceinline__ void unpack16_fp8(u32x4 w, f32x4& a, f32x4& b, f32x4& c, f32x4& d) {
    const f32x2 a0 = __builtin_amdgcn_cvt_pk_f32_fp8((int)w.x, false), a1 = __builtin_amdgcn_cvt_pk_f32_fp8((int)w.x, true), b0 = __builtin_amdgcn_cvt_pk_f32_fp8((int)w.y, false), b1 = __builtin_amdgcn_cvt_pk_f32_fp8((int)w.y, true);
    const f32x2 c0 = __builtin_amdgcn_cvt_pk_f32_fp8((int)w.z, false), c1 = __builtin_amdgcn_cvt_pk_f32_fp8((int)w.z, true), d0 = __builtin_amdgcn_cvt_pk_f32_fp8((int)w.w, false), d1 = __builtin_amdgcn_cvt_pk_f32_fp8((int)w.w, true);
    a = (f32x4){a0.x, a0.y, a1.x, a1.y}; b = (f32x4){b0.x, b0.y, b1.x, b1.y}; c = (f32x4){c0.x, c0.y, c1.x, c1.y}; d = (f32x4){d0.x, d0.y, d1.x, d1.y};
}
__device__ __forceinline__ float hsum4(f32x4 v) { return (v[0] + v[1]) + (v[2] + v[3]); }
__device__ __forceinline__ void p15_gather(const Frame& F, KArgs A) {
    const bf16* X2 = (const bf16*)(F.ws + A_X2); const int* IDS = (const int*)(F.ws + A_IDS); const float* GATES = (const float*)(F.ws + A_GATES);
    const unsigned char* UT = F.ws + A_UT; const unsigned char* VT = F.ws + A_VT; const float* g3 = (const float*)A->in[34]; const float* b3 = (const float*)A->in[35];
    float* out = (float*)F.ob; const int lane = F.lane; const bool b5 = lane & 32, b4 = lane & 16, b3_ = lane & 8;
    const int srcl = ((lane >> 2) & 1) * 32 + ((lane >> 1) & 1) * 16 + (lane & 1) * 8;
    for (int t = F.gw; t < NTOK; t += F.ngw) {
        f32x4 x0, x1, x2, x3; unpack8(*(const u32x4*)(X2 + (size_t)t * 1024 + 16 * lane), x0, x1); unpack8(*(const u32x4*)(X2 + (size_t)t * 1024 + 16 * lane + 8), x2, x3);
        const int id0 = IDS[(size_t)t * 128 + lane], id1 = IDS[(size_t)t * 128 + 64 + lane]; const float g0 = GATES[(size_t)t * 128 + lane], g1 = GATES[(size_t)t * 128 + 64 + lane];
        float c0 = 0.f, c1 = 0.f;
        for (int bi = 0; bi < 16; ++bi) {
            const int idv = bi < 8 ? id0 : id1; float p[8];
#pragma unroll
            for (int r = 0; r < 8; ++r) { const int id = __builtin_amdgcn_readlane(idv, (bi & 7) * 8 + r);
                f32x4 u0, u1, u2, u3; unpack16_fp8(*(const u32x4*)(UT + (size_t)id * 1024 + 16 * lane), u0, u1, u2, u3);
                p[r] = hsum4(x0 * u0 + x1 * u1 + x2 * u2 + x3 * u3); }
            float q[4], s2[2];
#pragma unroll
            for (int r = 0; r < 4; ++r) { const float keep = b5 ? p[r + 4] : p[r], send = b5 ? p[r] : p[r + 4]; q[r] = keep + __shfl_xor(send, 32); }
#pragma unroll
            for (int r = 0; r < 2; ++r) { const float keep = b4 ? q[r + 2] : q[r], send = b4 ? q[r] : q[r + 2]; s2[r] = keep + __shfl_xor(send, 16); }
            float v; { const float keep = b3_ ? s2[1] : s2[0], send = b3_ ? s2[0] : s2[1]; v = keep + __shfl_xor(send, 8); }
            v += __shfl_xor(v, 4); v += __shfl_xor(v, 2); v += __shfl_xor(v, 1);
            const float tv = __shfl(v, srcl);
            if ((lane >> 3) == (bi & 7)) { if (bi < 8) c0 = tv; else c1 = tv; }
        }
        c0 = g0 * gelu_tanh(c0 * (1.0f / USCALE)); c1 = g1 * gelu_tanh(c1 * (1.0f / USCALE));
        f32x4 acc[4] = {};
        for (int bi = 0; bi < 16; ++bi) {
            const int idv = bi < 8 ? id0 : id1; const float cv = bi < 8 ? c0 : c1;
#pragma unroll
            for (int r = 0; r < 8; ++r) { const int kk = (bi & 7) * 8 + r; const int id = __builtin_amdgcn_readlane(idv, kk);
                const float s = __uint_as_float(__builtin_amdgcn_readlane(__float_as_uint(cv), kk));
                f32x4 v0, v1, v2, v3; unpack16_fp8(*(const u32x4*)(VT + (size_t)id * 1024 + 16 * lane), v0, v1, v2, v3);
                acc[0] += v0 * s; acc[1] += v1 * s; acc[2] += v2 * s; acc[3] += v3 * s; }
        }
        acc[0] += x0 * ALPHA; acc[1] += x1 * ALPHA; acc[2] += x2 * ALPHA; acc[3] += x3 * ALPHA;
        float s = 0.f;
#pragma unroll
        for (int j = 0; j < 4; ++j) s += hsum4(acc[j]);
        const float mean = wave_sum(s) * (1.f / 1024.f); float qv = 0.f;
#pragma unroll
        for (int j = 0; j < 4; ++j) { acc[j] = acc[j] - mean; qv += hsum4(acc[j] * acc[j]); }
        const float rstd = rsqrtf(wave_sum(qv) * (1.f / 1024.f) + LN_EPS);
#pragma unroll
        for (int j = 0; j < 4; ++j) { const int c = 16 * lane + 4 * j; const f32x4 gg = *(const f32x4*)(g3 + c), bb = *(const f32x4*)(b3 + c);
            *(f32x4*)(out + (size_t)t * 1024 + c) = acc[j] * rstd * gg + bb; }
    }
}

__global__ void __launch_bounds__(NWAVES * 64, 2) mk_fwd(Args args) {
    extern __shared__ __attribute__((aligned(16))) unsigned char lds[];
    Frame F;
    F.lds = (LAS unsigned char*)lds; F.ws = args.ws; F.ob = (unsigned char*)args.out; F.ctl = (unsigned*)(args.ws + WS_CTL);
    F.tid = threadIdx.x; F.lane = F.tid & 63; F.wave = __builtin_amdgcn_readfirstlane(F.tid >> 6);
    F.G = gridDim.x; { const int bx = blockIdx.x; F.vcu = (F.G % 8 == 0) ? (bx % 8) * (F.G / 8) + bx / 8 : bx; }
    F.gw = F.vcu * NWAVES + F.wave; F.ngw = F.G * NWAVES;
    volatile LAS unsigned* MISC = (volatile LAS unsigned*)(F.lds + MISC_OFF);
    if (F.tid < 32) MISC[F.tid] = 0u;
    __syncthreads();
    const int lo = args.ph_lo, hi = args.ph_hi;
    XcdBarrier bar; bar.bar = F.ctl + CW_BAR; bar.x = 0; bar.st = nullptr;
    if (hi - lo > 1) bar = xcd_barrier_post(F.ctl + CW_BAR, MISC + 8);
#define IN(k) (lo <= (k) && (k) < hi)
#define SEAM(k) do { if (IN(k) && IN((k) + 1)) xcd_barrier(bar); } while (0)
    const int bx = (int)blockIdx.x;

    if (IN(0)) { for (int rep = 0; rep < 1 + ((MK_REP >> 0) & 1); ++rep) { F.refresh(); p0_prologue(F, kargs()); } SEAM(0); }

    if (IN(1)) {
        { pg8::Gemm g{(const bf16*)(F.ob + O_XB), (const bf16*)(F.ws + W_WINT), NTOK, NINP, DM}; BigSched S; S.so.init(NTOK, NINP, F.G, bx); S.bt = 0;
          EpiWin E{(bf16*)(F.ws + A_CQ), (bf16*)(F.ws + A_CKV), (bf16*)(F.ws + A_KH), (bf16*)(F.ws + A_UP), (const float2*)(F.ws + W_ROPE), (float*)(F.ws + W_SSQ)};
          pg8::gemm_phase<EpiWin, BigSched, true, true>(F.lds, g, S, E); }
        { pg8::Gemm g{(const bf16*)(F.ws + W_MEMB), (const bf16*)(F.ws + W_XKVT), 512, 2048, DM}; ListSched<DecKV2> S{16, F.G, (bx + F.G - 64) % F.G, DecKV2{}};
          EpiK2V2 E{(bf16*)(F.ws + W_K2V2)};
          pg8::gemm_phase<EpiK2V2, ListSched<DecKV2>, true, true>(F.lds, g, S, E); }
        SEAM(1);
    }
    if (IN(2)) {
        { pg8::Gemm g{(const bf16*)(F.ws + A_CQ), (const bf16*)(F.ws + W_WUQT), NTOK, 768, QL}; BigSched S; S.so.init(NTOK, 768, F.G, bx); S.bt = 0;
          EpiQ E{(bf16*)(F.ws + A_QH), (const float2*)(F.ws + W_ROPE), (const float*)(F.ws + W_SSQ)};
          pg8::gemm_phase<EpiQ, BigSched, true, true>(F.lds, g, S, E); }
        { pg8::Gemm g{(const bf16*)(F.ws + A_UP), (const bf16*)(F.ws + W_GM), 16384, 8192, 640}; ListSched<DecLS> S{64, F.G, (bx + F.G - 192) % F.G, DecLS{}};
          EpiLS E{(float*)(F.ws + A_LS)};
          pg8::gemm_phase<EpiLS, ListSched<DecLS>, true, true>(F.lds, g, S, E); }
        { pg8::Gemm g{(const bf16*)(F.ws + A_CKV), (const bf16*)(F.ws + W_WUKVT), NTOK, 1024, KVL}; BigSched S; S.so.init(NTOK, 1024, F.G, bx); S.bt = 0;
          EpiKV E{(bf16*)(F.ws + A_KH), (bf16*)(F.ws + A_VH), (const float*)(F.ws + W_SSQ)};
          pg8::gemm_phase<EpiKV, BigSched, true, true>(F.lds, g, S, E); }
        { pg8::Gemm g{(const bf16*)(F.ws + W_K2V2), (const bf16*)(F.ws + W_XQH), 2048, 4096, 256}; ListSched<DecMb> S{32, F.G, bx, DecMb{}};
          EpiMb E{(bf16*)(F.ws + W_MB)};
          pg8::gemm_phase<EpiMb, ListSched<DecMb>, true, true>(F.lds, g, S, E); }
        { pg8::Gemm g{(const bf16*)(F.ws + W_XOTH), (const bf16*)(F.ws + W_K2V2) + (size_t)2 * 4 * 256 * 256, 4096, 2048, 256}; ListSched<DecVOT> S{32, F.G, (bx + F.G - 32) % F.G, DecVOT{}};
          EpiVOT E{(bf16*)(F.ws + W_VOT)};
          pg8::gemm_phase<EpiVOT, ListSched<DecVOT>, true, true>(F.lds, g, S, E); }
        { pg8::Gemm g{(const bf16*)(F.ws + W_SKP), (const bf16*)(F.ws + W_WQR), 512, 16384, 256}; ListSched<DecWsc> S{64, F.G, (bx + F.G - 64) % F.G, DecWsc{}};
          EpiWsc E{(bf16*)(F.ws + W_WSC)};
          pg8::gemm_phase<EpiWsc, ListSched<DecWsc>, true, true>(F.lds, g, S, E); }
        SEAM(2);
    }
    if (IN(3)) { F.refresh(); p3_scan(F, kargs()); SEAM(3); }
    if (IN(4)) {
        for (int rep = 0; rep < 1 + ((MK_REP >> 4) & 1); ++rep)
        for (int L = F.vcu; L < 256; L += F.G) {
            const int bh = L >> 4, xq_ = L & 15, q0 = xq_, q1 = 31 - xq_, b = bh >> 3, h = bh & 7;
            const att::bf16* Qb = (const att::bf16*)(F.ws + A_QH) + (size_t)bh * SEQ * 96; const att::bf16* Kb = (const att::bf16*)(F.ws + A_KH) + (size_t)bh * SEQ * 96;
            const att::bf16* Vb = (const att::bf16*)(F.ws + A_VH) + (size_t)bh * SEQ * 64; att::bf16* Ob = (att::bf16*)(F.ws + A_OA) + (size_t)b * SEQ * 512 + h * 64;
            const att::BlockRef r0{Qb + (size_t)q0 * 256 * 96, Kb, Vb, Ob + (size_t)q0 * 256 * 512, q0 * 256};
            const att::BlockRef r1{Qb + (size_t)q1 * 256 * 96, Kb, Vb, Ob + (size_t)q1 * 256 * 512, q1 * 256};
            att::Seam S;
            att::attn_prime(r0, (char*)lds, S);
            att::attn_block(r0, r1, (char*)lds, S);
            att::attn_block(r1, r1, (char*)lds, S);
        }
        { pg8::Gemm g{(const bf16*)(F.ws + A_UP), (const bf16*)(F.ws + W_TH), 16384, 16384, 640}; ListSched<DecY> S{128, F.G, bx, DecY{}};
          EpiY E{(bf16*)(F.ob + O_YS)};
          pg8::gemm_phase<EpiY, ListSched<DecY>, true, true>(F.lds, g, S, E); }
        SEAM(4);
    }
    if (IN(5)) {
        pg8::Gemm g{(const bf16*)(F.ob + O_YS), (const bf16*)(F.ws + W_WGLUT), NTOK, 512, 512}; BigSched S; S.so.init(NTOK, 512, F.G, bx); S.bt = 0;
        EpiGlu E{(const bf16*)(F.ob + O_YS), (bf16*)(F.ob + O_OS), (const float*)kargs()->in[17]};
        pg8::gemm_phase<EpiGlu, BigSched, true, true>(F.lds, g, S, E);
        SEAM(5);
    }
    if (IN(6)) { F.refresh(); p6_rmsnorm(F); SEAM(6); }
    if (IN(7)) {
        pg8::Gemm g{(const bf16*)(F.ws + A_MIXN), (const bf16*)(F.ws + W_WOUTT), NTOK, DM, DM}; BigSched S; S.so.init(NTOK, DM, F.G, bx); S.bt = 0;
        EpiPre<0> E{(const float*)kargs()->in[0], nullptr, (float*)F.ob};
        pg8::gemm_phase<EpiPre<0>, BigSched, true, true>(F.lds, g, S, E);
        SEAM(7);
    }
    if (IN(8)) { F.refresh(); ln_rows(F, (const float*)F.ob, (const float*)kargs()->in[21], (const float*)kargs()->in[22], (bf16*)(F.ws + A_X1)); SEAM(8); }
    if (IN(9)) {
        pg8::Gemm g{(const bf16*)(F.ws + A_X1), (const bf16*)(F.ws + W_MB), NTOK, DM, DM}; BigSched S; S.so.init(NTOK, DM, F.G, bx); S.bt = 4;
        EpiXS E{(bf16*)(F.ws + A_P), F.lds};
        pg8::gemm_phase<EpiXS, BigSched, true, true>(F.lds, g, S, E);
        SEAM(9);
    }
    if (IN(10)) {
        pg8::Gemm g{(const bf16*)(F.ws + A_P), (const bf16*)(F.ws + W_VOT), NTOK, DM, DM}; BigSched S; S.so.init(NTOK, DM, F.G, bx); S.bt = 4;
        EpiPre<1> E{nullptr, (const bf16*)(F.ws + A_X1), (float*)F.ob};
        pg8::gemm_phase<EpiPre<1>, BigSched, true, true>(F.lds, g, S, E);
        SEAM(10);
    }
    if (IN(11)) { F.refresh(); ln_rows(F, (const float*)F.ob, (const float*)kargs()->in[27], (const float*)kargs()->in[28], (bf16*)(F.ws + A_X2)); SEAM(11); }
    if (IN(12)) {
        pg8::Gemm g{(const bf16*)(F.ws + A_X2), (const bf16*)(F.ws + W_WSC), NTOK, 2048, DM}; BigSched S; S.so.init(NTOK, 2048, F.G, bx); S.bt = 0;
        EpiSC E{(float*)F.ob, (float*)(F.ws + A_SCHI)};
        pg8::gemm_phase<EpiSC, BigSched, true, true>(F.lds, g, S, E);
        SEAM(12);
    }
    if (IN(13)) { for (int rep = 0; rep < 1 + ((MK_REP >> 13) & 1); ++rep) { F.refresh(); p13_topk(F, kargs()); } if (IN(13) && IN(15)) xcd_barrier(bar); }
    if (IN(15)) { for (int rep = 0; rep < 1 + ((MK_REP >> 15) & 1); ++rep) { F.refresh(); p15_gather(F, kargs()); } }
#undef IN
#undef SEAM
}

#if MK_DBG
struct DArgs { const void* in[36]; float* out; unsigned char* ws; };
__device__ __forceinline__ unsigned hsh(unsigned x) { x ^= x >> 16; x *= 0x7feb352du; x ^= x >> 15; x *= 0x846ca68bu; x ^= x >> 16; return x; }
__device__ __forceinline__ float bf2f(bf16 v) { return __uint_as_float((unsigned)v << 16); }
__device__ __forceinline__ void dbg_report(unsigned char* ws, int code, bool bad) { if (bad) atomicMax((unsigned*)(ws + WS_CTL) + CW_DBG, (unsigned)(32 - code)); }
__device__ __forceinline__ bool far(float got, float ref, float scale) { return !(fabsf(got - ref) <= 0.03f * scale + 0.03f * fabsf(ref)); }
__device__ __forceinline__ int ropepos(int i, int second) { return (i >> 2) * 8 + (i & 3) + 4 * second; }

__global__ void chk1(DArgs a) {
    const int i = blockIdx.x * blockDim.x + threadIdx.x; const unsigned h0 = hsh(i * 2 + 1), h1 = hsh(i * 2 + 2);
    const int t = h0 % NTOK; int col = h1 % 1184; const float* x = (const float*)a.in[0]; const float* w = (const float*)a.in[3]; const int* pos = (const int*)a.in[2];
    const int b = t >> 13, tl = t & 8191;
    if (col >= 640 && col < 672) { const int ii = (col - 640) & 15; float x1 = 0.f, x2 = 0.f;
        for (int k = 0; k < 1024; ++k) { x1 += x[(size_t)t * 1024 + k] * w[(size_t)k * 1184 + 640 + ii]; x2 += x[(size_t)t * 1024 + k] * w[(size_t)k * 1184 + 656 + ii]; }
        const float ang = (float)pos[t] * powf(10000.f, -(float)ii / 16.f); const float c = cosf(ang), s = sinf(ang); const int hh = h1 % 8;
        const bf16* kr = (const bf16*)(a.ws + A_KH) + ((size_t)(b * 8 + hh) * SEQ + tl) * 96 + 64;
        dbg_report(a.ws, 1, far(bf2f(kr[ropepos(ii, 0)]), x1 * c - x2 * s, 1.f) || far(bf2f(kr[ropepos(ii, 1)]), x2 * c + x1 * s, 1.f)); return; }
    float r = 0.f; for (int k = 0; k < 1024; ++k) r += x[(size_t)t * 1024 + k] * w[(size_t)k * 1184 + col];
    float got;
    if (col < 384) got = bf2f(((const bf16*)(a.ws + A_CQ))[(size_t)t * 384 + col]);
    else if (col < 640) got = bf2f(((const bf16*)(a.ws + A_CKV))[(size_t)t * 256 + col - 384]);
    else { const int ch = col - 672, g = ch >> 4, hp = ch & 15; got = bf2f(((const bf16*)(a.ws + A_UP))[((size_t)(g * 512 + b * 256 + (tl >> 5)) * 640) + (tl & 31) * 16 + hp]); }
    dbg_report(a.ws, 1, far(got, r, 1.f));
}
__global__ void chk2(DArgs a) {
    const int i = blockIdx.x * blockDim.x + threadIdx.x; const unsigned h0 = hsh(i * 3 + 11), h1 = hsh(i * 3 + 12), h2 = hsh(i * 3 + 13);
    const int t = h0 % NTOK, h = h1 % 8, b = t >> 13, tl = t & 8191; const int* pos = (const int*)a.in[2];
    if (h2 & 1) {
        const bf16* cq = (const bf16*)(a.ws + A_CQ) + (size_t)t * 384; const float* g = (const float*)a.in[4]; const float* w = (const float*)a.in[5];
        float ss = 0.f; for (int k = 0; k < 384; ++k) ss += bf2f(cq[k]) * bf2f(cq[k]);
        const float rr = rsqrtf(ss / 384.f + 1e-6f); const int d = (h2 >> 1) % 96; const bf16* q = (const bf16*)(a.ws + A_QH) + ((size_t)(b * 8 + h) * SEQ + tl) * 96;
        if (d < 64) { float r = 0.f; for (int k = 0; k < 384; ++k) r += bf2f(cq[k]) * g[k] * w[(size_t)k * 768 + h * 96 + d]; dbg_report(a.ws, 2, far(bf2f(q[d]), r * rr * C2Q, 0.15f)); }
        else { const int ii = (d - 64) & 15; float x1 = 0.f, x2 = 0.f;
            for (int k = 0; k < 384; ++k) { const float v = bf2f(cq[k]) * g[k]; x1 += v * w[(size_t)k * 768 + h * 96 + 64 + ii]; x2 += v * w[(size_t)k * 768 + h * 96 + 80 + ii]; }
            x1 *= rr * C2Q; x2 *= rr * C2Q; const float ang = (float)pos[t] * powf(10000.f, -(float)ii / 16.f); const float c = cosf(ang), s = sinf(ang);
            dbg_report(a.ws, 2, far(bf2f(q[64 + ropepos(ii, 0)]), x1 * c - x2 * s, 0.15f) || far(bf2f(q[64 + ropepos(ii, 1)]), x2 * c + x1 * s, 0.15f)); }
    } else {
        const bf16* ck = (const bf16*)(a.ws + A_CKV) + (size_t)t * 256; const float* g = (const float*)a.in[6]; const float* w = (const float*)a.in[7];
        float ss = 0.f; for (int k = 0; k < 256; ++k) ss += bf2f(ck[k]) * bf2f(ck[k]);
        const float rr = rsqrtf(ss / 256.f + 1e-6f); const int j = (h2 >> 1) % 128; float r = 0.f;
        for (int k = 0; k < 256; ++k) r += bf2f(ck[k]) * g[k] * w[(size_t)k * 1024 + h * 128 + j];
        const float got = j < 64 ? bf2f(((const bf16*)(a.ws + A_KH))[((size_t)(b * 8 + h) * SEQ + tl) * 96 + j]) : bf2f(((const bf16*)(a.ws + A_VH))[((size_t)(b * 8 + h) * SEQ + tl) * 64 + j - 64]);
        dbg_report(a.ws, 2, far(got, r * rr, 1.f));
    }
}
__global__ void chk3(DArgs a) {
    const int i = blockIdx.x * (blockDim.x >> 6) + (threadIdx.x >> 6), lane = threadIdx.x & 63; const unsigned h0 = hsh(i * 3 + 21), h1 = hsh(i * 3 + 22), h2 = hsh(i * 3 + 23);
    int t = h0 % NTOK; if ((i & 3) == 0) t = (t & ~8191) + (h0 >> 16) % 300; const int h = h1 % 8, d = h2 % 64, b = t >> 13, tl = t & 8191;
    const bf16* q = (const bf16*)(a.ws + A_QH) + ((size_t)(b * 8 + h) * SEQ + tl) * 96; const bf16* K = (const bf16*)(a.ws + A_KH) + (size_t)(b * 8 + h) * SEQ * 96; const bf16* V = (const bf16*)(a.ws + A_VH) + (size_t)(b * 8 + h) * SEQ * 64;
    float mx = -1e30f;
    for (int k = lane; k <= tl; k += 64) { float s = 0.f; for (int e = 0; e < 96; ++e) s += bf2f(q[e]) * bf2f(K[(size_t)k * 96 + e]); mx = fmaxf(mx, s); }
    for (int o = 1; o < 64; o <<= 1) mx = fmaxf(mx, __shfl_xor(mx, o));
    float l = 0.f, acc = 0.f;
    for (int k = lane; k <= tl; k += 64) { float s = 0.f; for (int e = 0; e < 96; ++e) s += bf2f(q[e]) * bf2f(K[(size_t)k * 96 + e]); const float p = exp2f(s - mx); l += p; acc += p * bf2f(V[(size_t)k * 64 + d]); }
    l = wave_sum(l); acc = wave_sum(acc);
    const float got = bf2f(((const bf16*)(a.ws + A_OA))[(size_t)t * 512 + h * 64 + d]);
    if (lane == 0) dbg_report(a.ws, 3, far(got, acc / l, 0.05f));
}
__global__ void chk4(DArgs a) {
    const int i = blockIdx.x * (blockDim.x >> 6) + (threadIdx.x >> 6), p = threadIdx.x & 63; const unsigned h0 = hsh(i * 3 + 31), h1 = hsh(i * 3 + 32);
    const int b = h0 & 1, tl = (h0 >> 1) % 420, ch = h1 % 512, g = ch >> 4, h = ch & 15;
    const float lr = ((const float*)a.in[8])[g * 64 + p], li = ((const float*)a.in[9])[g * 64 + p], dt = expf(((const float*)a.in[10])[g]);
    const float mag = expf(lr * dt), ar = mag * cosf(li * dt), ai = mag * sinf(li * dt), den = lr * lr + li * li, nr = ar - 1.f, ni = ai;
    const float fr_ = (nr * lr + ni * li) / den, fi_ = (ni * lr - nr * li) / den;
    const float* bre = (const float*)a.in[11] + g * 1024 + p * 16; const float* bim = (const float*)a.in[12] + g * 1024 + p * 16;
    const bf16* UP = (const bf16*)(a.ws + A_UP);
    float sr = 0.f, si = 0.f, ulast = 0.f;
    for (int tau = 0; tau <= tl; ++tau) { const bf16* ur = UP + ((size_t)(g * 512 + b * 256 + (tau >> 5)) * 640) + (tau & 31) * 16; float br = 0.f, bi = 0.f;
        for (int hp = 0; hp < 16; ++hp) { const float uu = bf2f(ur[hp]); const float bbr = fr_ * bre[hp] - fi_ * bim[hp], bbi = fr_ * bim[hp] + fi_ * bre[hp]; br += bbr * uu; bi += bbi * uu; }
        const float n0 = ar * sr - ai * si + br, n1 = ar * si + ai * sr + bi; sr = n0; si = n1; ulast = bf2f(ur[h]); }
    const float cr = ((const float*)a.in[13])[g * 1024 + h * 64 + p], ci = ((const float*)a.in[14])[g * 1024 + h * 64 + p];
    float y = wave_sum(cr * sr - ci * si) + ((const float*)a.in[15])[g * 16 + h] * ulast;
    const float k0 = 0.7978845608f; y = 0.5f * y * (1.f + tanhf(k0 * (y + 0.044715f * y * y * y)));
    const float got = bf2f(((const bf16*)((unsigned char*)a.out + O_YS))[(size_t)(b * SEQ + tl) * 512 + ch]);
    if (p == 0) dbg_report(a.ws, 4, far(got, y, 0.3f));
}
__global__ void chk5(DArgs a) {
    const int i = blockIdx.x * blockDim.x + threadIdx.x; const unsigned h0 = hsh(i * 2 + 41), h1 = hsh(i * 2 + 42); const int t = h0 % NTOK, c = h1 % 512;
    const bf16* y = (const bf16*)((unsigned char*)a.out + O_YS) + (size_t)t * 512; const float* w = (const float*)a.in[16]; float z = ((const float*)a.in[17])[c];
    for (int k = 0; k < 512; ++k) z += bf2f(y[k]) * w[(size_t)k * 512 + c];
    const float r = bf2f(y[c]) / (1.f + expf(-z)); dbg_report(a.ws, 5, far(bf2f(((const bf16*)((unsigned char*)a.out + O_OS))[(size_t)t * 512 + c]), r, 0.3f));
}
__global__ void chk7(DArgs a) {
    const int i = blockIdx.x * blockDim.x + threadIdx.x; const unsigned h0 = hsh(i * 2 + 51), h1 = hsh(i * 2 + 52); const int t = h0 % NTOK, c = h1 % 1024;
    const bf16* oa = (const bf16*)(a.ws + A_OA) + (size_t)t * 512; const bf16* os = (const bf16*)((unsigned char*)a.out + O_OS) + (size_t)t * 512;
    const bf16* mx = (const bf16*)(a.ws + A_MIXN) + (size_t)t * 1024; const float* w = (const float*)a.in[20]; const float* ga = (const float*)a.in[18]; const float* gs = (const float*)a.in[19];
    float ss = 0.f; for (int k = 0; k < 512; ++k) ss += bf2f(oa[k]) * bf2f(oa[k]);
    const float ra = rsqrtf(ss / 512.f + 1e-6f); const int kk = h1 % 512; const bool badn = far(bf2f(mx[kk]), bf2f(oa[kk]) * ra, 1.f); (void)os;
    float r = 0.f; for (int k = 0; k < 1024; ++k) r += bf2f(mx[k]) * (k < 512 ? ga[k] : gs[k - 512]) * w[(size_t)k * 1024 + c];
    r += ALPHA * ((const float*)a.in[0])[(size_t)t * 1024 + c];
    dbg_report(a.ws, 6, badn || far(a.out[(size_t)t * 1024 + c], r, 1.f));
}
__global__ void chk8(DArgs a, int which) {
    const int i = blockIdx.x * blockDim.x + threadIdx.x; const unsigned h0 = hsh(i * 2 + 61), h1 = hsh(i * 2 + 62); const int t = h0 % NTOK, c = h1 % 1024; const float* pre = a.out + (size_t)t * 1024;
    float m = 0.f; for (int k = 0; k < 1024; ++k) m += pre[k]; m /= 1024.f; float v = 0.f; for (int k = 0; k < 1024; ++k) v += (pre[k] - m) * (pre[k] - m); v /= 1024.f;
    const float* g = (const float*)a.in[which ? 27 : 21]; const float* bb = (const float*)a.in[which ? 28 : 22]; const float r = (pre[c] - m) * rsqrtf(v + 1e-5f) * g[c] + bb[c];
    dbg_report(a.ws, 7, far(bf2f(((const bf16*)(a.ws + (which ? A_X2 : A_X1)))[(size_t)t * 1024 + c]), r, 1.f));
}
__global__ void chk_k2(DArgs a) {
    const int i = blockIdx.x * blockDim.x + threadIdx.x; const unsigned h0 = hsh(i * 2 + 71), h1 = hsh(i * 2 + 72); const int bm = h0 % 512, n = h1 % 1024, kv = (h1 >> 12) & 1;
    const float* mem = (const float*)a.in[1] + (size_t)bm * 1024; const float* w = (const float*)a.in[kv ? 25 : 24]; float r = 0.f; for (int k = 0; k < 1024; ++k) r += mem[k] * w[(size_t)k * 1024 + n];
    const int b = bm >> 8, m = bm & 255, h = n >> 8, j = n & 255;
    dbg_report(a.ws, 8, far(bf2f(((const bf16*)(a.ws + W_K2V2))[((size_t)(((kv * 2 + b) * 4 + h) * 256 + m)) * 256 + j]), r, 1.f));
}
__global__ void chk10(DArgs a) {
    __shared__ float q[1024], s[1024], o[1024]; __shared__ float red[4];
    const int i = blockIdx.x, tid = threadIdx.x; const unsigned h0 = hsh(i * 2 + 81), h1 = hsh(i * 2 + 82); const int t = h0 % NTOK, c = h1 % 1024, b = t >> 13;
    const bf16* x1 = (const bf16*)(a.ws + A_X1) + (size_t)t * 1024; const float* xq = (const float*)a.in[23]; const float* xo = (const float*)a.in[26];
    const bf16* K2 = (const bf16*)(a.ws + W_K2V2) + (size_t)(0 * 2 + b) * 4 * 256 * 256; const bf16* V2 = (const bf16*)(a.ws + W_K2V2) + (size_t)(1 * 2 + b) * 4 * 256 * 256;
    for (int n = tid; n < 1024; n += 256) { float r = 0.f; for (int k = 0; k < 1024; ++k) r += bf2f(x1[k]) * xq[(size_t)k * 1024 + n]; q[n] = r; }
    __syncthreads();
    for (int n = tid; n < 1024; n += 256) { const int h = n >> 8, m = n & 255; float r = 0.f; for (int j = 0; j < 256; ++j) r += q[h * 256 + j] * bf2f(K2[((size_t)h * 256 + m) * 256 + j]); s[n] = r * 0.0625f; }
    __syncthreads();
    if (tid < 4) { float mx = -1e30f; for (int m = 0; m < 256; ++m) mx = fmaxf(mx, s[tid * 256 + m]); float l = 0.f; for (int m = 0; m < 256; ++m) l += expf(s[tid * 256 + m] - mx); red[tid] = mx; __threadfence_block();
        for (int m = 0; m < 256; ++m) s[tid * 256 + m] = expf(s[tid * 256 + m] - mx) / l; }
    __syncthreads();
    for (int n = tid; n < 1024; n += 256) { const int h = n >> 8, j = n & 255; float r = 0.f; for (int m = 0; m < 256; ++m) r += s[h * 256 + m] * bf2f(V2[((size_t)h * 256 + m) * 256 + j]); o[n] = r; }
    __syncthreads();
    if (tid == 0) { float r = 0.f; for (int n = 0; n < 1024; ++n) r += o[n] * xo[(size_t)n * 1024 + c]; const float res = ALPHA * bf2f(x1[c]);
        dbg_report(a.ws, 9, far(a.out[(size_t)t * 1024 + c] - res, r, 0.06f)); }
}
__global__ void chk12(DArgs a) {
    const int i = blockIdx.x * blockDim.x + threadIdx.x; const unsigned h0 = hsh(i * 2 + 91), h1 = hsh(i * 2 + 92); const int t = h0 % NTOK, hh = h1 % 16, key = (h1 >> 8) % 128;
    const bf16* x2 = (const bf16*)(a.ws + A_X2) + (size_t)t * 1024; const float* wq = (const float*)a.in[29]; const float* sk = (const float*)a.in[(hh & 1) ? 31 : 30] + key * 128; float r = 0.f;
    for (int d = 0; d < 128; ++d) { float qd = 0.f; for (int k = 0; k < 1024; ++k) qd += bf2f(x2[k]) * wq[(size_t)k * 2048 + hh * 128 + d]; r += qd * sk[d]; }
    const int h = hh >> 1; const float* sc = (h < 4 ? a.out : (const float*)(a.ws + A_SCHI)) + (size_t)t * 1024 + (h & 3) * 256 + (hh & 1) * 128 + key;
    dbg_report(a.ws, 10, far(*sc, r, 1.f));
}
__global__ void chk13(DArgs a) {
    __shared__ float s1[128], s2[128]; __shared__ int cnt;
    const int i = blockIdx.x, tid = threadIdx.x; const unsigned h0 = hsh(i * 2 + 101), h1 = hsh(i * 2 + 102); const int t = h0 % NTOK, h = h1 % 8;
    const float* sc = (h < 4 ? a.out : (const float*)(a.ws + A_SCHI)) + (size_t)t * 1024 + (h & 3) * 256;
    s1[tid] = sc[tid]; s1[tid + 64] = sc[tid + 64]; s2[tid] = sc[128 + tid]; s2[tid + 64] = sc[192 + tid]; if (tid == 0) cnt = 0; __syncthreads();
    const int* ids = (const int*)(a.ws + A_IDS) + (size_t)t * 128 + h * 16; const float* gt = (const float*)(a.ws + A_GATES) + (size_t)t * 128 + h * 16;
    float smin = 1e30f, smax = -1e30f; bool bad = false;
    for (int k = 0; k < 16; ++k) { const int id = ids[k]; if (id < 0 || id >= 16384) { bad = true; continue; } const float v = s1[id >> 7] + s2[id & 127]; smin = fminf(smin, v); smax = fmaxf(smax, v); for (int k2 = 0; k2 < k; ++k2) if (ids[k2] == id) bad = true; }
    float l = 0.f; for (int k = 0; k < 16; ++k) { const int id = ids[k] & 16383; l += expf(s1[id >> 7] + s2[id & 127] - smax); }
    for (int k = 0; k < 16; ++k) { const int id = ids[k] & 16383; if (far(gt[k], expf(s1[id >> 7] + s2[id & 127] - smax) / l, 0.02f)) bad = true; }
    int c = 0; for (int e = tid; e < 16384; e += 64) if (s1[e >> 7] + s2[e & 127] > smin + 2e-3f) ++c;
    atomicAdd(&cnt, c); __syncthreads();
    if (tid == 0) dbg_report(a.ws, 11, bad || cnt > 15);
}
__global__ void chk15(DArgs a) {
    __shared__ float hc[128], row[1024], red[256];
    const int i = blockIdx.x, tid = threadIdx.x; const int t = hsh(i * 2 + 111) % NTOK; const bf16* x2 = (const bf16*)(a.ws + A_X2) + (size_t)t * 1024;
    const int* ids = (const int*)(a.ws + A_IDS) + (size_t)t * 128; const float* gt = (const float*)(a.ws + A_GATES) + (size_t)t * 128; const float* ut = (const float*)a.in[32]; const float* vt = (const float*)a.in[33];
    if (tid < 128) { const float* u = ut + (size_t)(ids[tid] & 16383) * 1024; float d = 0.f; for (int k = 0; k < 1024; ++k) d += bf2f(x2[k]) * u[k];
        hc[tid] = gt[tid] * 0.5f * d * (1.f + tanhf(0.7978845608f * (d + 0.044715f * d * d * d))); }
    __syncthreads();
    for (int c = tid; c < 1024; c += 256) { float r = ALPHA * bf2f(x2[c]); for (int k = 0; k < 128; ++k) r += hc[k] * vt[(size_t)(ids[k] & 16383) * 1024 + c]; row[c] = r; }
    __syncthreads();
    float m = 0.f; for (int c = tid; c < 1024; c += 256) m += row[c]; red[tid] = m; __syncthreads(); if (tid == 0) { float s = 0.f; for (int k = 0; k < 256; ++k) s += red[k]; red[0] = s / 1024.f; } __syncthreads(); m = red[0]; __syncthreads();
    float v = 0.f; for (int c = tid; c < 1024; c += 256) v += (row[c] - m) * (row[c] - m); red[tid] = v; __syncthreads(); if (tid == 0) { float s = 0.f; for (int k = 0; k < 256; ++k) s += red[k]; red[0] = s / 1024.f; } __syncthreads(); v = red[0];
    __syncthreads(); float se = 0.f, sr = 0.f;
    for (int c = tid; c < 1024; c += 256) { const float r = (row[c] - m) * rsqrtf(v + 1e-5f) * ((const float*)a.in[34])[c] + ((const float*)a.in[35])[c]; const float g = a.out[(size_t)t * 1024 + c]; se += (g - r) * (g - r); sr += r * r; }
    red[tid] = se; __syncthreads(); if (tid == 0) { float s = 0.f; for (int k = 0; k < 256; ++k) s += red[k]; hc[0] = s; } __syncthreads();
    red[tid] = sr; __syncthreads(); if (tid == 0) { float s = 0.f; for (int k = 0; k < 256; ++k) s += red[k]; dbg_report(a.ws, 12, !(hc[0] <= 0.003f * s)); }
}
__global__ void dbg_poison(DArgs a) {
    const unsigned f = ((const unsigned*)(a.ws + WS_CTL))[CW_DBG]; if (!f) return; const int code = 32 - (int)f; float sc = 1.f; for (int k = 0; k < code; ++k) sc *= 10.f;
    for (size_t e = (size_t)blockIdx.x * blockDim.x + threadIdx.x; e < (size_t)NTOK * DM; e += (size_t)gridDim.x * blockDim.x) a.out[e] *= sc;
}
#endif

extern "C" void kernel_launch(void* const* d_in, const int* in_sizes, int n_in, void* d_out, int out_size, void* d_ws, size_t ws_size, hipStream_t stream) {
    static int grid = 0;
    if (grid == 0) {
        if (n_in != 36 || in_sizes[0] != NTOK * DM || out_size != NTOK * DM || ws_size < WS_NEED) {
            fprintf(stderr, "kernel_launch: unexpected shapes (n_in %d, in0 %d, out %d, ws %zu); nothing launched\n", n_in, n_in > 0 ? in_sizes[0] : -1, out_size, ws_size); grid = -1; return; }
        int dev = 0, cus = 0, per_cu = 0;
        if (hipGetDevice(&dev) != hipSuccess || hipDeviceGetAttribute(&cus, hipDeviceAttributeMultiprocessorCount, dev) != hipSuccess) { grid = -1; return; }
        if (hipFuncSetAttribute((const void*)mk_fwd, hipFuncAttributeMaxDynamicSharedMemorySize, LDS_BYTES) != hipSuccess) { fprintf(stderr, "kernel_launch: hipFuncSetAttribute failed\n"); grid = -1; return; }
        if (hipOccupancyMaxActiveBlocksPerMultiprocessor(&per_cu, (const void*)mk_fwd, NWAVES * 64, LDS_BYTES) != hipSuccess || per_cu < 1)
            fprintf(stderr, "kernel_launch: note: occupancy query reports %d workgroups per CU\n", per_cu);
        (void)hipGetLastError();
        grid = cus;
    }
    if (grid < 0) return;
    if (hipMemsetAsync((char*)d_ws + WS_CTL, 0, CTL_ZERO_BYTES, stream) != hipSuccess) return;
    Args a{};
    for (int i = 0; i < 36; ++i) a.in[i] = d_in[i];
    a.out = (float*)d_out; a.ws = (unsigned char*)d_ws;
#if MK_DBG
    DArgs da{}; for (int i = 0; i < 36; ++i) da.in[i] = d_in[i]; da.out = (float*)d_out; da.ws = (unsigned char*)d_ws;
    for (int p = 0; p < NPH; ++p) { a.ph_lo = p; a.ph_hi = p + 1; hipLaunchKernelGGL(mk_fwd, dim3(grid), dim3(NWAVES * 64), LDS_BYTES, stream, a);
        if (p == 1) { hipLaunchKernelGGL(chk1, dim3(8), dim3(256), 0, stream, da); hipLaunchKernelGGL(chk_k2, dim3(8), dim3(256), 0, stream, da); }
        if (p == 2) hipLaunchKernelGGL(chk2, dim3(8), dim3(256), 0, stream, da);
        if (p == 4) { hipLaunchKernelGGL(chk3, dim3(64), dim3(256), 0, stream, da); hipLaunchKernelGGL(chk4, dim3(64), dim3(256), 0, stream, da); }
        if (p == 5) hipLaunchKernelGGL(chk5, dim3(8), dim3(256), 0, stream, da);
        if (p == 7) hipLaunchKernelGGL(chk7, dim3(8), dim3(256), 0, stream, da);
        if (p == 8) hipLaunchKernelGGL(chk8, dim3(8), dim3(256), 0, stream, da, 0);
        if (p == 10) hipLaunchKernelGGL(chk10, dim3(64), dim3(256), 0, stream, da);
        if (p == 11) hipLaunchKernelGGL(chk8, dim3(8), dim3(256), 0, stream, da, 1);
        if (p == 12) hipLaunchKernelGGL(chk12, dim3(8), dim3(256), 0, stream, da);
        if (p == 13) hipLaunchKernelGGL(chk13, dim3(512), dim3(64), 0, stream, da);
        if (p == 15) { hipLaunchKernelGGL(chk15, dim3(64), dim3(256), 0, stream, da); hipLaunchKernelGGL(dbg_poison, dim3(1024), dim3(256), 0, stream, da); } }
#elif MK_PER_PHASE
    for (int p = 0; p < NPH; ++p) { a.ph_lo = p; a.ph_hi = p + 1; hipLaunchKernelGGL(mk_fwd, dim3(grid), dim3(NWAVES * 64), LDS_BYTES, stream, a); }
#else
    a.ph_lo = 0; a.ph_hi = NPH; hipLaunchKernelGGL(mk_fwd, dim3(grid), dim3(NWAVES * 64), LDS_BYTES, stream, a);
#endif
}
```
